# Optimizing an MI355X kernel written in HIP

```python
import math
import jax, jax.numpy as jnp
from jax import lax
import numpy as np

D_MODEL = 1024
BATCH = 4
SEQ = 4096
DEPTH = 4

D_MIX = D_MODEL
W_GROUP = D_MIX // 4
EPS = 1e-6
CONV_A_WIDTH = 31
A_GROUPS = 4
B_HEADS = 4
B_KV_HEADS = 2
B_HEAD_DIM = W_GROUP // B_HEADS
WINDOW = 128
BLOCK = 128
N_BUCKETS = 32
MAX_DISTANCE = 128
CONV_C_WIDTH = 4
C_BLOCKS = 4
C_BLOCK_DIM = W_GROUP // C_BLOCKS
LRU_C = 8.0
D_HEADS = 4
D_KEY_DIM = (W_GROUP // 2) // D_HEADS
D_VAL_DIM = W_GROUP // D_HEADS
GATE_RANK = 16
GATE_TAU = 16.0
CHUNK = 64

SPLIT_SIZES = [
    W_GROUP, W_GROUP, W_GROUP,
    B_HEADS * B_HEAD_DIM, B_KV_HEADS * B_HEAD_DIM, B_KV_HEADS * B_HEAD_DIM, W_GROUP,
    W_GROUP, W_GROUP,
    D_HEADS * D_KEY_DIM, D_HEADS * D_KEY_DIM, D_HEADS * D_VAL_DIM, GATE_RANK, W_GROUP,
]
IN_COLS = int(sum(SPLIT_SIZES))
SPLIT_POINTS = [int(v) for v in np.cumsum(SPLIT_SIZES)[:-1]]

kernel_name = "hymba_style_four_mixer_hybrid"


def rmsnorm(x, g):
    xf = x.astype(jnp.float32)
    y = xf * lax.rsqrt(jnp.mean(xf * xf, axis=-1, keepdims=True) + EPS)
    return (y * g.astype(jnp.float32)).astype(x.dtype)


def causal_dwconv(x, w, b):
    k = w.shape[0]
    y = lax.conv_general_dilated(x, w[:, None, :].astype(x.dtype), window_strides=(1,),
                                 padding=[(k - 1, 0)], dimension_numbers=("NWC", "WIO", "NWC"),
                                 feature_group_count=x.shape[-1])
    return y + b.astype(x.dtype)


def conformer_conv(val, glu, w_dw, b_dw, ln_g, ln_b, w_pw):
    u = val * jax.nn.sigmoid(glu)
    u = causal_dwconv(u, w_dw, b_dw)
    bsz, t, c = u.shape
    ug = u.reshape(bsz, t, A_GROUPS, c // A_GROUPS).astype(jnp.float32)
    mu = jnp.mean(ug, axis=-1, keepdims=True)
    var = jnp.mean(jnp.square(ug - mu), axis=-1, keepdims=True)
    ug = ((ug - mu) * lax.rsqrt(var + EPS)).reshape(bsz, t, c)
    u = (ug * ln_g.astype(jnp.float32) + ln_b.astype(jnp.float32)).astype(val.dtype)
    return jax.nn.silu(u) @ w_pw


def t5_bucket(dist):
    max_exact = N_BUCKETS // 2
    d = jnp.maximum(dist, 1).astype(jnp.float32)
    large = max_exact + (jnp.log(d / max_exact) / math.log(MAX_DISTANCE / max_exact)
                         * (N_BUCKETS - max_exact)).astype(jnp.int32)
    large = jnp.minimum(large, N_BUCKETS - 1)
    return jnp.where(dist < max_exact, dist, large)


def swa_sink_attention(q, k, v, q_g, k_g, sinks, bias):
    bsz, t, _ = q.shape
    nb = t // BLOCK
    grp = B_HEADS // B_KV_HEADS
    q = rmsnorm(q.reshape(bsz, t, B_KV_HEADS, grp, B_HEAD_DIM), q_g)
    k = rmsnorm(k.reshape(bsz, t, B_KV_HEADS, B_HEAD_DIM), k_g)
    v = v.reshape(bsz, t, B_KV_HEADS, B_HEAD_DIM)
    qb = q.reshape(bsz, nb, BLOCK, B_KV_HEADS, grp, B_HEAD_DIM)

    def band(z):
        prev = jnp.pad(z, ((0, 0), (BLOCK, 0), (0, 0), (0, 0)))[:, :t]
        shp = (bsz, nb, BLOCK, B_KV_HEADS, B_HEAD_DIM)
        return jnp.concatenate([prev.reshape(shp), z.reshape(shp)], axis=2)

    kb, vb = band(k), band(v)
    s = jnp.einsum('bnqhgd,bnkhd->bnhgqk', qb, kb,
                   preferred_element_type=jnp.float32) * (B_HEAD_DIM ** -0.5)
    s = s + bias.reshape(B_KV_HEADS, grp, BLOCK, 2 * BLOCK).astype(jnp.float32)[None, None]
    qi = jnp.arange(BLOCK)[:, None]
    kj = jnp.arange(2 * BLOCK)[None, :]
    dist = qi + BLOCK - kj
    keypos = jnp.arange(nb)[:, None, None] * BLOCK - BLOCK + kj[None]
    valid = (dist >= 0)[None] & (dist < WINDOW)[None] & (keypos >= 0)
    s = jnp.where(valid[None, :, None, None], s, -jnp.inf)
    sink = sinks.reshape(B_KV_HEADS, grp).astype(jnp.float32)[None, None, :, :, None, None]
    m = jnp.maximum(jnp.max(s, axis=-1, keepdims=True), sink)
    p = jnp.exp(s - m)
    p = p / (jnp.sum(p, axis=-1, keepdims=True) + jnp.exp(sink - m))
    o = jnp.einsum('bnhgqk,bnkhd->bnqhgd', p.astype(v.dtype), vb)
    return o.reshape(bsz, t, B_HEADS * B_HEAD_DIM)


def rg_lru(xc, conv_w, conv_b, w_r, b_r, w_i, b_i, lam):
    x = causal_dwconv(xc, conv_w, conv_b)
    bsz, t, c = x.shape
    xb = x.reshape(bsz, t, C_BLOCKS, C_BLOCK_DIM)
    r = jax.nn.sigmoid(jnp.einsum('btnc,ncd->btnd', xb, w_r).reshape(bsz, t, c) + b_r)
    i = jax.nn.sigmoid(jnp.einsum('btnc,ncd->btnd', xb, w_i).reshape(bsz, t, c) + b_i)
    log_a = (-LRU_C * r.astype(jnp.float32)) * jax.nn.softplus(-lam.astype(jnp.float32))
    a = jnp.exp(log_a)
    u = jnp.sqrt(-jnp.expm1(2.0 * log_a)) * (i * x).astype(jnp.float32)

    def combine(left, right):
        a1, b1 = left
        a2, b2 = right
        return a1 * a2, a2 * b1 + b2

    _, h = lax.associative_scan(combine, (a, u), axis=1)
    return h.astype(x.dtype)


def gla(q, k, v, lr, w_up, b_up, norm_g):
    bsz, t, _ = q.shape
    nc = t // CHUNK
    f32 = jnp.float32
    g = jax.nn.log_sigmoid((lr @ w_up + b_up).astype(f32)) / GATE_TAU
    q = q.reshape(bsz, nc, CHUNK, D_HEADS, D_KEY_DIM).astype(f32) * (D_KEY_DIM ** -0.5)
    k = k.reshape(bsz, nc, CHUNK, D_HEADS, D_KEY_DIM).astype(f32)
    vv = v.reshape(bsz, nc, CHUNK, D_HEADS, D_VAL_DIM).astype(f32)
    g = g.reshape(bsz, nc, CHUNK, D_HEADS, D_KEY_DIM)
    b = jnp.cumsum(g, axis=2)
    b_last = b[:, :, -1:]
    q_t = q * jnp.exp(b)
    k_t = k * jnp.exp(-b)
    k_end = k * jnp.exp(b_last - b)
    causal = jnp.tril(jnp.ones((CHUNK, CHUNK), f32))
    att = jnp.einsum('bnihd,bnjhd->bnhij', q_t, k_t) * causal
    o_intra = jnp.einsum('bnhij,bnjhe->bnihe', att, vv)
    d_state = jnp.einsum('bnjhd,bnjhe->bnhde', k_end, vv)
    decay = jnp.exp(b_last[:, :, 0])

    def step(state, inp):
        ds, dec = inp
        return state * dec[..., None] + ds, state

    s0 = jnp.zeros((bsz, D_HEADS, D_KEY_DIM, D_VAL_DIM), f32)
    _, s_prev = lax.scan(step, s0, (jnp.moveaxis(d_state, 1, 0), jnp.moveaxis(decay, 1, 0)))
    s_prev = jnp.moveaxis(s_prev, 0, 1)
    o_inter = jnp.einsum('bnihd,bnhde->bnihe', q_t, s_prev)
    o = (o_intra + o_inter).reshape(bsz, t, D_HEADS, D_VAL_DIM)
    o = rmsnorm(o, norm_g)
    return o.reshape(bsz, t, D_HEADS * D_VAL_DIM).astype(v.dtype)


def setup_inputs(seed: int = 0) -> dict:
    key = jax.random.key(seed)
    ks = jax.random.split(key, 24)
    f32 = jnp.float32
    nrm = lambda k, shp, s: jax.random.normal(k, shp, f32) * s
    a0 = jax.random.uniform(ks[20], (DEPTH, W_GROUP), f32, 0.9, 0.999)
    base = a0 ** (1.0 / LRU_C)
    return {
        "x": jax.random.normal(ks[0], (BATCH, SEQ, D_MODEL), f32),
        "norm_g": 1.0 + nrm(ks[1], (DEPTH, D_MODEL), 0.02),
        "w_in": nrm(ks[2], (DEPTH, D_MODEL, IN_COLS), D_MODEL ** -0.5),
        "a_conv_w": nrm(ks[3], (DEPTH, CONV_A_WIDTH, W_GROUP), CONV_A_WIDTH ** -0.5),
        "a_conv_b": nrm(ks[4], (DEPTH, W_GROUP), 0.01),
        "a_ln_g": 1.0 + nrm(ks[5], (DEPTH, W_GROUP), 0.02),
        "a_ln_b": nrm(ks[6], (DEPTH, W_GROUP), 0.01),
        "a_pw": nrm(ks[7], (DEPTH, W_GROUP, W_GROUP), W_GROUP ** -0.5),
        "b_q_g": 1.0 + nrm(ks[8], (DEPTH, B_HEAD_DIM), 0.02),
        "b_k_g": 1.0 + nrm(ks[9], (DEPTH, B_HEAD_DIM), 0.02),
        "b_sinks": nrm(ks[10], (DEPTH, B_HEADS), 0.5),
        "rel_bias": nrm(ks[11], (N_BUCKETS, B_HEADS), 0.5),
        "c_conv_w": nrm(ks[12], (DEPTH, CONV_C_WIDTH, W_GROUP), CONV_C_WIDTH ** -0.5),
        "c_conv_b": nrm(ks[13], (DEPTH, W_GROUP), 0.01),
        "c_w_r": nrm(ks[14], (DEPTH, C_BLOCKS, C_BLOCK_DIM, C_BLOCK_DIM), C_BLOCK_DIM ** -0.5),
        "c_b_r": nrm(ks[15], (DEPTH, W_GROUP), 0.01),
        "c_w_i": nrm(ks[16], (DEPTH, C_BLOCKS, C_BLOCK_DIM, C_BLOCK_DIM), C_BLOCK_DIM ** -0.5),
        "c_b_i": nrm(ks[17], (DEPTH, W_GROUP), 0.01),
        "c_lambda": jnp.log(base) - jnp.log1p(-base),
        "d_w_up": nrm(ks[18], (DEPTH, GATE_RANK, D_HEADS * D_KEY_DIM), GATE_RANK ** -0.5),
        "d_b_up": nrm(ks[19], (DEPTH, D_HEADS * D_KEY_DIM), 0.01),
        "d_norm_g": 1.0 + nrm(ks[21], (DEPTH, D_VAL_DIM), 0.02),
        "w_out": nrm(ks[22], (DEPTH, D_MIX, D_MODEL), 0.5 * D_MIX ** -0.5),
    }


def reference(x, norm_g, w_in, a_conv_w, a_conv_b, a_ln_g, a_ln_b, a_pw, b_q_g, b_k_g, b_sinks,
              rel_bias, c_conv_w, c_conv_b, c_w_r, c_b_r, c_w_i, c_b_i, c_lambda, d_w_up, d_b_up,
              d_norm_g, w_out):
    dist = jnp.arange(BLOCK)[:, None] + BLOCK - jnp.arange(2 * BLOCK)[None, :]
    bucket = t5_bucket(jnp.clip(dist, 0, None))
    bias = jnp.transpose(rel_bias[bucket], (2, 0, 1))
    for l in range(DEPTH):
        h = rmsnorm(x, norm_g[l])
        proj = h @ w_in[l]
        (a_val, a_glu, a_gate, bq, bk, bv, b_gate, c_x, c_gate,
         dq, dk, dv, d_lr, d_gate) = jnp.split(proj, SPLIT_POINTS, axis=-1)
        ya = conformer_conv(a_val, a_glu, a_conv_w[l], a_conv_b[l], a_ln_g[l], a_ln_b[l], a_pw[l]) * jax.nn.silu(a_gate)
        yb = swa_sink_attention(bq, bk, bv, b_q_g[l], b_k_g[l], b_sinks[l], bias) * jax.nn.silu(b_gate)
        yc = rg_lru(c_x, c_conv_w[l], c_conv_b[l], c_w_r[l], c_b_r[l], c_w_i[l], c_b_i[l], c_lambda[l]) * jax.nn.silu(c_gate)
        yd = gla(dq, dk, dv, d_lr, d_w_up[l], d_b_up[l], d_norm_g[l]) * jax.nn.silu(d_gate)
        y = jnp.concatenate([ya, yb, yc, yd], axis=-1)
        x = x + y @ w_out[l]
    return x
```

```cpp
#include <hip/hip_runtime.h>
#include <cstdio>
#include <cstdint>
template <int CTRL> __device__ __forceinline__ float dpp(float x) { return __builtin_bit_cast(float, __builtin_amdgcn_mov_dpp(__builtin_bit_cast(int, x), CTRL, 0xf, 0xf, true)); }
constexpr int DPP_XOR1 = 0xB1, DPP_XOR2 = 0x4E, DPP_XOR7 = 0x141, DPP_XOR8 = 0x128;
__device__ __forceinline__ float sum8(float v) { v += dpp<DPP_XOR1>(v); v += dpp<DPP_XOR2>(v); v += dpp<DPP_XOR7>(v); return v; }
__device__ __forceinline__ float sum16(float v) { v = sum8(v); v += dpp<DPP_XOR8>(v); return v; }
__device__ __forceinline__ float xsum16(float x) { auto s = __builtin_amdgcn_permlane16_swap(__float_as_uint(x), __float_as_uint(x), false, false); return __uint_as_float(s[0]) + __uint_as_float(s[1]); }
__device__ __forceinline__ float xsum32(float x) { auto s = __builtin_amdgcn_permlane32_swap(__float_as_uint(x), __float_as_uint(x), false, false); return __uint_as_float(s[0]) + __uint_as_float(s[1]); }
__device__ __forceinline__ float xmax32(float x) { auto s = __builtin_amdgcn_permlane32_swap(__float_as_uint(x), __float_as_uint(x), false, false); return fmaxf(__uint_as_float(s[0]), __uint_as_float(s[1])); }
__device__ __forceinline__ float xget32(float x, int hi) { auto s = __builtin_amdgcn_permlane32_swap(__float_as_uint(x), __float_as_uint(x), false, false); return __uint_as_float(hi ? s[0] : s[1]); }
__device__ __forceinline__ float sum32(float v) { return xsum16(sum16(v)); }
namespace pg8 {
#define PG8_LAS __attribute__((address_space(3)))
typedef unsigned short bf16_t;
typedef short bf16x8 __attribute__((ext_vector_type(8)));
typedef float f32x4 __attribute__((ext_vector_type(4)));
typedef unsigned u32x4 __attribute__((ext_vector_type(4)));
constexpr int BM = 256, BK = 64, HALF = 128, HTB = HALF * BK * 2  , STAGE_BYTES = 8 * HTB, NXCD = 8, WGM = 8;

__host__ __device__ __forceinline__ int lds_byte(int r, int c) { const int st = (r >> 4) * 2 + (c >> 5), rr = r & 15, cc = c & 31, ob = rr * 64 + cc * 2; return st * 1024 + (ob ^ (((ob >> 9) & 1) << 5)); }
__host__ __device__ __forceinline__ void stage_rc(int b, int& R, int& C) { const int st = b / 1024, sb = b % 1024, swz = sb ^ (((sb >> 9) & 1) << 5); R = (st >> 1) * 16 + swz / 64; C = (st & 1) * 32 + (swz % 64) / 2; }
__host__ __device__ __forceinline__ int perm32(int rho) { const int n = rho >> 4, i = rho & 15; return 8 * (i >> 2) + 4 * n + (i & 3); }

struct Unit { int pm, pn; };
struct Gemm { const bf16_t* A; const bf16_t* Bt; int M, N, K; };

struct StaticOrder {
    int nM, nN, nwg, G, c;
    __host__ __device__ void init(int M, int N, int G_, int c_) { nM = M / BM; nN = N / BM; nwg = nM * nN; G = G_; c = c_; }
    __host__ __device__ bool next(int i, Unit& u) const {
        const long L = (long)i * G + c; if (L >= nwg) return false;
        int wgid = (int)L; { const int q = nwg / NXCD, r = nwg % NXCD, xcd = wgid % NXCD, off = wgid / NXCD; wgid = (xcd < r ? xcd * (q + 1) : r * (q + 1) + (xcd - r) * q) + off; }
        const int nig = WGM * nN, gid = wgid / nig, fm = gid * WGM, gsz = (nM - fm) < WGM ? (nM - fm) : WGM;
        u.pm = fm + ((wgid % nig) % gsz); u.pn = (wgid % nig) / gsz; return true;
    }
    __device__ __forceinline__ void a_ready(const Unit&) const {}
    __device__ __forceinline__ void done(const Unit&) const {}
};

__device__ __forceinline__ unsigned cvt_pk_bf16(float lo, float hi) { unsigned r; asm volatile("v_cvt_pk_bf16_f32 %0, %1, %2" : "=v"(r) : "v"(lo), "v"(hi)); return r; }
struct EpiProj {
    static constexpr bool PERM = true, AFTER_DRAIN = false;
    bf16_t* O; int ldc; const float* ssq; __amdgpu_buffer_rsrc_t rsrc;
    __device__ __forceinline__ void operator()(const f32x4 (&acc)[2][2][4][2], const Unit& u, int wr, int wc, int fr, int fq) const {
        const int row0 = u.pm * BM + wr * 64 + fr, col0 = u.pn * BM + wc * 32 + 8 * fq;
#pragma unroll
        for (int ai = 0; ai < 2; ++ai)
#pragma unroll
            for (int m = 0; m < 4; ++m) { const int row = row0 + ai * HALF + m * 16;
                const f32x4 s4 = *(const f32x4*)(ssq + (size_t)row * 16 + 4 * fq);
                float s = (s4[0] + s4[1]) + (s4[2] + s4[3]); s = xsum32(xsum16(s));
                const float rs = 1.0f / sqrtf(s * (1.0f / 1024.0f) + 1e-6f);
                const unsigned boff = (unsigned)(((size_t)row * ldc + col0) * 2);
#pragma unroll
                for (int bj = 0; bj < 2; ++bj) { const f32x4 v0 = acc[ai][bj][m][0] * rs, v1 = acc[ai][bj][m][1] * rs;
                    u32x4 w; w.x = cvt_pk_bf16(v0[0], v0[1]); w.y = cvt_pk_bf16(v0[2], v0[3]); w.z = cvt_pk_bf16(v1[0], v1[1]); w.w = cvt_pk_bf16(v1[2], v1[3]);
                    __builtin_amdgcn_raw_buffer_store_b128(w, rsrc, boff + bj * HALF * 2, 0,   16); } }
    }
};
struct EpiRes {
    static constexpr bool PERM = true, AFTER_DRAIN = false;
    const float* xin; float* xout; bf16_t* xb; float* ssq; int mode;
    __device__ __forceinline__ void operator()(const f32x4 (&acc)[2][2][4][2], const Unit& u, int wr, int wc, int fr, int fq) const {
        const int row0 = u.pm * BM + wr * 64 + fr, col0 = u.pn * BM + wc * 32 + 8 * fq;
#pragma unroll
        for (int ai = 0; ai < 2; ++ai)
#pragma unroll
            for (int m = 0; m < 4; ++m) { const int row = row0 + ai * HALF + m * 16; float ss = 0.f;
#pragma unroll
                for (int bj = 0; bj < 2; ++bj) { const size_t off = (size_t)row * 1024 + col0 + bj * HALF; f32x4 x0, x1;
                    if (mode == 0) { x0 = *(const f32x4*)(xin + off); x1 = *(const f32x4*)(xin + off + 4); }
                    else { const u32x4 w = *(const u32x4*)(xb + off); x0 = (f32x4){__uint_as_float(w.x << 16), __uint_as_float(w.x & 0xffff0000u), __uint_as_float(w.y << 16), __uint_as_float(w.y & 0xffff0000u)};
                        x1 = (f32x4){__uint_as_float(w.z << 16), __uint_as_float(w.z & 0xffff0000u), __uint_as_float(w.w << 16), __uint_as_float(w.w & 0xffff0000u)}; }
                    x0 = x0 + acc[ai][bj][m][0]; x1 = x1 + acc[ai][bj][m][1];
                    if (mode == 2) { *(f32x4*)(xout + off) = x0; *(f32x4*)(xout + off + 4) = x1; }
                    else { u32x4 w; w.x = cvt_pk_bf16(x0[0], x0[1]); w.y = cvt_pk_bf16(x0[2], x0[3]); w.z = cvt_pk_bf16(x1[0], x1[1]); w.w = cvt_pk_bf16(x1[2], x1[3]);
                        *(u32x4*)(xb + off) = w;
                        const float r0 = __uint_as_float(w.x << 16), r1 = __uint_as_float(w.x & 0xffff0000u), r2 = __uint_as_float(w.y << 16), r3 = __uint_as_float(w.y & 0xffff0000u),
                                    r4 = __uint_as_float(w.z << 16), r5 = __uint_as_float(w.z & 0xffff0000u), r6 = __uint_as_float(w.w << 16), r7 = __uint_as_float(w.w & 0xffff0000u);
                        ss += (r0 * r0 + r1 * r1) + (r2 * r2 + r3 * r3) + (r4 * r4 + r5 * r5) + (r6 * r6 + r7 * r7); } }
                if (mode != 2) { ss = xsum32(xsum16(ss)); if (fq == 0) ssq[(size_t)row * 16 + u.pn * 4 + wc] = ss; } }
    }
};

template <class Epi, class Sched, bool ALIGN_EPI = false, bool SP2 = false>
__device__ __forceinline__ void gemm_phase(PG8_LAS unsigned char* lds, const Gemm g, const Sched& S, const Epi& E) {
    int tid_ = threadIdx.x; asm volatile("" : "+v"(tid_));
    const int tid = tid_, wid = __builtin_amdgcn_readfirstlane(tid >> 6), lane = tid & 63, wr = wid >> 2, wc = wid & 3, fr = lane & 15, fq = lane >> 4;
    const int K = g.K, nt = K / BK;
    unsigned voffA[2], voffB[2];
#pragma unroll
    for (int i = 0; i < 2; ++i) { int R, C; stage_rc(tid * 16 + i * 8192, R, C); const int Rb = Epi::PERM ? ((R & ~31) + perm32(R & 31)) : R;
        voffA[i] = (unsigned)(R * K + C) * 2u; voffB[i] = (unsigned)(Rb * K + C) * 2u; }
    const size_t kstep = (size_t)(BK * 2);
    const size_t hstep = (size_t)HALF * K * 2;
    const size_t tstep = 2 * hstep;
    const unsigned ldsw = (unsigned)wid * 1024u;
    const int aoff = lds_byte(wr * 64 + fr, fq * 8), boff = lds_byte(wc * 32 + fr, fq * 8);
#define PG8_SA(b, h) (((b) * 2 + (h)) * HTB)
#define PG8_SB(b, h) ((4 + (b) * 2 + (h)) * HTB)
#define PG8_STAGE(bufoff, gbase, voff) do { _Pragma("unroll") for (int _i = 0; _i < 2; ++_i) \
        __builtin_amdgcn_global_load_lds((const unsigned*)((const char*)(gbase) + (voff)[_i]), (PG8_LAS unsigned*)(lds + (bufoff) + ldsw + _i * 8192), 16, 0, 0); } while (0)
#define PG8_LDA(dst, b, h) do { _Pragma("unroll") for (int m = 0; m < 4; ++m) _Pragma("unroll") for (int k = 0; k < 2; ++k) dst[m][k] = *(const PG8_LAS bf16x8*)(lds + PG8_SA(b, h) + aoff + m * 2048 + k * 1024); } while (0)
#define PG8_LDB(dst, b, h) do { _Pragma("unroll") for (int n = 0; n < 2; ++n) _Pragma("unroll") for (int k = 0; k < 2; ++k) dst[n][k] = *(const PG8_LAS bf16x8*)(lds + PG8_SB(b, h) + boff + n * 2048 + k * 1024); } while (0)
#define PG8_MMA(ai, bj, At, Bt) do { __builtin_amdgcn_s_setprio(1); _Pragma("unroll") for (int m = 0; m < 4; ++m) _Pragma("unroll") for (int n = 0; n < 2; ++n) _Pragma("unroll") for (int k = 0; k < 2; ++k) \
        acc[ai][bj][m][n] = __builtin_amdgcn_mfma_f32_16x16x32_bf16(Bt[n][k], At[m][k], acc[ai][bj][m][n], 0, 0, 0); __builtin_amdgcn_s_setprio(0); } while (0)
#define PG8_WAIT_V(n) asm volatile("s_waitcnt vmcnt(" #n ")" ::: "memory")
#define PG8_WAIT_L(n) asm volatile("s_waitcnt lgkmcnt(" #n ")" ::: "memory")
#define PG8_BAR __builtin_amdgcn_s_barrier()
#define PG8_SCHED __builtin_amdgcn_sched_barrier(0)
    Unit cur, nxt; int ui = 0;
    if (!S.next(0, cur)) return;
    f32x4 acc[2][2][4][2];
#pragma unroll
    for (int a = 0; a < 2; ++a)
#pragma unroll
        for (int b = 0; b < 2; ++b)
#pragma unroll
            for (int m = 0; m < 4; ++m)
#pragma unroll
                for (int n = 0; n < 2; ++n) acc[a][b][m][n] = (f32x4){0.f, 0.f, 0.f, 0.f};
    bf16x8 At[4][2], B0[2][2], B1[2][2];
    const char* cA = (const char*)g.A + (size_t)cur.pm * tstep; const char* cB = (const char*)g.Bt + (size_t)cur.pn * tstep;
    S.a_ready(cur);
    if constexpr (SP2) {
        PG8_STAGE(PG8_SB(0, 0), cB, voffB); PG8_STAGE(PG8_SB(0, 1), cB + hstep, voffB); PG8_STAGE(PG8_SA(0, 0), cA, voffA); PG8_STAGE(PG8_SA(0, 1), cA + hstep, voffA);
        if (wr == 1) PG8_BAR;
        PG8_WAIT_V(2); PG8_BAR;
        PG8_STAGE(PG8_SB(1, 0), cB + kstep, voffB); PG8_STAGE(PG8_SA(1, 0), cA + kstep, voffA); PG8_STAGE(PG8_SB(1, 1), cB + hstep + kstep, voffB);
        PG8_WAIT_V(6); PG8_BAR;
    } else {
        PG8_STAGE(PG8_SB(0, 0), cB, voffB); PG8_STAGE(PG8_SA(0, 0), cA, voffA); PG8_STAGE(PG8_SB(0, 1), cB + hstep, voffB); PG8_STAGE(PG8_SA(0, 1), cA + hstep, voffA);
        if (wr == 1) PG8_BAR;
        PG8_WAIT_V(4); PG8_BAR;
        PG8_STAGE(PG8_SB(1, 0), cB + kstep, voffB); PG8_STAGE(PG8_SA(1, 0), cA + kstep, voffA); PG8_STAGE(PG8_SB(1, 1), cB + hstep + kstep, voffB);
        PG8_WAIT_V(6); PG8_BAR;
    }
    for (;;) {
        const bool has_next = S.next(ui + 1, nxt);
        const char* nA = has_next ? (const char*)g.A + (size_t)nxt.pm * tstep : cA; const char* nB = has_next ? (const char*)g.Bt + (size_t)nxt.pn * tstep : cB;
        for (int t = 0; t < nt; t += 2) {
            const bool last = (t == nt - 2);
            const char* a1 = cA + (size_t)(t + 1) * kstep;
            const char* a2 = last ? nA : cA + (size_t)(t + 2) * kstep; const char* b2 = last ? nB : cB + (size_t)(t + 2) * kstep;
            const char* a3 = a2 + kstep; const char* b3 = b2 + kstep;
            if (last && has_next) S.a_ready(nxt);
            if constexpr (SP2) {
            PG8_LDB(B0, 0, 0); PG8_LDB(B1, 0, 1); PG8_SCHED; PG8_LDA(At, 0, 0); PG8_STAGE(PG8_SA(1, 1), a1 + hstep, voffA);
            PG8_WAIT_V(8); PG8_WAIT_L(0); PG8_BAR; PG8_MMA(0, 0, At, B0); PG8_MMA(0, 1, At, B1); PG8_BAR; PG8_SCHED;
            PG8_LDA(At, 0, 1); PG8_STAGE(PG8_SB(0, 0), b2, voffB); PG8_STAGE(PG8_SB(0, 1), b2 + hstep, voffB); PG8_STAGE(PG8_SA(0, 0), a2, voffA);
            PG8_WAIT_V(8); PG8_WAIT_L(0); PG8_BAR; PG8_MMA(1, 0, At, B0); PG8_MMA(1, 1, At, B1); PG8_BAR; PG8_SCHED;
            PG8_LDB(B0, 1, 0); PG8_LDB(B1, 1, 1); PG8_SCHED; PG8_LDA(At, 1, 0); PG8_STAGE(PG8_SA(0, 1), a2 + hstep, voffA);
            PG8_WAIT_V(8); PG8_WAIT_L(0); PG8_BAR; PG8_MMA(0, 0, At, B0); PG8_MMA(0, 1, At, B1); PG8_BAR; PG8_SCHED;
            PG8_LDA(At, 1, 1); PG8_STAGE(PG8_SB(1, 0), b3, voffB); PG8_STAGE(PG8_SB(1, 1), b3 + hstep, voffB); PG8_STAGE(PG8_SA(1, 0), a3, voffA);
            PG8_WAIT_V(8); PG8_WAIT_L(0); PG8_BAR; PG8_MMA(1, 0, At, B0); PG8_MMA(1, 1, At, B1); PG8_BAR; PG8_SCHED;
            } else {
            PG8_LDB(B0, 0, 0); PG8_SCHED; PG8_LDA(At, 0, 0); PG8_STAGE(PG8_SA(1, 1), a1 + hstep, voffA);
            PG8_WAIT_L(8); PG8_BAR; PG8_WAIT_L(0); PG8_MMA(0, 0, At, B0); PG8_BAR; PG8_SCHED;
            PG8_LDB(B1, 0, 1); PG8_STAGE(PG8_SB(0, 0), b2, voffB);
            PG8_BAR; PG8_WAIT_L(0); PG8_MMA(0, 1, At, B1); PG8_BAR;
            PG8_LDA(At, 0, 1); PG8_STAGE(PG8_SA(0, 0), a2, voffA);
            PG8_BAR; PG8_WAIT_L(0); PG8_MMA(1, 0, At, B0); PG8_BAR; PG8_SCHED;
            PG8_STAGE(PG8_SB(0, 1), b2 + hstep, voffB);
            PG8_WAIT_V(6); PG8_BAR; PG8_MMA(1, 1, At, B1); PG8_BAR;
            PG8_LDB(B0, 1, 0); PG8_SCHED; PG8_LDA(At, 1, 0); PG8_STAGE(PG8_SA(0, 1), a2 + hstep, voffA);
            PG8_WAIT_L(8); PG8_BAR; PG8_WAIT_L(0); PG8_MMA(0, 0, At, B0); PG8_BAR; PG8_SCHED;
            PG8_LDB(B1, 1, 1); PG8_STAGE(PG8_SB(1, 0), b3, voffB);
            PG8_BAR; PG8_WAIT_L(0); PG8_MMA(0, 1, At, B1); PG8_BAR;
            PG8_LDA(At, 1, 1); PG8_STAGE(PG8_SA(1, 0), a3, voffA);
            PG8_BAR; PG8_WAIT_L(0); PG8_MMA(1, 0, At, B0); PG8_BAR; PG8_SCHED;
            PG8_STAGE(PG8_SB(1, 1), b3 + hstep, voffB);
            PG8_WAIT_V(6); PG8_BAR; PG8_MMA(1, 1, At, B1); PG8_BAR;
            }
        }
        if constexpr (ALIGN_EPI) { if (wr == 0) PG8_BAR; }
        if constexpr (!Epi::AFTER_DRAIN) { E(acc, cur, wr, wc, fr, fq); S.done(cur); }
        if (!has_next) break;
#pragma unroll
        for (int a = 0; a < 2; ++a)
#pragma unroll
            for (int b = 0; b < 2; ++b)
#pragma unroll
                for (int m = 0; m < 4; ++m)
#pragma unroll
                    for (int n = 0; n < 2; ++n) acc[a][b][m][n] = (f32x4){0.f, 0.f, 0.f, 0.f};
        cur = nxt; cA = nA; cB = nB; ++ui;
        if constexpr (ALIGN_EPI) { if (wr == 1) PG8_BAR; }
    }
    PG8_WAIT_V(0);
    if constexpr (!ALIGN_EPI) { if (wr == 0) PG8_BAR; }
    PG8_BAR;
    if constexpr (Epi::AFTER_DRAIN) { E.fused(acc, cur, wr, wc, fr, fq, lds, wid, lane); S.done(cur); }
#undef PG8_SA
#undef PG8_SB
#undef PG8_STAGE
#undef PG8_LDA
#undef PG8_LDB
#undef PG8_MMA
#undef PG8_WAIT_V
#undef PG8_WAIT_L
#undef PG8_BAR
#undef PG8_SCHED
}
}
using pg8::bf16_t; using pg8::bf16x8; using pg8::f32x4; using pg8::u32x4; using pg8::cvt_pk_bf16;
#define GAS __attribute__((address_space(1)))
#define LAS __attribute__((address_space(3)))
typedef float f32x16 __attribute__((ext_vector_type(16)));
typedef float f32x2 __attribute__((ext_vector_type(2)));
typedef unsigned u32x2 __attribute__((ext_vector_type(2)));
typedef GAS unsigned gu32;
#define RLX_AGENT __ATOMIC_RELAXED, __HIP_MEMORY_SCOPE_AGENT
#define LDS_WAIT() asm volatile("s_waitcnt lgkmcnt(0)" ::: "memory")
#define MFMA32(a, b, c) __builtin_amdgcn_mfma_f32_32x32x16_bf16((a), (b), (c), 0, 0, 0)

constexpr int NWAVES = 8, NTHR = 512;
constexpr int BATCH = 4, SEQ = 4096, DM = 1024, DEPTH = 4, M = BATCH * SEQ, NIN = 2832, NP = 3072;
constexpr float EPS = 1e-6f;
constexpr int PC_AVAL = 0, PC_AGLU = 256, PC_AGATE = 512, PC_BQ = 768, PC_BK = 1024, PC_BV = 1152, PC_BGATE = 1280, PC_CX = 1536, PC_CGATE = 1792,
              PC_DQ = 2048, PC_DK = 2176, PC_DV = 2304, PC_DGATE = 2560, PC_DLR = 2816;
__host__ __device__ __forceinline__ int win_remap(int n) { return n < 2560 ? n : (n < 2816 ? n + 16 : (n < 2832 ? n - 256 : -1)); }
constexpr size_t MiB = 1u << 20;
constexpr size_t WS_CTL = 0, CTL_ZERO_BYTES = 1 * MiB;
constexpr size_t WS_WIN = 2 * MiB;
constexpr size_t WS_WOUT = 26 * MiB;
constexpr size_t WS_APW = 34 * MiB;
constexpr size_t WS_WR = WS_APW + 512 * 1024, WS_WI = WS_WR + 128 * 1024;
constexpr size_t WS_SSQ = 35 * MiB;
constexpr size_t WS_XB = 36 * MiB;
constexpr size_t WS_Y = 68 * MiB;
constexpr size_t WS_PROJ = 100 * MiB;
constexpr size_t WS_GC = 200 * MiB;
constexpr size_t WS_GD = 201 * MiB;
constexpr size_t WS_BIAS = 204 * MiB;
constexpr size_t WS_END = 205 * MiB;
constexpr int CW_BAR = 4096;
constexpr int CW_TEAM = 65536;
constexpr int CW_PCNT = 131072;
constexpr int CW_GDONE = CW_PCNT + 64 * 256;
constexpr int CW_Q = 16384;
constexpr int RING_BYTES = 131072, LDSCTL_OFF = RING_BYTES, MISC_OFF = LDSCTL_OFF + 320, LDS_BYTES = 147456;

__device__ __forceinline__ float bf_lo(unsigned w) { return __uint_as_float(w << 16); }
__device__ __forceinline__ float bf_hi(unsigned w) { return __uint_as_float(w & 0xffff0000u); }
__device__ __forceinline__ unsigned f2bf(float f) { unsigned u = __float_as_uint(f); return (u + 0x7fffu + ((u >> 16) & 1u)) >> 16; }
typedef __bf16 bf16v2 __attribute__((ext_vector_type(2)));
__device__ __forceinline__ unsigned pk2(float lo, float hi) { const f32x2 f = {lo, hi}; const bf16v2 b = __builtin_convertvector(f, bf16v2); return __builtin_bit_cast(unsigned, b); }
__device__ __forceinline__ float fexp(float x) { return __builtin_amdgcn_exp2f(x * 1.4426950408889634f); }
__device__ __forceinline__ float frcp(float x) { return __builtin_amdgcn_rcpf(x); }
__device__ __forceinline__ float sigm(float x) { return frcp(1.f + fexp(-x)); }
__device__ __forceinline__ float silu(float x) { return x * sigm(x); }
__device__ __forceinline__ float rsq(float x) { return __builtin_amdgcn_rsqf(x); }
__device__ __forceinline__ float log1p_01(float e) { return __builtin_amdgcn_logf(1.0f + e) * 0.6931471805599453f; }
__device__ __forceinline__ float one_minus_exp(float x) { const float p = -x * (1.0f + x * (0.5f + x * (1.0f / 6.0f + x * (1.0f / 24.0f + x * (1.0f / 120.0f + x * (1.0f / 720.0f)))))); return x > -0.25f ? p : 1.0f - fexp(x); }
__device__ __forceinline__ void unpack8(const u32x4 w, float (&f)[8]) { f[0] = bf_lo(w.x); f[1] = bf_hi(w.x); f[2] = bf_lo(w.y); f[3] = bf_hi(w.y); f[4] = bf_lo(w.z); f[5] = bf_hi(w.z); f[6] = bf_lo(w.w); f[7] = bf_hi(w.w); }
__device__ __forceinline__ u32x4 pack8(const float (&f)[8]) { u32x4 w; w.x = pk2(f[0], f[1]); w.y = pk2(f[2], f[3]); w.z = pk2(f[4], f[5]); w.w = pk2(f[6], f[7]); return w; }
__device__ __forceinline__ bf16x8 as_frag(const u32x4 w) { return __builtin_bit_cast(bf16x8, w); }
__device__ __forceinline__ bf16x8 frag_from_acc(const f32x16& a, int s8) { u32x4 w; w.x = pk2(a[s8 + 0], a[s8 + 1]); w.y = pk2(a[s8 + 2], a[s8 + 3]); w.z = pk2(a[s8 + 4], a[s8 + 5]); w.w = pk2(a[s8 + 6], a[s8 + 7]); return as_frag(w); }
__device__ __forceinline__ float wave_sum(float v) { return xsum32(sum32(v)); }
#define XB_TMO      128
#define XB_XCNT(j)  (256  + 64 * (j))
#define XB_XSUB(j)  (1280 + 64 * (j))
#define XB_XGEN(j)  (2304 + 64 * (j))
#define XB_TOP      3328
#define XB_TOPGEN   3392
#define XCD_BAR_WORDS 3456
#define XB_SPIN_CAP (1u << 18)

__device__ __forceinline__ unsigned xb_ld(unsigned* p)              { return __hip_atomic_load(p, __ATOMIC_RELAXED, __HIP_MEMORY_SCOPE_AGENT); }
__device__ __forceinline__ unsigned xb_add(unsigned* p, unsigned v) { return __hip_atomic_fetch_add(p, v, __ATOMIC_RELAXED, __HIP_MEMORY_SCOPE_AGENT); }
__device__ __forceinline__ unsigned xb_xcc_id() { return (unsigned)__builtin_amdgcn_s_getreg((3 << 11) | 20) & 0xFu; }
#define XB_SPIN(cond, bar) do { unsigned _sp = 0; while (cond) { __builtin_amdgcn_s_sleep(1); \
    if ((++_sp & 255u) == 0u) { if (xb_ld(&(bar)[XB_TMO])) break; if (_sp > XB_SPIN_CAP) { atomicAdd(&(bar)[XB_TMO], 1u); break; } } } } while (0)

struct XcdBarrier {
    unsigned* bar; unsigned x;
    volatile LAS unsigned* st;
};

__device__ __forceinline__ XcdBarrier xcd_barrier_post(unsigned* bar, volatile LAS unsigned* st) {
    XcdBarrier b; b.bar = bar; b.x = xb_xcc_id(); b.st = st;
    if (threadIdx.x == 0) (void)xb_add(&bar[XB_XCNT(b.x)], 1u);
    return b;
}
__device__ __forceinline__ void xcd_barrier_complete(unsigned* bar, unsigned x, unsigned& nloc, unsigned& nx) {
    const unsigned G = gridDim.x * gridDim.y * gridDim.z;
    unsigned sum, cnt, mine, sp = 0u;
    for (;;) {
        sum = 0u; cnt = 0u; mine = 0u;
#pragma unroll
        for (unsigned j = 0; j < 16; ++j) { const unsigned c = xb_ld(&bar[XB_XCNT(j)]); sum += c; cnt += (c > 0u) ? 1u : 0u; mine = (j == x) ? c : mine; }
        if (sum == G) break;
        __builtin_amdgcn_s_sleep(1);
        if ((++sp & 255u) == 0u) { if (xb_ld(&bar[XB_TMO])) break; if (sp > XB_SPIN_CAP) { atomicAdd(&bar[XB_TMO], 1u); break; } }
    }
    nloc = mine > 0u ? mine : 1u; nx = cnt > 0u ? cnt : 1u;
}

__device__ __forceinline__ void xcd_barrier(const XcdBarrier& b) {
    asm volatile("s_waitcnt vmcnt(0)" ::: "memory");
    __syncthreads();
    if (threadIdx.x == 0) {
        unsigned* bar = b.bar;
        __builtin_amdgcn_s_waitcnt(0);
        unsigned nloc = b.st[0], nx = b.st[1];
        if (nloc == 0u) { xcd_barrier_complete(bar, b.x, nloc, nx); b.st[0] = nloc; b.st[1] = nx; }
        const unsigned old = xb_add(&bar[XB_XSUB(b.x)], 1u);
        const unsigned gen = old / nloc;
        if (old + 1u == (gen + 1u) * nloc) {
            __builtin_amdgcn_fence(__ATOMIC_RELEASE, "agent");
            asm volatile("s_waitcnt vmcnt(0)" ::: "memory");
            const unsigned og = xb_add(&bar[XB_TOP], 1u);
            const unsigned tg = og / nx;
            if (og + 1u == (tg + 1u) * nx) xb_add(&bar[XB_TOPGEN], 1u);
            else XB_SPIN(xb_ld(&bar[XB_TOPGEN]) == tg, bar);
            __builtin_amdgcn_fence(__ATOMIC_ACQUIRE, "agent");
            xb_add(&bar[XB_XGEN(b.x)], 1u);
            asm volatile("s_waitcnt vmcnt(0)" ::: "memory");
        } else {
            XB_SPIN(xb_ld(&bar[XB_XGEN(b.x)]) == gen, bar);
            __builtin_amdgcn_fence(__ATOMIC_ACQUIRE, "agent");
            asm volatile("s_waitcnt vmcnt(0)" ::: "memory");
        }
    }
    __syncthreads();
}
template <int S8> __device__ __forceinline__ bf16x8 frag_acc(const f32x16& a) { u32x4 w; w.x = pk2(a[S8 + 0], a[S8 + 1]); w.y = pk2(a[S8 + 2], a[S8 + 3]); w.z = pk2(a[S8 + 4], a[S8 + 5]); w.w = pk2(a[S8 + 6], a[S8 + 7]); return as_frag(w); }

struct Args { const float* in[23]; float* out; unsigned char* ws; };
typedef __attribute__((address_space(4))) const Args CArgs;
__device__ __forceinline__ CArgs* get_args() { CArgs* p = (CArgs*)__builtin_amdgcn_kernarg_segment_ptr(); asm volatile("" : "+s"(p)); return p; }
enum { I_X = 0, I_NORM_G, I_W_IN, I_A_CONV_W, I_A_CONV_B, I_A_LN_G, I_A_LN_B, I_A_PW, I_B_Q_G, I_B_K_G, I_B_SINKS, I_REL_BIAS, I_C_CONV_W, I_C_CONV_B, I_C_W_R, I_C_B_R, I_C_W_I, I_C_B_I, I_C_LAMBDA, I_D_W_UP, I_D_B_UP, I_D_NORM_G, I_W_OUT };
struct Frame { LAS unsigned char* lds; volatile LAS unsigned* MISC; int tid, lane, wave, G; };
#define WSP(T, off) ((T*)(A->ws + (off)))

template <bool REMAP>
__device__ __forceinline__ void transpose_item(const float* W, int ldw, const float* gk, bf16_t* WT, int ldt, int k0, int n0, LAS float* scr, int lane) {
    const int nn = n0 + (lane & 31); const int col = REMAP ? win_remap(nn) : nn, colc = col < 0 ? 0 : col;
    const float* wp = W + (size_t)(k0 + (lane >> 5)) * ldw + colc;
    float v[32];
#pragma unroll
    for (int i = 0; i < 32; ++i) v[i] = wp[(size_t)(2 * i) * ldw];
    const int c = lane & 7;
    f32x4 g0 = (f32x4){1.f, 1.f, 1.f, 1.f}, g1 = g0; if (gk) { g0 = *(const f32x4*)(gk + k0 + 8 * c); g1 = *(const f32x4*)(gk + k0 + 8 * c + 4); }
#pragma unroll
    for (int i = 0; i < 32; ++i) scr[(2 * i + (lane >> 5)) * 33 + (lane & 31)] = col < 0 ? 0.f : v[i];
    LDS_WAIT(); asm volatile("" ::: "memory");
#pragma unroll
    for (int j = 0; j < 4; ++j) { const int n = (lane >> 3) + 8 * j; const LAS float* s = scr + (8 * c) * 33 + n;
        u32x4 o; o.x = pk2(s[0 * 33] * g0.x, s[1 * 33] * g0.y); o.y = pk2(s[2 * 33] * g0.z, s[3 * 33] * g0.w); o.z = pk2(s[4 * 33] * g1.x, s[5 * 33] * g1.y); o.w = pk2(s[6 * 33] * g1.z, s[7 * 33] * g1.w);
        *(u32x4*)(WT + (size_t)(n0 + n) * ldt + k0 + 8 * c) = o; }
    LDS_WAIT(); asm volatile("" ::: "memory");
}
constexpr int I_IN = 16 * 96, I_OUT = 16 * 32, I_PW = 4 * 8, I_G = 4 * 2, I_L = I_IN + I_OUT + I_PW + 2 * I_G;
__device__ __forceinline__ void convert_item(Frame& F, int l, int r) {
    CArgs* A = get_args(); const float* norm_g = A->in[I_NORM_G]; const float* w_in = A->in[I_W_IN]; const float* a_pw = A->in[I_A_PW]; const float* c_w_r = A->in[I_C_W_R]; const float* c_w_i = A->in[I_C_W_I]; const float* w_out = A->in[I_W_OUT];
    bf16_t* WtIn = WSP(bf16_t, WS_WIN); bf16_t* WtOut = WSP(bf16_t, WS_WOUT); bf16_t* ApwT = WSP(bf16_t, WS_APW); bf16_t* WrT = WSP(bf16_t, WS_WR); bf16_t* WiT = WSP(bf16_t, WS_WI);
    LAS float* scr = (LAS float*)(F.lds + F.wave * 16384);
    if (r < I_IN) { const int kb = r / 96, nb = r % 96; transpose_item<true>(w_in + (size_t)l * DM * NIN, NIN, norm_g + l * DM, WtIn + (size_t)l * NP * DM, DM, 64 * kb, 32 * nb, scr, F.lane); return; } r -= I_IN;
    if (r < I_OUT) { const int kb = r / 32, nb = r % 32; transpose_item<false>(w_out + (size_t)l * DM * DM, DM, nullptr, WtOut + (size_t)l * DM * DM, DM, 64 * kb, 32 * nb, scr, F.lane); return; } r -= I_OUT;
    if (r < I_PW) { const int kb = r / 8, nb = r % 8; transpose_item<false>(a_pw + (size_t)l * 65536, 256, nullptr, ApwT + (size_t)l * 65536, 256, 64 * kb, 32 * nb, scr, F.lane); return; } r -= I_PW;
    if (r < I_G) { const int blk = r / 2, nb = r % 2; transpose_item<false>(c_w_r + (size_t)(l * 4 + blk) * 4096, 64, nullptr, WrT + (size_t)(l * 4 + blk) * 4096, 64, 0, 32 * nb, scr, F.lane); return; } r -= I_G;
    { const int blk = r / 2, nb = r % 2; transpose_item<false>(c_w_i + (size_t)(l * 4 + blk) * 4096, 64, nullptr, WiT + (size_t)(l * 4 + blk) * 4096, 64, 0, 32 * nb, scr, F.lane); }
}
__device__ __forceinline__ void p0_prologue(Frame& F) {
    CArgs* A = get_args(); const float* x = A->in[I_X]; bf16_t* XB = WSP(bf16_t, WS_XB); float* SSQ = WSP(float, WS_SSQ);
    const int gw = blockIdx.x * NWAVES + F.wave, NGW = F.G * NWAVES;
    for (int it = gw; it < I_L; it += NGW) convert_item(F, 0, it);
    { const float* rel_bias = A->in[I_REL_BIAS]; float* BT = WSP(float, WS_BIAS);
      for (int i = gw * 64 + F.lane; i < 4 * 5 * 16 * 64; i += NGW * 64) { const int e = i & 3, ln = (i >> 2) & 63, q4 = (i >> 8) & 3, kt = (i >> 10) % 5, hd = (i >> 10) / 5;
          const int dist = (ln & 31) - (e + 8 * q4) - 4 * (ln >> 5) + 128 - 32 * kt; float v = -INFINITY;
          if (dist >= 0 && dist < 128) { int bucket = dist; if (dist >= 16) { bucket = 16 + (int)(logf((float)dist / 16.0f) / 2.0794415416798357f * 16.0f); bucket = bucket < 31 ? bucket : 31; } v = rel_bias[bucket * 4 + hd]; }
          BT[i] = v; } }
    for (int m = gw; m < M; m += 2 * NGW) {
        const f32x4* xr0 = (const f32x4*)(x + (size_t)m * DM) + F.lane; const int m1 = (m + NGW < M) ? m + NGW : m; const f32x4* xr1 = (const f32x4*)(x + (size_t)m1 * DM) + F.lane; f32x4 v0[4], v1[4]; float s0 = 0.f, s1 = 0.f;
#pragma unroll
        for (int j = 0; j < 4; ++j) { v0[j] = xr0[64 * j]; v1[j] = xr1[64 * j]; }
#pragma unroll
        for (int j = 0; j < 4; ++j) { s0 += (v0[j].x * v0[j].x + v0[j].y * v0[j].y) + (v0[j].z * v0[j].z + v0[j].w * v0[j].w); s1 += (v1[j].x * v1[j].x + v1[j].y * v1[j].y) + (v1[j].z * v1[j].z + v1[j].w * v1[j].w); }
        s0 = wave_sum(s0); s1 = wave_sum(s1);
        u32x2* o0 = (u32x2*)(XB + (size_t)m * DM) + F.lane; u32x2* o1 = (u32x2*)(XB + (size_t)m1 * DM) + F.lane;
#pragma unroll
        for (int j = 0; j < 4; ++j) { u32x2 w; w.x = pk2(v0[j].x, v0[j].y); w.y = pk2(v0[j].z, v0[j].w); o0[64 * j] = w; w.x = pk2(v1[j].x, v1[j].y); w.y = pk2(v1[j].z, v1[j].w); o1[64 * j] = w; }
        if (F.lane < 16) { SSQ[(size_t)m * 16 + F.lane] = (F.lane == 0) ? s0 : 0.f; SSQ[(size_t)m1 * 16 + F.lane] = (F.lane == 0) ? s1 : 0.f; }
    }
}

constexpr int A_TA = 64, A_ROWS = A_TA + 30, A_S_OFF = A_ROWS * 512, A_S_STRIDE = 528;
__device__ __forceinline__ void mixer_a(Frame& F, int l, int unit) {
    CArgs* A = get_args(); const float* a_conv_w = A->in[I_A_CONV_W]; const float* a_conv_b = A->in[I_A_CONV_B]; const float* a_ln_g = A->in[I_A_LN_G]; const float* a_ln_b = A->in[I_A_LN_B]; bf16_t* ApwT = WSP(bf16_t, WS_APW); bf16_t* Y = WSP(bf16_t, WS_Y); bf16_t* PROJ = WSP(bf16_t, WS_PROJ);
    LAS unsigned char* lds = F.lds; const int tid = F.tid, lane = F.lane, w = F.wave;
    const int b = unit >> 6, t0 = (unit & 63) * A_TA; const size_t m0 = (size_t)b * SEQ + t0;
    const int pA = tid & 127, tgA = tid >> 7, c0A = 2 * pA;
    float w0[31], w1[31];
#pragma unroll
    for (int j = 0; j < 31; ++j) { const f32x2 ww = *(const f32x2*)(a_conv_w + ((size_t)l * 31 + j) * 256 + c0A); w0[j] = ww.x; w1[j] = ww.y; }
    const f32x2 cb = *(const f32x2*)(a_conv_b + l * 256 + c0A), lg = *(const f32x2*)(a_ln_g + l * 256 + c0A), lb = *(const f32x2*)(a_ln_b + l * 256 + c0A);
    { u32x4 vw[6], gw[6];
#pragma unroll
      for (int k = 0; k < 6; ++k) { const int it = tid + k * NTHR, itc = it < A_ROWS * 32 ? it : A_ROWS * 32 - 1, r = itc >> 5, p = itc & 31, tok = t0 + r - 30, tokc = tok < 0 ? 0 : tok;
          const bf16_t* rp = PROJ + ((size_t)b * SEQ + tokc) * NP + 8 * p; vw[k] = *(const u32x4*)(rp + PC_AVAL); gw[k] = *(const u32x4*)(rp + PC_AGLU); }
#pragma unroll
      for (int k = 0; k < 6; ++k) { const int it = tid + k * NTHR, r = it >> 5, p = it & 31, tok = t0 + r - 30;
          float v[8], g[8]; unpack8(vw[k], v); unpack8(gw[k], g);
#pragma unroll
          for (int j = 0; j < 8; ++j) v[j] = tok < 0 ? 0.f : v[j] * sigm(g[j]);
          if (it < A_ROWS * 32) *(LAS u32x4*)(lds + r * 512 + p * 16) = pack8(v); } }
    __syncthreads();
    bf16x8 af[16];
    { const bf16_t* ap = ApwT + (size_t)l * 65536 + (size_t)(32 * w + (lane & 31)) * 256 + 8 * (lane >> 5);
#pragma unroll
      for (int ks = 0; ks < 16; ++ks) af[ks] = *(const bf16x8*)(ap + 16 * ks); }
    { const int p = pA, tg = tgA;
#pragma unroll 1
      for (int blk = 0; blk < 2; ++blk) { const int base = 16 * tg + 8 * blk;
        f32x2 in[38];
#pragma unroll
        for (int i = 0; i < 38; ++i) { const unsigned wv = *(const LAS unsigned*)(lds + (base + i) * 512 + p * 4); in[i] = (f32x2){bf_lo(wv), bf_hi(wv)}; }
        f32x2 acc[8];
#pragma unroll
        for (int o = 0; o < 8; ++o) acc[o] = cb;
#pragma unroll
        for (int j = 0; j < 31; ++j) { const f32x2 wj = {w0[j], w1[j]};
#pragma unroll
            for (int o = 0; o < 8; ++o) acc[o] = __builtin_elementwise_fma(wj, in[o + j], acc[o]); }
        float sv[8], qv[8];
#pragma unroll
        for (int o = 0; o < 8; ++o) { sv[o] = acc[o].x + acc[o].y; qv[o] = acc[o].x * acc[o].x + acc[o].y * acc[o].y; }
#pragma unroll
        for (int o = 0; o < 8; ++o) { sv[o] = sum32(sv[o]); qv[o] = sum32(qv[o]); }
#pragma unroll
        for (int o = 0; o < 8; ++o) { const float mean = sv[o] * (1.f / 64.f), var = fmaxf(qv[o] * (1.f / 64.f) - mean * mean, 0.f), rstd = rsq(var + EPS);
            const float v0 = (acc[o].x - mean) * rstd * lg.x + lb.x, v1 = (acc[o].y - mean) * rstd * lg.y + lb.y;
            *(LAS unsigned*)(lds + A_S_OFF + (base + o) * A_S_STRIDE + p * 4) = pk2(silu(v0), silu(v1)); } } }
    __syncthreads();
    { const int r = lane & 31, h = lane >> 5;
      u32x2 gwA[2][4];
#pragma unroll
      for (int tt = 0; tt < 2; ++tt)
#pragma unroll
          for (int g4 = 0; g4 < 4; ++g4) gwA[tt][g4] = *(const u32x2*)(PROJ + (m0 + 32 * tt + r) * NP + PC_AGATE + 32 * w + 8 * g4 + 4 * h);
      f32x16 acc[2];
#pragma unroll
      for (int tt = 0; tt < 2; ++tt) { acc[tt] = (f32x16)(0.f);
#pragma unroll
          for (int ks = 0; ks < 16; ++ks) { const bf16x8 bfr = *(const LAS bf16x8*)(lds + A_S_OFF + (32 * tt + r) * A_S_STRIDE + (16 * ks + 8 * h) * 2); acc[tt] = MFMA32(af[ks], bfr, acc[tt]); } }
#pragma unroll
      for (int tt = 0; tt < 2; ++tt) { const size_t tok = m0 + 32 * tt + r;
#pragma unroll
          for (int g4 = 0; g4 < 4; ++g4) { const int n = 32 * w + 8 * g4 + 4 * h; const u32x2 gw = gwA[tt][g4];
              u32x2 o; o.x = pk2(acc[tt][4 * g4 + 0] * silu(bf_lo(gw.x)), acc[tt][4 * g4 + 1] * silu(bf_hi(gw.x))); o.y = pk2(acc[tt][4 * g4 + 2] * silu(bf_lo(gw.y)), acc[tt][4 * g4 + 3] * silu(bf_hi(gw.y)));
              *(u32x2*)(Y + tok * DM + n) = o; } } }
    __syncthreads();
}

typedef short s16x4 __attribute__((ext_vector_type(4)));
__device__ __forceinline__ u32x2 tr_read4(const LAS unsigned char* p) { const s16x4 v = __builtin_amdgcn_ds_read_tr16_b64_v4i16((LAS s16x4*)p); return __builtin_bit_cast(u32x2, v); }
constexpr int B_VT_OFF = 256 * 144;
__device__ __forceinline__ void mixer_b(Frame& F, int l, int unit) {
    CArgs* A = get_args(); const float* b_q_g = A->in[I_B_Q_G]; const float* b_k_g = A->in[I_B_K_G]; const float* b_sinks = A->in[I_B_SINKS]; bf16_t* Y = WSP(bf16_t, WS_Y); bf16_t* PROJ = WSP(bf16_t, WS_PROJ);
    LAS unsigned char* lds = F.lds; const int tid = F.tid, lane = F.lane, w = F.wave;
    const int b = unit >> 6, qb = (unit >> 1) & 31, kvh = unit & 1, t0 = qb * 128;
    { float kg[8]; const int pc = tid & 7;
#pragma unroll
      for (int j = 0; j < 8; ++j) kg[j] = b_k_g[l * 64 + 8 * pc + j];
#pragma unroll
      for (int it = 0; it < 4; ++it) { const int i = it * NTHR + tid, key = i >> 3, tok = t0 - 128 + key; u32x4 kw = (u32x4){0u, 0u, 0u, 0u}, vw = kw;
        { const int tokc = tok < 0 ? 0 : tok; const bf16_t* rp = PROJ + ((size_t)b * SEQ + tokc) * NP + kvh * 64 + 8 * pc; kw = *(const u32x4*)(rp + PC_BK); vw = *(const u32x4*)(rp + PC_BV);
          if (tok < 0) { kw = (u32x4){0u, 0u, 0u, 0u}; vw = kw; } }
        float kf[8]; unpack8(kw, kf); float ss = 0.f;
#pragma unroll
        for (int j = 0; j < 8; ++j) ss = fmaf(kf[j], kf[j], ss);
        ss = sum8(ss);
        const float rs = rsq(ss * (1.f / 64.f) + EPS);
#pragma unroll
        for (int j = 0; j < 8; ++j) kf[j] = kf[j] * rs * kg[j];
        *(LAS u32x4*)(lds + key * 144 + pc * 16) = pack8(kf);
        *(LAS u32x4*)(lds + B_VT_OFF + key * 144 + pc * 16) = vw; } }
    const int g = w >> 2, s = w & 3, head = 2 * kvh + g, r = lane & 31, h = lane >> 5;
    const size_t tokq = (size_t)b * SEQ + t0 + 32 * s + r;
    bf16x8 qf[4];
    { float q[32]; const bf16_t* qrow = PROJ + tokq * NP + PC_BQ + head * 64 + 8 * h; float ss = 0.f;
#pragma unroll
      for (int ks = 0; ks < 4; ++ks) { const u32x4 wv = *(const u32x4*)(qrow + 16 * ks); float t8[8]; unpack8(wv, t8);
#pragma unroll
          for (int j = 0; j < 8; ++j) { q[8 * ks + j] = t8[j]; ss = fmaf(t8[j], t8[j], ss); } }
      ss = xsum32(ss);
      const float rs = rsq(ss * (1.f / 64.f) + EPS) * 0.125f;
#pragma unroll
      for (int ks = 0; ks < 4; ++ks) { float t8[8];
#pragma unroll
          for (int j = 0; j < 8; ++j) t8[j] = q[8 * ks + j] * rs * b_q_g[l * 64 + 16 * ks + 8 * h + j];
          qf[ks] = as_frag(pack8(t8)); } }
    u32x2 gwB[2][4];
#pragma unroll
    for (int et = 0; et < 2; ++et)
#pragma unroll
        for (int g4 = 0; g4 < 4; ++g4) gwB[et][g4] = *(const u32x2*)(PROJ + tokq * NP + PC_BGATE + head * 64 + 32 * et + 8 * g4 + 4 * h);
    f32x16 S[5];
    { const f32x4* bt = (const f32x4*)(WSP(float, WS_BIAS)) + (size_t)head * 5 * 4 * 64 + lane;
#pragma unroll
      for (int kt = 0; kt < 5; ++kt)
#pragma unroll
          for (int q4 = 0; q4 < 4; ++q4) { const f32x4 v = bt[(kt * 4 + q4) * 64]; S[kt][4 * q4 + 0] = v.x; S[kt][4 * q4 + 1] = v.y; S[kt][4 * q4 + 2] = v.z; S[kt][4 * q4 + 3] = v.w; } }
    __syncthreads();
#pragma unroll
    for (int kt = 0; kt < 5; ++kt) { const int kb = 32 * (s + kt);
#pragma unroll
        for (int ks = 0; ks < 4; ++ks) { const bf16x8 a = *(const LAS bf16x8*)(lds + (kb + r) * 144 + (16 * ks + 8 * h) * 2); S[kt] = MFMA32(a, qf[ks], S[kt]); } }
    const float sink = b_sinks[l * 4 + head]; float mx = sink;
#pragma unroll
    for (int kt = 0; kt < 5; ++kt) { const bool dead = (t0 == 0) && (s + kt < 4);
#pragma unroll
        for (int rg = 0; rg < 16; ++rg) { const float v = dead ? -INFINITY : S[kt][rg]; S[kt][rg] = v; mx = fmaxf(mx, v); } }
    mx = xmax32(mx);
    float sum = 0.f;
#pragma unroll
    for (int kt = 0; kt < 5; ++kt)
#pragma unroll
        for (int rg = 0; rg < 16; ++rg) { const float p = fexp(S[kt][rg] - mx); S[kt][rg] = p; sum += p; }
    sum = xsum32(sum);
    const float inv = 1.0f / (sum + fexp(sink - mx));
    f32x16 O[2]; O[0] = (f32x16)(0.f); O[1] = (f32x16)(0.f);
    const LAS unsigned char* vrbB = lds + B_VT_OFF + ((lane & 15) >> 2) * 144 + (16 * ((lane >> 4) & 1) + 4 * (lane & 3)) * 2;
#define B_PV(kt, SP) do { const bf16x8 pf = frag_acc<8 * SP>(S[kt]); const int kb = 32 * (s + kt) + 16 * SP + 4 * h; \
        _Pragma("unroll") for (int et = 0; et < 2; ++et) { const LAS unsigned char* vp = vrbB + kb * 144 + 64 * et; \
            const u32x2 lo = tr_read4(vp), hi = tr_read4(vp + 8 * 144); O[et] = MFMA32(as_frag((u32x4){lo.x, lo.y, hi.x, hi.y}), pf, O[et]); } } while (0)
#pragma unroll
    for (int kt = 0; kt < 5; ++kt) { B_PV(kt, 0); B_PV(kt, 1); }
#undef B_PV
#pragma unroll
    for (int et = 0; et < 2; ++et)
#pragma unroll
        for (int g4 = 0; g4 < 4; ++g4) { const int d = 32 * et + 8 * g4 + 4 * h; const u32x2 gw = gwB[et][g4];
            u32x2 o; o.x = pk2(O[et][4 * g4 + 0] * inv * silu(bf_lo(gw.x)), O[et][4 * g4 + 1] * inv * silu(bf_hi(gw.x))); o.y = pk2(O[et][4 * g4 + 2] * inv * silu(bf_lo(gw.y)), O[et][4 * g4 + 3] * inv * silu(bf_hi(gw.y)));
            *(u32x2*)(Y + tokq * DM + 256 + head * 64 + d) = o; }
    __syncthreads();
}
constexpr int C_AA = 128 * 144, C_UU = C_AA + 64 * 129 * 4, C_SEG = C_UU + 64 * 129 * 4, C_CARRY = C_SEG + 4096, C_CST = C_CARRY + 512, C_LOOK = C_CST + 1024;
constexpr unsigned SPIN_CAP = 1u << 16;
__device__ __forceinline__ void gr_store(unsigned long long* g, unsigned tag, float v) { __hip_atomic_store(g, ((unsigned long long)tag << 32) | (unsigned long long)__float_as_uint(v), __ATOMIC_RELAXED, __HIP_MEMORY_SCOPE_AGENT); }
__device__ __forceinline__ unsigned long long gr_load(const unsigned long long* g) { return __hip_atomic_load(g, __ATOMIC_RELAXED, __HIP_MEMORY_SCOPE_AGENT); }
__device__ __forceinline__ void mixer_c(Frame& F, int l, int unit, unsigned* qh, unsigned& nxt) {
    CArgs* A = get_args(); const float* c_conv_w = A->in[I_C_CONV_W]; const float* c_conv_b = A->in[I_C_CONV_B]; const float* c_b_r = A->in[I_C_B_R]; const float* c_b_i = A->in[I_C_B_I]; const float* c_lambda = A->in[I_C_LAMBDA]; bf16_t* WrT = WSP(bf16_t, WS_WR); bf16_t* WiT = WSP(bf16_t, WS_WI); bf16_t* Y = WSP(bf16_t, WS_Y); bf16_t* PROJ = WSP(bf16_t, WS_PROJ);
    unsigned long long* GC = WSP(unsigned long long, WS_GC);
    LAS unsigned char* lds = F.lds; const int tid = F.tid, lane = F.lane, w = F.wave;
    const int tile = unit >> 4, b = (unit >> 2) & 3, n = unit & 3, t0 = tile * 128; const unsigned tag = (unsigned)l + 1u;
    LAS float* Aa = (LAS float*)(lds + C_AA); LAS float* Uu = (LAS float*)(lds + C_UU); LAS float* SegX = (LAS float*)(lds + C_SEG); LAS float* Carry = (LAS float*)(lds + C_CARRY); LAS float* Cst = (LAS float*)(lds + C_CST); LAS float* LookY = (LAS float*)(lds + C_LOOK);
    const int pc = tid & 7, trow = tid >> 3;
    const int tt = w & 3, mt = w >> 2, r = lane & 31, h = lane >> 5;
    const int sc = tid & 63, seg = tid >> 6;
    u32x4 gwC[2];
#pragma unroll
    for (int it = 0; it < 2; ++it) gwC[it] = *(const u32x4*)(PROJ + ((size_t)b * SEQ + t0 + trow + 64 * it) * NP + PC_CGATE + 64 * n + 8 * pc);
    if (tid < 64) { const int cg = l * 256 + 64 * n + tid;
        Cst[4 * tid + 0] = c_b_r[cg]; Cst[4 * tid + 1] = c_b_i[cg]; Cst[4 * tid + 2] = -8.0f * log1pf(expf(-c_lambda[cg])); Cst[4 * tid + 3] = 0.f; }
    { float cw[4][8], cb[8];
#pragma unroll
      for (int j = 0; j < 8; ++j) { cb[j] = c_conv_b[l * 256 + 64 * n + 8 * pc + j];
#pragma unroll
          for (int jj = 0; jj < 4; ++jj) cw[jj][j] = c_conv_w[((size_t)l * 4 + jj) * 256 + 64 * n + 8 * pc + j]; }
#pragma unroll
      for (int it = 0; it < 2; ++it) { const int t = trow + 64 * it, tok = t0 + t; float acc[8];
#pragma unroll
          for (int j = 0; j < 8; ++j) acc[j] = cb[j];
#pragma unroll
          for (int jj = 0; jj < 4; ++jj) { const int tk = tok - 3 + jj, tkc = tk < 0 ? 0 : tk;
              const u32x4 wv = *(const u32x4*)(PROJ + ((size_t)b * SEQ + tkc) * NP + PC_CX + 64 * n + 8 * pc); float x8[8]; unpack8(wv, x8); const float m = tk < 0 ? 0.f : 1.f;
#pragma unroll
              for (int j = 0; j < 8; ++j) acc[j] = fmaf(cw[jj][j] * m, x8[j], acc[j]); }
          *(LAS u32x4*)(lds + t * 144 + pc * 16) = pack8(acc); } }
    __syncthreads();
    { bf16x8 wrf[4], wif[4];
#pragma unroll
      for (int ks = 0; ks < 4; ++ks) { const size_t o = ((size_t)(l * 4 + n) * 64 + 32 * mt + r) * 64 + 16 * ks + 8 * h; wrf[ks] = *(const bf16x8*)(WrT + o); wif[ks] = *(const bf16x8*)(WiT + o); }
      f32x16 R = (f32x16)(0.f), I = (f32x16)(0.f);
#pragma unroll
      for (int ks = 0; ks < 4; ++ks) { const bf16x8 bfr = *(const LAS bf16x8*)(lds + (32 * tt + r) * 144 + (16 * ks + 8 * h) * 2); R = MFMA32(wrf[ks], bfr, R); I = MFMA32(wif[ks], bfr, I); }
      const int t = 32 * tt + r;
#pragma unroll
      for (int g4 = 0; g4 < 4; ++g4) { const int c0 = 32 * mt + 8 * g4 + 4 * h; const u32x2 xw = *(const LAS u32x2*)(lds + t * 144 + c0 * 2);
          const float xc[4] = {bf_lo(xw.x), bf_hi(xw.x), bf_lo(xw.y), bf_hi(xw.y)};
#pragma unroll
          for (int j = 0; j < 4; ++j) { const f32x4 cs = *(const LAS f32x4*)(Cst + 4 * (c0 + j));
              const float rr = sigm(R[4 * g4 + j] + cs.x), ii = sigm(I[4 * g4 + j] + cs.y), la = cs.z * rr, a = fexp(la), u = __builtin_amdgcn_sqrtf(fmaxf(one_minus_exp(2.0f * la), 0.f)) * (ii * xc[j]);
              Aa[(c0 + j) * 129 + t] = a; Uu[(c0 + j) * 129 + t] = u; }
          __builtin_amdgcn_sched_barrier(0); } }
    __syncthreads();
    float a[16], u[16];
    { float Ap = 1.f, Hp = 0.f;
#pragma unroll
      for (int i = 0; i < 16; ++i) { a[i] = Aa[sc * 129 + 16 * seg + i]; u[i] = Uu[sc * 129 + 16 * seg + i]; }
#pragma unroll
      for (int i = 0; i < 16; ++i) { Hp = fmaf(a[i], Hp, u[i]); Ap *= a[i]; }
      SegX[(seg * 64 + sc) * 2] = Ap; SegX[(seg * 64 + sc) * 2 + 1] = Hp; }
    __syncthreads();
    { unsigned long long* gbase = GC + ((size_t)((b * 4 + n) * 32) * 128) + 2 * lane;
      if (w == 0) { float At = 1.f, Ht = 0.f;
#pragma unroll
          for (int s2 = 0; s2 < 8; ++s2) { const float As = SegX[(s2 * 64 + lane) * 2], Hs = SegX[(s2 * 64 + lane) * 2 + 1]; Ht = fmaf(As, Ht, Hs); At *= As; }
          gr_store(gbase + (size_t)tile * 128, tag, At); gr_store(gbase + (size_t)tile * 128 + 1, tag, Ht); }
      float Aw = 1.f, Hw = 0.f; const int p0 = 4 * w;
      if (p0 < tile) { unsigned long long ga[4], gh[4]; unsigned spins = 0;
          for (;;) { bool ok = true;
#pragma unroll
              for (int k = 0; k < 4; ++k) { const int p = (p0 + k < tile) ? p0 + k : tile - 1; ga[k] = gr_load(gbase + (size_t)p * 128); gh[k] = gr_load(gbase + (size_t)p * 128 + 1);
                  ok = ok && ((unsigned)(ga[k] >> 32) == tag) && ((unsigned)(gh[k] >> 32) == tag); }
              if (__all(ok) || ++spins > SPIN_CAP) break;
              __builtin_amdgcn_s_sleep(2); }
#pragma unroll
          for (int k = 0; k < 4; ++k) if (p0 + k < tile) { const float Ap = __uint_as_float((unsigned)ga[k]), Hp = __uint_as_float((unsigned)gh[k]); Hw = fmaf(Ap, Hw, Hp); Aw *= Ap; } }
      LookY[(w * 64 + lane) * 2] = Aw; LookY[(w * 64 + lane) * 2 + 1] = Hw; }
    __syncthreads();
    if (tid == 0) nxt = __hip_atomic_fetch_add(qh, 1u, __ATOMIC_RELAXED, __HIP_MEMORY_SCOPE_AGENT);
    { float hh = 0.f;
#pragma unroll
      for (int w2 = 0; w2 < 8; ++w2) hh = fmaf(LookY[(w2 * 64 + sc) * 2], hh, LookY[(w2 * 64 + sc) * 2 + 1]);
      for (int s2 = 0; s2 < seg; ++s2) hh = fmaf(SegX[(s2 * 64 + sc) * 2], hh, SegX[(s2 * 64 + sc) * 2 + 1]);
#pragma unroll
      for (int i = 0; i < 16; ++i) { hh = fmaf(a[i], hh, u[i]); Uu[sc * 129 + 16 * seg + i] = hh; } }
    __syncthreads();
#pragma unroll
    for (int it = 0; it < 2; ++it) { const int t = trow + 64 * it; const size_t tokg = (size_t)b * SEQ + t0 + t;
        float g8[8], y8[8]; unpack8(gwC[it], g8);
#pragma unroll
        for (int j = 0; j < 8; ++j) y8[j] = Uu[(8 * pc + j) * 129 + t] * silu(g8[j]);
        *(u32x4*)(Y + tokg * DM + 512 + 64 * n + 8 * pc) = pack8(y8); }
    __syncthreads();
}


constexpr int D_WAVE = 14464, D_VT = 5120, D_DEC = 14336, D_SST = 8 * D_WAVE, D_SIN = D_SST  , D_PDL = D_SST + 8192;
static_assert(D_PDL + 128 <= RING_BYTES, "mixer D LDS map");
constexpr int GD_STRIDE = 2112;
__device__ __forceinline__ void mixer_d(Frame& F, int l, int unit) {
    CArgs* A = get_args(); const float* d_w_up = A->in[I_D_W_UP]; const float* d_b_up = A->in[I_D_B_UP]; const float* d_norm_g = A->in[I_D_NORM_G]; bf16_t* Y = WSP(bf16_t, WS_Y); bf16_t* PROJ = WSP(bf16_t, WS_PROJ);
    unsigned long long* GD = WSP(unsigned long long, WS_GD);
    const int tid = F.tid, lane = F.lane, w = F.wave;
    const int grp = unit >> 4, b = (unit >> 2) & 3, head = unit & 3, r = lane & 31, h = lane >> 5; const unsigned tag = (unsigned)l + 1u;
    LAS unsigned char* scr = F.lds + w * D_WAVE; LAS unsigned char* VT = scr + D_VT; LAS float* Dec = (LAS float*)(scr + D_DEC); LAS f32x4* Sst = (LAS f32x4*)(F.lds + D_SST); LAS f32x4* Sin = (LAS f32x4*)(F.lds + D_SIN); LAS float* Pdl = (LAS float*)(F.lds + D_PDL);
    bf16x8 wupf; { float t8[8];
#pragma unroll
        for (int j = 0; j < 8; ++j) t8[j] = d_w_up[((size_t)l * 16 + 8 * h + j) * 128 + 32 * head + r];
        wupf = as_frag(pack8(t8)); }
    const float bup = d_b_up[l * 128 + 32 * head + r];
    Sst[tid] = (f32x4){0.f, 0.f, 0.f, 0.f}; if (tid < 32) Pdl[tid] = 1.f;
    __syncthreads();
    const int chunk = 8 * grp + w; const size_t mrow0 = (size_t)b * SEQ + 64 * chunk;
    float qv[32], kv[32], bb[32];
    f32x16 G[2];
#pragma unroll
    for (int tile = 0; tile < 2; ++tile) { const bf16x8 lrf = *(const bf16x8*)(PROJ + (mrow0 + 32 * tile + r) * NP + PC_DLR + 8 * h); G[tile] = MFMA32(lrf, wupf, (f32x16)(0.f)); }
    { const bf16_t* qbase = PROJ + mrow0 * NP + PC_DQ + 32 * head; const unsigned loff = (unsigned)(4 * h * NP + r);
#pragma unroll
      for (int i = 0; i < 32; ++i) { const unsigned o = loff + (unsigned)((32 * (i >> 4) + 8 * ((i >> 2) & 3) + (i & 3)) * NP);
          qv[i] = __uint_as_float((unsigned)qbase[o] << 16); kv[i] = __uint_as_float((unsigned)qbase[o + (PC_DK - PC_DQ)] << 16); } }
    float run = 0.f;
#pragma unroll
    for (int k = 0; k < 8; ++k) { float c[4];
#pragma unroll
        for (int j = 0; j < 4; ++j) { const float z = G[k >> 2][4 * (k & 3) + j] + bup; const float gl = -(fmaxf(-z, 0.f) + log1p_01(fexp(-fabsf(z)))) * (1.f / 16.f); c[j] = (j ? c[j - 1] : 0.f) + gl; }
        const float tot = c[3], ptot = xget32(tot, h); const float pre = run + (h ? ptot : 0.f);
#pragma unroll
        for (int j = 0; j < 4; ++j) bb[4 * k + j] = pre + c[j];
        run += tot + ptot; }
    const float blast = run, dec = fexp(blast);
    if (h == 0) Dec[r] = dec;
#pragma unroll
    for (int i = 0; i < 32; ++i) { const int t = 32 * (i >> 4) + 8 * ((i >> 2) & 3) + 4 * h + (i & 3); *(LAS bf16_t*)(scr + t * 80 + r * 2) = (bf16_t)f2bf(qv[i] * 0.17677669529663687f * fexp(bb[i])); }
    __builtin_amdgcn_wave_barrier(); asm volatile("" ::: "memory");
    bf16x8 qB[2][2], qP[2][2];
#pragma unroll
    for (int it = 0; it < 2; ++it)
#pragma unroll
        for (int ks = 0; ks < 2; ++ks) { const LAS unsigned char* p = scr + (32 * it + r) * 80; qB[it][ks] = *(const LAS bf16x8*)(p + (16 * ks + 8 * h) * 2);
            const u32x2 lo = *(const LAS u32x2*)(p + (16 * ks + 4 * h) * 2), hi = *(const LAS u32x2*)(p + (16 * ks + 8 + 4 * h) * 2); qP[it][ks] = as_frag((u32x4){lo.x, lo.y, hi.x, hi.y}); }
    __builtin_amdgcn_wave_barrier(); asm volatile("" ::: "memory");
#pragma unroll
    for (int i = 0; i < 32; ++i) { const int t = 32 * (i >> 4) + 8 * ((i >> 2) & 3) + 4 * h + (i & 3); *(LAS bf16_t*)(scr + t * 80 + r * 2) = (bf16_t)f2bf(kv[i] * fexp(-bb[i])); }
    __builtin_amdgcn_wave_barrier(); asm volatile("" ::: "memory");
    bf16x8 kA[2][2];
#pragma unroll
    for (int jt = 0; jt < 2; ++jt)
#pragma unroll
        for (int ks = 0; ks < 2; ++ks) kA[jt][ks] = *(const LAS bf16x8*)(scr + (32 * jt + r) * 80 + (16 * ks + 8 * h) * 2);
    __builtin_amdgcn_wave_barrier(); asm volatile("" ::: "memory");
#pragma unroll
    for (int k = 0; k < 8; ++k) { const int t = 32 * (k >> 2) + 8 * (k & 3) + 4 * h; u32x2 o;
        o.x = pk2(kv[4 * k + 0] * fexp(blast - bb[4 * k + 0]), kv[4 * k + 1] * fexp(blast - bb[4 * k + 1])); o.y = pk2(kv[4 * k + 2] * fexp(blast - bb[4 * k + 2]), kv[4 * k + 3] * fexp(blast - bb[4 * k + 3]));
        *(LAS u32x2*)(scr + r * 144 + t * 2) = o; }
    __builtin_amdgcn_wave_barrier(); asm volatile("" ::: "memory");
    bf16x8 keA[4];
#pragma unroll
    for (int ks = 0; ks < 4; ++ks) keA[ks] = *(const LAS bf16x8*)(scr + r * 144 + (16 * ks + 8 * h) * 2);
#pragma unroll
    for (int i8 = 0; i8 < 8; ++i8) { const int tv = 8 * i8 + (lane >> 3), pc = lane & 7; const u32x4 vw = *(const u32x4*)(PROJ + (mrow0 + tv) * NP + PC_DV + 64 * head + 8 * pc);
        *(LAS u32x4*)(VT + tv * 144 + pc * 16) = vw; }
    const LAS unsigned char* vrb = VT + ((lane & 15) >> 2) * 144 + (16 * ((lane >> 4) & 1) + 4 * (lane & 3)) * 2;
    __builtin_amdgcn_wave_barrier(); asm volatile("" ::: "memory");
    bf16x8 P[3][2];
#define D_ATT(idx, jt, it) do { f32x16 acc = (f32x16)(0.f); acc = MFMA32(kA[jt][0], qB[it][0], acc); acc = MFMA32(kA[jt][1], qB[it][1], acc); \
    if (jt == it) { const int rr = r - 4 * h; _Pragma("unroll") for (int rg = 0; rg < 16; ++rg) { acc[rg] = (rr < (rg & 3) + 8 * (rg >> 2)) ? 0.f : acc[rg]; } } \
    P[idx][0] = frag_acc<0>(acc); P[idx][1] = frag_acc<8>(acc); } while (0)
    D_ATT(0, 0, 0); __builtin_amdgcn_sched_barrier(0); D_ATT(1, 0, 1); __builtin_amdgcn_sched_barrier(0); D_ATT(2, 1, 1); __builtin_amdgcn_sched_barrier(0);
#undef D_ATT
    f32x16 ds[2];
#pragma unroll
    for (int et = 0; et < 2; ++et) { ds[et] = (f32x16)(0.f);
#pragma unroll
        for (int ks = 0; ks < 4; ++ks) { const LAS unsigned char* vp = vrb + (16 * ks + 8 * h) * 144 + 64 * et; const u32x2 lo = tr_read4(vp), hi = tr_read4(vp + 4 * 144);
            ds[et] = MFMA32(keA[ks], as_frag((u32x4){lo.x, lo.y, hi.x, hi.y}), ds[et]); } }
    f32x16 L[2]; float pdv[16], dv[16];
#pragma unroll
    for (int q4 = 0; q4 < 4; ++q4) { const f32x4 v = *(const LAS f32x4*)(Dec + 8 * q4 + 4 * h); dv[4 * q4 + 0] = v.x; dv[4 * q4 + 1] = v.y; dv[4 * q4 + 2] = v.z; dv[4 * q4 + 3] = v.w; }
#pragma unroll 1
    for (int step = 0; step < 8; ++step) {
        if (w == step) {
#pragma unroll
            for (int q4 = 0; q4 < 4; ++q4) { const f32x4 v = *(const LAS f32x4*)(Pdl + 8 * q4 + 4 * h); pdv[4 * q4 + 0] = v.x; pdv[4 * q4 + 1] = v.y; pdv[4 * q4 + 2] = v.z; pdv[4 * q4 + 3] = v.w; }
#pragma unroll
            for (int et = 0; et < 2; ++et)
#pragma unroll
                for (int q4 = 0; q4 < 4; ++q4) { const f32x4 v = Sst[(et * 4 + q4) * 64 + lane]; L[et][4 * q4 + 0] = v.x; L[et][4 * q4 + 1] = v.y; L[et][4 * q4 + 2] = v.z; L[et][4 * q4 + 3] = v.w;
                    f32x4 nv; nv.x = fmaf(v.x, dv[4 * q4 + 0], ds[et][4 * q4 + 0]); nv.y = fmaf(v.y, dv[4 * q4 + 1], ds[et][4 * q4 + 1]); nv.z = fmaf(v.z, dv[4 * q4 + 2], ds[et][4 * q4 + 2]); nv.w = fmaf(v.w, dv[4 * q4 + 3], ds[et][4 * q4 + 3]);
                    Sst[(et * 4 + q4) * 64 + lane] = nv; }
            if (lane < 32) Pdl[lane] = Pdl[lane] * Dec[lane]; }
        __syncthreads(); }
    { unsigned long long* gmine = GD + (size_t)((b * 4 + head) * 8 + grp) * GD_STRIDE; const f32x4 sv = Sst[tid];
      gr_store(gmine + 4 * tid + 0, tag, sv.x); gr_store(gmine + 4 * tid + 1, tag, sv.y); gr_store(gmine + 4 * tid + 2, tag, sv.z); gr_store(gmine + 4 * tid + 3, tag, sv.w);
      if (tid < 32) gr_store(gmine + 2048 + tid, tag, Pdl[tid]);
      f32x4 sin = (f32x4){0.f, 0.f, 0.f, 0.f}; const int d0 = 8 * ((tid >> 6) & 3) + 4 * ((tid >> 5) & 1);
      const unsigned long long* gb = GD + (size_t)((b * 4 + head) * 8) * GD_STRIDE;
      for (int p0 = 0; p0 < grp; p0 += 4) { unsigned long long gs[4][4], gd[4][4]; unsigned spins = 0;
          for (;;) { bool ok = true;
#pragma unroll
              for (int k = 0; k < 4; ++k) { const int p = (p0 + k < grp) ? p0 + k : grp - 1; const unsigned long long* gp = gb + (size_t)p * GD_STRIDE;
#pragma unroll
                  for (int e = 0; e < 4; ++e) { gs[k][e] = gr_load(gp + 4 * tid + e); gd[k][e] = gr_load(gp + 2048 + d0 + e); ok = ok && ((unsigned)(gs[k][e] >> 32) == tag) && ((unsigned)(gd[k][e] >> 32) == tag); } }
              if (__all(ok) || ++spins > SPIN_CAP) break;
              __builtin_amdgcn_s_sleep(2); }
#pragma unroll
          for (int k = 0; k < 4; ++k) if (p0 + k < grp) {
              sin.x = fmaf(sin.x, __uint_as_float((unsigned)gd[k][0]), __uint_as_float((unsigned)gs[k][0])); sin.y = fmaf(sin.y, __uint_as_float((unsigned)gd[k][1]), __uint_as_float((unsigned)gs[k][1]));
              sin.z = fmaf(sin.z, __uint_as_float((unsigned)gd[k][2]), __uint_as_float((unsigned)gs[k][2])); sin.w = fmaf(sin.w, __uint_as_float((unsigned)gd[k][3]), __uint_as_float((unsigned)gs[k][3])); } }
      Sin[tid] = sin; }
    __syncthreads();
    bf16x8 SA[2][2];
#pragma unroll
    for (int et = 0; et < 2; ++et) {
#pragma unroll
        for (int q4 = 0; q4 < 4; ++q4) { const f32x4 v = Sin[(et * 4 + q4) * 64 + lane]; L[et][4 * q4 + 0] = fmaf(pdv[4 * q4 + 0], v.x, L[et][4 * q4 + 0]); L[et][4 * q4 + 1] = fmaf(pdv[4 * q4 + 1], v.y, L[et][4 * q4 + 1]);
            L[et][4 * q4 + 2] = fmaf(pdv[4 * q4 + 2], v.z, L[et][4 * q4 + 2]); L[et][4 * q4 + 3] = fmaf(pdv[4 * q4 + 3], v.w, L[et][4 * q4 + 3]); }
        SA[et][0] = frag_acc<0>(L[et]); SA[et][1] = frag_acc<8>(L[et]); }
#pragma unroll
    for (int it = 0; it < 2; ++it) { f32x16 o[2]; o[0] = (f32x16)(0.f); o[1] = (f32x16)(0.f);
#pragma unroll
        for (int jt = 0; jt <= it; ++jt) { const int idx = (jt == 0) ? it : 2;
#pragma unroll
            for (int sp = 0; sp < 2; ++sp)
#pragma unroll
                for (int et = 0; et < 2; ++et) { const LAS unsigned char* vp = vrb + (32 * jt + 16 * sp + 4 * h) * 144 + 64 * et; const u32x2 lo = tr_read4(vp), hi = tr_read4(vp + 8 * 144);
                    o[et] = MFMA32(as_frag((u32x4){lo.x, lo.y, hi.x, hi.y}), P[idx][sp], o[et]); } }
#pragma unroll
        for (int ks = 0; ks < 2; ++ks)
#pragma unroll
            for (int et = 0; et < 2; ++et) o[et] = MFMA32(SA[et][ks], qP[it][ks], o[et]);
        float ss = 0.f;
#pragma unroll
        for (int et = 0; et < 2; ++et)
#pragma unroll
            for (int rg = 0; rg < 16; ++rg) ss = fmaf(o[et][rg], o[et][rg], ss);
        ss = xsum32(ss);
        const float rstd = rsq(ss * (1.f / 64.f) + EPS); const size_t tok = mrow0 + 32 * it + r;
#pragma unroll
        for (int et = 0; et < 2; ++et)
#pragma unroll
            for (int g4 = 0; g4 < 4; ++g4) { const int e = 32 * et + 8 * g4 + 4 * h; const f32x4 ng = *(const f32x4*)(d_norm_g + l * 64 + e); const u32x2 gw = *(const u32x2*)(PROJ + tok * NP + PC_DGATE + 64 * head + e);
                u32x2 ov; ov.x = pk2(o[et][4 * g4 + 0] * rstd * ng.x * silu(bf_lo(gw.x)), o[et][4 * g4 + 1] * rstd * ng.y * silu(bf_hi(gw.x)));
                ov.y = pk2(o[et][4 * g4 + 2] * rstd * ng.z * silu(bf_lo(gw.y)), o[et][4 * g4 + 3] * rstd * ng.w * silu(bf_hi(gw.y)));
                *(u32x2*)(Y + tok * DM + 768 + 64 * head + e) = ov; } }
    __syncthreads();
}

constexpr int U_D = 128, U_C = 512, U_B = 256, U_A = 256, U_MIX = U_C + U_D + U_B + U_A, U_W = (I_L + NWAVES - 1) / NWAVES;
__global__ void __launch_bounds__(NTHR, 2) fwd_kernel(Args args) {
    extern __shared__ __attribute__((aligned(16))) unsigned char lds_raw[];
    Frame F;
    F.lds = (LAS unsigned char*)lds_raw; F.MISC = (volatile LAS unsigned*)(F.lds + MISC_OFF);
    F.tid = threadIdx.x; F.lane = F.tid & 63; F.wave = __builtin_amdgcn_readfirstlane(F.tid >> 6); F.G = gridDim.x;
    for (int u = F.tid; u < 256; u += NTHR) ((LAS unsigned*)(F.lds + LDSCTL_OFF))[u] = 0u;
    __syncthreads();
    XcdBarrier bar = xcd_barrier_post((unsigned*)(args.ws + WS_CTL) + CW_BAR, F.MISC + 8);
#define GRID_BAR() xcd_barrier(bar)
    p0_prologue(F);
    GRID_BAR();
#pragma unroll 1
    for (int l = 0; l < DEPTH; ++l) {
        { CArgs* A = get_args();
          pg8::Gemm g{WSP(bf16_t, WS_XB), WSP(bf16_t, WS_WIN) + (size_t)l * NP * DM, M, NP, DM}; pg8::StaticOrder S; S.init(M, NP, F.G, (int)blockIdx.x);
          pg8::EpiProj E{WSP(bf16_t, WS_PROJ), NP, WSP(float, WS_SSQ), __builtin_amdgcn_make_buffer_rsrc(WSP(bf16_t, WS_PROJ), 0, (int)((size_t)M * NP * 2), 0x00020000)};
          pg8::gemm_phase<pg8::EpiProj, pg8::StaticOrder, true, true>(F.lds, g, S, E); }
        int all_seen = 1;
        if (F.G == 256) { all_seen = 0;
            asm volatile("s_waitcnt vmcnt(0)" ::: "memory"); __syncthreads();
            if (F.tid == 0) { const int c = (int)blockIdx.x; unsigned* ctl = (unsigned*)(args.ws + WS_CTL);
                __hip_atomic_fetch_add(ctl + CW_PCNT + 64 * (l * 64 + 8 * (c & 7) + ((c >> 3) & 7)), 1u, RLX_AGENT); __hip_atomic_fetch_add(ctl + CW_GDONE + 64 * l, 1u, RLX_AGENT); }
        } else GRID_BAR();
        { CArgs* A = get_args(); unsigned* qh = WSP(unsigned, WS_CTL) + CW_Q + 64 * l;
          __syncthreads();
          if (F.tid == 0) F.MISC[16] = __hip_atomic_fetch_add(qh, 1u, RLX_AGENT);
          __syncthreads();
          int u = (int)F.MISC[16];
          const int U_TOTAL = U_MIX + (l + 1 < DEPTH ? U_W : 0);
          while (u < U_TOTAL) {
              const bool pre = u >= U_D + U_C;
              unsigned nxt = 0u; if (pre && F.tid == 0) nxt = __hip_atomic_fetch_add(qh, 1u, RLX_AGENT);
              if (!all_seen) {
                  if (F.tid == 0) { int need = 1, bb = 0, lo = 0, hi = 0;
                      if (u < U_D) { bb = (u >> 2) & 3; lo = 512 * (u >> 4); hi = lo + 511; }
                      else if (u < U_C + U_D) { const int uc = u - U_D; bb = (uc >> 2) & 3; lo = 128 * (uc >> 4) - 3; hi = lo + 130; }
                      else if (u < U_C + U_D + U_A) { const int ua = u - U_C - U_D; bb = ua >> 6; lo = 64 * (ua & 63) - 30; hi = lo + 93; }
                      else if (u < U_MIX) { const int ub = u - U_C - U_D - U_A; bb = ub >> 6; lo = 128 * ((ub >> 1) & 31) - 128; hi = lo + 255; }
                      else need = 0;
                      unsigned* ctl = (unsigned*)(A->ws + WS_CTL); unsigned* pc = ctl + CW_PCNT + 64 * (l * 64 + 16 * bb);
                      const int p0 = (lo < 0 ? 0 : lo) >> 8, p1 = hi >> 8; unsigned sp = 0;
                      if (need) while ((__hip_atomic_load(pc + 64 * p0, RLX_AGENT) < 4u || __hip_atomic_load(pc + 64 * p1, RLX_AGENT) < 4u) && ++sp < (1u << 20)) __builtin_amdgcn_s_sleep(1);
                      const unsigned gd = __hip_atomic_load(ctl + CW_GDONE + 64 * l, RLX_AGENT);
                      __builtin_amdgcn_fence(__ATOMIC_ACQUIRE, "agent"); asm volatile("s_waitcnt vmcnt(0)" ::: "memory");
                      F.MISC[18] = (gd >= (unsigned)F.G) ? 1u : 0u; }
                  __syncthreads();
                  all_seen = (int)F.MISC[18];
              }
              Frame FL = F; { int t = F.tid; asm volatile("" : "+v"(t)); FL.tid = t; FL.lane = t & 63; FL.wave = __builtin_amdgcn_readfirstlane(t >> 6); }
              if (u < U_D) { mixer_d(FL, l, u); }
              else if (u < U_C + U_D) { mixer_c(FL, l, u - U_D, qh, nxt); }
              else if (u < U_C + U_D + U_A) { mixer_a(FL, l, u - U_C - U_D); }
              else if (u < U_MIX) { mixer_b(FL, l, u - U_C - U_D - U_A); }
              else { const int it = (u - U_MIX) * NWAVES + FL.wave; if (it < I_L) convert_item(FL, l + 1, it); __syncthreads(); }
              if (F.tid == 0) F.MISC[16] = (pre || (u >= U_D && u < U_D + U_C)) ? nxt : __hip_atomic_fetch_add(qh, 1u, RLX_AGENT);
              __syncthreads();
              u = (int)F.MISC[16];
          }
        }
        GRID_BAR();
        { CArgs* A = get_args();
          pg8::Gemm g{WSP(bf16_t, WS_Y), WSP(bf16_t, WS_WOUT) + (size_t)l * DM * DM, M, DM, DM}; pg8::StaticOrder S; S.init(M, DM, F.G, (int)blockIdx.x);
          pg8::EpiRes E{A->in[I_X], A->out, WSP(bf16_t, WS_XB), WSP(float, WS_SSQ), l == 0 ? 0 : (l + 1 < DEPTH ? 1 : 2)};
          pg8::gemm_phase<pg8::EpiRes, pg8::StaticOrder, true, true>(F.lds, g, S, E); }
        if (l + 1 < DEPTH) {
            if (F.G == 256) {
                asm volatile("s_waitcnt vmcnt(0)" ::: "memory"); __syncthreads();
                if (F.tid == 0) { unsigned* cnt = (unsigned*)(args.ws + WS_CTL) + CW_TEAM + 64 * (l * 64 + ((int)blockIdx.x & 63));
                    __builtin_amdgcn_fence(__ATOMIC_RELEASE, "agent"); asm volatile("s_waitcnt vmcnt(0)" ::: "memory");
                    __hip_atomic_fetch_add(cnt, 1u, RLX_AGENT);
                    unsigned sp = 0; while (__hip_atomic_load(cnt, RLX_AGENT) < 4u && ++sp < (1u << 20)) __builtin_amdgcn_s_sleep(1);
                    __builtin_amdgcn_fence(__ATOMIC_ACQUIRE, "agent"); asm volatile("s_waitcnt vmcnt(0)" ::: "memory"); }
                __syncthreads();
            } else GRID_BAR();
        }
    }
}

extern "C" void kernel_launch(void* const* d_in, const int* in_sizes, int n_in, void* d_out, int out_size, void* d_ws, size_t ws_size, hipStream_t stream) {
    static int grid = 0;
    if (grid == 0) {
        if (n_in != 23 || in_sizes[0] != M * DM || out_size != M * DM || ws_size < WS_END) { fprintf(stderr, "kernel_launch: unexpected problem shape (n_in %d, in0 %d, out %d, ws %zu)\n", n_in, n_in > 0 ? in_sizes[0] : -1, out_size, ws_size); grid = -1; return; }
        int dev = 0, cus = 0, per_cu = 0;
        if (hipGetDevice(&dev) != hipSuccess || hipDeviceGetAttribute(&cus, hipDeviceAttributeMultiprocessorCount, dev) != hipSuccess) { grid = -1; return; }
        if (hipFuncSetAttribute((const void*)fwd_kernel, hipFuncAttributeMaxDynamicSharedMemorySize, LDS_BYTES) != hipSuccess) { fprintf(stderr, "kernel_launch: hipFuncSetAttribute failed\n"); grid = -1; return; }
        if (hipOccupancyMaxActiveBlocksPerMultiprocessor(&per_cu, (const void*)fwd_kernel, NTHR, LDS_BYTES) != hipSuccess || per_cu < 1) { fprintf(stderr, "kernel_launch: occupancy query says %d blocks per CU\n", per_cu); grid = -1; (void)hipGetLastError(); return; }
        grid = cus * per_cu < 256 ? cus * per_cu : 256;
    }
    if (grid <= 0) return;
    (void)hipMemsetAsync((char*)d_ws + WS_CTL, 0, CTL_ZERO_BYTES, stream);
    Args a{};
    for (int i = 0; i < 23; ++i) a.in[i] = (const float*)d_in[i];
    a.out = (float*)d_out; a.ws = (unsigned char*)d_ws;
    void* kargs[] = {&a};
    hipError_t e = hipLaunchCooperativeKernel((const void*)fwd_kernel, dim3(grid), dim3(NTHR), kargs, LDS_BYTES, stream);
    if (e != hipSuccess) fprintf(stderr, "kernel_launch: cooperative launch failed: %s (grid %d)\n", hipGetErrorString(e), grid);
}
```

```cpp
#include <hip/hip_runtime.h>
#include <cstdio>
#include <cstdint>
template <int CTRL> __device__ __forceinline__ float dpp(float x) { return __builtin_bit_cast(float, __builtin_amdgcn_mov_dpp(__builtin_bit_cast(int, x), CTRL, 0xf, 0xf, true)); }
constexpr int DPP_XOR1 = 0xB1, DPP_XOR2 = 0x4E, DPP_XOR7 = 0x141, DPP_XOR8 = 0x128;
__device__ __forceinline__ float sum8(float v) { v += dpp<DPP_XOR1>(v); v += dpp<DPP_XOR2>(v); v += dpp<DPP_XOR7>(v); return v; }
__device__ __forceinline__ float sum16(float v) { v = sum8(v); v += dpp<DPP_XOR8>(v); return v; }
__device__ __forceinline__ float xsum16(float x) { auto s = __builtin_amdgcn_permlane16_swap(__float_as_uint(x), __float_as_uint(x), false, false); return __uint_as_float(s[0]) + __uint_as_float(s[1]); }
__device__ __forceinline__ float xsum32(float x) { auto s = __builtin_amdgcn_permlane32_swap(__float_as_uint(x), __float_as_uint(x), false, false); return __uint_as_float(s[0]) + __uint_as_float(s[1]); }
__device__ __forceinline__ float xmax32(float x) { auto s = __builtin_amdgcn_permlane32_swap(__float_as_uint(x), __float_as_uint(x), false, false); return fmaxf(__uint_as_float(s[0]), __uint_as_float(s[1])); }
__device__ __forceinline__ float xget32(float x, int hi) { auto s = __builtin_amdgcn_permlane32_swap(__float_as_uint(x), __float_as_uint(x), false, false); return __uint_as_float(hi ? s[0] : s[1]); }
__device__ __forceinline__ float sum32(float v) { return xsum16(sum16(v)); }
namespace pg8 {
#define PG8_LAS __attribute__((address_space(3)))
typedef unsigned short bf16_t;
typedef short bf16x8 __attribute__((ext_vector_type(8)));
typedef float f32x4 __attribute__((ext_vector_type(4)));
typedef unsigned u32x4 __attribute__((ext_vector_type(4)));
constexpr int BM = 256, BK = 64, HALF = 128, HTB = HALF * BK * 2  , STAGE_BYTES = 8 * HTB, NXCD = 8, WGM = 8;

__host__ __device__ __forceinline__ int lds_byte(int r, int c) { const int st = (r >> 4) * 2 + (c >> 5), rr = r & 15, cc = c & 31, ob = rr * 64 + cc * 2; return st * 1024 + (ob ^ (((ob >> 9) & 1) << 5)); }
__host__ __device__ __forceinline__ void stage_rc(int b, int& R, int& C) { const int st = b / 1024, sb = b % 1024, swz = sb ^ (((sb >> 9) & 1) << 5); R = (st >> 1) * 16 + swz / 64; C = (st & 1) * 32 + (swz % 64) / 2; }
__host__ __device__ __forceinline__ int perm32(int rho) { const int n = rho >> 4, i = rho & 15; return 8 * (i >> 2) + 4 * n + (i & 3); }

struct Unit { int pm, pn; };
struct Gemm { const bf16_t* A; const bf16_t* Bt; int M, N, K; };

struct StaticOrder {
    int nM, nN, nwg, G, c;
    __host__ __device__ void init(int M, int N, int G_, int c_) { nM = M / BM; nN = N / BM; nwg = nM * nN; G = G_; c = c_; }
    __host__ __device__ bool next(int i, Unit& u) const {
        const long L = (long)i * G + c; if (L >= nwg) return false;
        int wgid = (int)L; { const int q = nwg / NXCD, r = nwg % NXCD, xcd = wgid % NXCD, off = wgid / NXCD; wgid = (xcd < r ? xcd * (q + 1) : r * (q + 1) + (xcd - r) * q) + off; }
        const int nig = WGM * nN, gid = wgid / nig, fm = gid * WGM, gsz = (nM - fm) < WGM ? (nM - fm) : WGM;
        u.pm = fm + ((wgid % nig) % gsz); u.pn = (wgid % nig) / gsz; return true;
    }
    __device__ __forceinline__ void a_ready(const Unit&) const {}
    __device__ __forceinline__ void done(const Unit&) const {}
};

__device__ __forceinline__ unsigned cvt_pk_bf16(float lo, float hi) { unsigned r; asm volatile("v_cvt_pk_bf16_f32 %0, %1, %2" : "=v"(r) : "v"(lo), "v"(hi)); return r; }
struct EpiProj {
    static constexpr bool PERM = true, AFTER_DRAIN = false;
    bf16_t* O; int ldc; const float* ssq; __amdgpu_buffer_rsrc_t rsrc;
    __device__ __forceinline__ void operator()(const f32x4 (&acc)[2][2][4][2], const Unit& u, int wr, int wc, int fr, int fq) const {
        const int row0 = u.pm * BM + wr * 64 + fr, col0 = u.pn * BM + wc * 32 + 8 * fq;
#pragma unroll
        for (int ai = 0; ai < 2; ++ai)
#pragma unroll
            for (int m = 0; m < 4; ++m) { const int row = row0 + ai * HALF + m * 16;
                const f32x4 s4 = *(const f32x4*)(ssq + (size_t)row * 16 + 4 * fq);
                float s = (s4[0] + s4[1]) + (s4[2] + s4[3]); s = xsum32(xsum16(s));
                const float rs = 1.0f / sqrtf(s * (1.0f / 1024.0f) + 1e-6f);
                const unsigned boff = (unsigned)(((size_t)row * ldc + col0) * 2);
#pragma unroll
                for (int bj = 0; bj < 2; ++bj) { const f32x4 v0 = acc[ai][bj][m][0] * rs, v1 = acc[ai][bj][m][1] * rs;
                    u32x4 w; w.x = cvt_pk_bf16(v0[0], v0[1]); w.y = cvt_pk_bf16(v0[2], v0[3]); w.z = cvt_pk_bf16(v1[0], v1[1]); w.w = cvt_pk_bf16(v1[2], v1[3]);
                    __builtin_amdgcn_raw_buffer_store_b128(w, rsrc, boff + bj * HALF * 2, 0,   16); } }
    }
};
struct EpiRes {
    static constexpr bool PERM = true, AFTER_DRAIN = false;
    const float* xin; float* xout; bf16_t* xb; float* ssq; int mode; __amdgpu_buffer_rsrc_t rsrc;
    __device__ __forceinline__ void operator()(const f32x4 (&acc)[2][2][4][2], const Unit& u, int wr, int wc, int fr, int fq) const {
        const int row0 = u.pm * BM + wr * 64 + fr, col0 = u.pn * BM + wc * 32 + 8 * fq;
#pragma unroll
        for (int ai = 0; ai < 2; ++ai)
#pragma unroll
            for (int m = 0; m < 4; ++m) { const int row = row0 + ai * HALF + m * 16; float ss = 0.f;
#pragma unroll
                for (int bj = 0; bj < 2; ++bj) { const size_t off = (size_t)row * 1024 + col0 + bj * HALF; f32x4 x0, x1;
                    if (mode == 0) { x0 = *(const f32x4*)(xin + off); x1 = *(const f32x4*)(xin + off + 4); }
                    else { const u32x4 w = *(const u32x4*)(xb + off); x0 = (f32x4){__uint_as_float(w.x << 16), __uint_as_float(w.x & 0xffff0000u), __uint_as_float(w.y << 16), __uint_as_float(w.y & 0xffff0000u)};
                        x1 = (f32x4){__uint_as_float(w.z << 16), __uint_as_float(w.z & 0xffff0000u), __uint_as_float(w.w << 16), __uint_as_float(w.w & 0xffff0000u)}; }
                    x0 = x0 + acc[ai][bj][m][0]; x1 = x1 + acc[ai][bj][m][1];
                    if (mode == 2) { *(f32x4*)(xout + off) = x0; *(f32x4*)(xout + off + 4) = x1; }
                    else { u32x4 w; w.x = cvt_pk_bf16(x0[0], x0[1]); w.y = cvt_pk_bf16(x0[2], x0[3]); w.z = cvt_pk_bf16(x1[0], x1[1]); w.w = cvt_pk_bf16(x1[2], x1[3]);
                        __builtin_amdgcn_raw_buffer_store_b128(w, rsrc, (unsigned)(off * 2), 0,   16);
                        const float r0 = __uint_as_float(w.x << 16), r1 = __uint_as_float(w.x & 0xffff0000u), r2 = __uint_as_float(w.y << 16), r3 = __uint_as_float(w.y & 0xffff0000u),
                                    r4 = __uint_as_float(w.z << 16), r5 = __uint_as_float(w.z & 0xffff0000u), r6 = __uint_as_float(w.w << 16), r7 = __uint_as_float(w.w & 0xffff0000u);
                        ss += (r0 * r0 + r1 * r1) + (r2 * r2 + r3 * r3) + (r4 * r4 + r5 * r5) + (r6 * r6 + r7 * r7); } }
                if (mode != 2) { ss = xsum32(xsum16(ss)); if (fq == 0) __hip_atomic_store(ssq + (size_t)row * 16 + u.pn * 4 + wc, ss, __ATOMIC_RELAXED, __HIP_MEMORY_SCOPE_AGENT); } }
    }
};

template <class Epi, class Sched, bool ALIGN_EPI = false, bool SP2 = false>
__device__ __forceinline__ void gemm_phase(PG8_LAS unsigned char* lds, const Gemm g, const Sched& S, const Epi& E) {
    int tid_ = threadIdx.x; asm volatile("" : "+v"(tid_));
    const int tid = tid_, wid = __builtin_amdgcn_readfirstlane(tid >> 6), lane = tid & 63, wr = wid >> 2, wc = wid & 3, fr = lane & 15, fq = lane >> 4;
    const int K = g.K, nt = K / BK;
    unsigned voffA[2], voffB[2];
#pragma unroll
    for (int i = 0; i < 2; ++i) { int R, C; stage_rc(tid * 16 + i * 8192, R, C); const int Rb = Epi::PERM ? ((R & ~31) + perm32(R & 31)) : R;
        voffA[i] = (unsigned)(R * K + C) * 2u; voffB[i] = (unsigned)(Rb * K + C) * 2u; }
    const size_t kstep = (size_t)(BK * 2);
    const size_t hstep = (size_t)HALF * K * 2;
    const size_t tstep = 2 * hstep;
    const unsigned ldsw = (unsigned)wid * 1024u;
    const int aoff = lds_byte(wr * 64 + fr, fq * 8), boff = lds_byte(wc * 32 + fr, fq * 8);
#define PG8_SA(b, h) (((b) * 2 + (h)) * HTB)
#define PG8_SB(b, h) ((4 + (b) * 2 + (h)) * HTB)
#define PG8_STAGE(bufoff, gbase, voff) do { _Pragma("unroll") for (int _i = 0; _i < 2; ++_i) \
        __builtin_amdgcn_global_load_lds((const unsigned*)((const char*)(gbase) + (voff)[_i]), (PG8_LAS unsigned*)(lds + (bufoff) + ldsw + _i * 8192), 16, 0, 0); } while (0)
#define PG8_LDA(dst, b, h) do { _Pragma("unroll") for (int m = 0; m < 4; ++m) _Pragma("unroll") for (int k = 0; k < 2; ++k) dst[m][k] = *(const PG8_LAS bf16x8*)(lds + PG8_SA(b, h) + aoff + m * 2048 + k * 1024); } while (0)
#define PG8_LDB(dst, b, h) do { _Pragma("unroll") for (int n = 0; n < 2; ++n) _Pragma("unroll") for (int k = 0; k < 2; ++k) dst[n][k] = *(const PG8_LAS bf16x8*)(lds + PG8_SB(b, h) + boff + n * 2048 + k * 1024); } while (0)
#define PG8_MMA(ai, bj, At, Bt) do { __builtin_amdgcn_s_setprio(1); _Pragma("unroll") for (int m = 0; m < 4; ++m) _Pragma("unroll") for (int n = 0; n < 2; ++n) _Pragma("unroll") for (int k = 0; k < 2; ++k) \
        acc[ai][bj][m][n] = __builtin_amdgcn_mfma_f32_16x16x32_bf16(Bt[n][k], At[m][k], acc[ai][bj][m][n], 0, 0, 0); __builtin_amdgcn_s_setprio(0); } while (0)
#define PG8_WAIT_V(n) asm volatile("s_waitcnt vmcnt(" #n ")" ::: "memory")
#define PG8_WAIT_L(n) asm volatile("s_waitcnt lgkmcnt(" #n ")" ::: "memory")
#define PG8_BAR __builtin_amdgcn_s_barrier()
#define PG8_SCHED __builtin_amdgcn_sched_barrier(0)
    Unit cur, nxt; int ui = 0;
    if (!S.next(0, cur)) return;
    f32x4 acc[2][2][4][2];
#pragma unroll
    for (int a = 0; a < 2; ++a)
#pragma unroll
        for (int b = 0; b < 2; ++b)
#pragma unroll
            for (int m = 0; m < 4; ++m)
#pragma unroll
                for (int n = 0; n < 2; ++n) acc[a][b][m][n] = (f32x4){0.f, 0.f, 0.f, 0.f};
    bf16x8 At[4][2], B0[2][2], B1[2][2];
    const char* cA = (const char*)g.A + (size_t)cur.pm * tstep; const char* cB = (const char*)g.Bt + (size_t)cur.pn * tstep;
    S.a_ready(cur);
    if constexpr (SP2) {
        PG8_STAGE(PG8_SB(0, 0), cB, voffB); PG8_STAGE(PG8_SB(0, 1), cB + hstep, voffB); PG8_STAGE(PG8_SA(0, 0), cA, voffA); PG8_STAGE(PG8_SA(0, 1), cA + hstep, voffA);
        if (wr == 1) PG8_BAR;
        PG8_WAIT_V(2); PG8_BAR;
        PG8_STAGE(PG8_SB(1, 0), cB + kstep, voffB); PG8_STAGE(PG8_SA(1, 0), cA + kstep, voffA); PG8_STAGE(PG8_SB(1, 1), cB + hstep + kstep, voffB);
        PG8_WAIT_V(6); PG8_BAR;
    } else {
        PG8_STAGE(PG8_SB(0, 0), cB, voffB); PG8_STAGE(PG8_SA(0, 0), cA, voffA); PG8_STAGE(PG8_SB(0, 1), cB + hstep, voffB); PG8_STAGE(PG8_SA(0, 1), cA + hstep, voffA);
        if (wr == 1) PG8_BAR;
        PG8_WAIT_V(4); PG8_BAR;
        PG8_STAGE(PG8_SB(1, 0), cB + kstep, voffB); PG8_STAGE(PG8_SA(1, 0), cA + kstep, voffA); PG8_STAGE(PG8_SB(1, 1), cB + hstep + kstep, voffB);
        PG8_WAIT_V(6); PG8_BAR;
    }
    for (;;) {
        const bool has_next = S.next(ui + 1, nxt);
        const char* nA = has_next ? (const char*)g.A + (size_t)nxt.pm * tstep : cA; const char* nB = has_next ? (const char*)g.Bt + (size_t)nxt.pn * tstep : cB;
        for (int t = 0; t < nt; t += 2) {
            const bool last = (t == nt - 2);
            const char* a1 = cA + (size_t)(t + 1) * kstep;
            const char* a2 = last ? nA : cA + (size_t)(t + 2) * kstep; const char* b2 = last ? nB : cB + (size_t)(t + 2) * kstep;
            const char* a3 = a2 + kstep; const char* b3 = b2 + kstep;
            if (last && has_next) S.a_ready(nxt);
            if constexpr (SP2) {
            PG8_LDB(B0, 0, 0); PG8_LDB(B1, 0, 1); PG8_SCHED; PG8_LDA(At, 0, 0); PG8_STAGE(PG8_SA(1, 1), a1 + hstep, voffA);
            PG8_WAIT_V(8); PG8_WAIT_L(0); PG8_BAR; PG8_MMA(0, 0, At, B0); PG8_MMA(0, 1, At, B1); PG8_BAR; PG8_SCHED;
            PG8_LDA(At, 0, 1); PG8_STAGE(PG8_SB(0, 0), b2, voffB); PG8_STAGE(PG8_SB(0, 1), b2 + hstep, voffB); PG8_STAGE(PG8_SA(0, 0), a2, voffA);
            PG8_WAIT_V(8); PG8_WAIT_L(0); PG8_BAR; PG8_MMA(1, 0, At, B0); PG8_MMA(1, 1, At, B1); PG8_BAR; PG8_SCHED;
            PG8_LDB(B0, 1, 0); PG8_LDB(B1, 1, 1); PG8_SCHED; PG8_LDA(At, 1, 0); PG8_STAGE(PG8_SA(0, 1), a2 + hstep, voffA);
            PG8_WAIT_V(8); PG8_WAIT_L(0); PG8_BAR; PG8_MMA(0, 0, At, B0); PG8_MMA(0, 1, At, B1); PG8_BAR; PG8_SCHED;
            PG8_LDA(At, 1, 1); PG8_STAGE(PG8_SB(1, 0), b3, voffB); PG8_STAGE(PG8_SB(1, 1), b3 + hstep, voffB); PG8_STAGE(PG8_SA(1, 0), a3, voffA);
            PG8_WAIT_V(8); PG8_WAIT_L(0); PG8_BAR; PG8_MMA(1, 0, At, B0); PG8_MMA(1, 1, At, B1); PG8_BAR; PG8_SCHED;
            } else {
            PG8_LDB(B0, 0, 0); PG8_SCHED; PG8_LDA(At, 0, 0); PG8_STAGE(PG8_SA(1, 1), a1 + hstep, voffA);
            PG8_WAIT_L(8); PG8_BAR; PG8_WAIT_L(0); PG8_MMA(0, 0, At, B0); PG8_BAR; PG8_SCHED;
            PG8_LDB(B1, 0, 1); PG8_STAGE(PG8_SB(0, 0), b2, voffB);
            PG8_BAR; PG8_WAIT_L(0); PG8_MMA(0, 1, At, B1); PG8_BAR;
            PG8_LDA(At, 0, 1); PG8_STAGE(PG8_SA(0, 0), a2, voffA);
            PG8_BAR; PG8_WAIT_L(0); PG8_MMA(1, 0, At, B0); PG8_BAR; PG8_SCHED;
            PG8_STAGE(PG8_SB(0, 1), b2 + hstep, voffB);
            PG8_WAIT_V(6); PG8_BAR; PG8_MMA(1, 1, At, B1); PG8_BAR;
            PG8_LDB(B0, 1, 0); PG8_SCHED; PG8_LDA(At, 1, 0); PG8_STAGE(PG8_SA(0, 1), a2 + hstep, voffA);
            PG8_WAIT_L(8); PG8_BAR; PG8_WAIT_L(0); PG8_MMA(0, 0, At, B0); PG8_BAR; PG8_SCHED;
            PG8_LDB(B1, 1, 1); PG8_STAGE(PG8_SB(1, 0), b3, voffB);
            PG8_BAR; PG8_WAIT_L(0); PG8_MMA(0, 1, At, B1); PG8_BAR;
            PG8_LDA(At, 1, 1); PG8_STAGE(PG8_SA(1, 0), a3, voffA);
            PG8_BAR; PG8_WAIT_L(0); PG8_MMA(1, 0, At, B0); PG8_BAR; PG8_SCHED;
            PG8_STAGE(PG8_SB(1, 1), b3 + hstep, voffB);
            PG8_WAIT_V(6); PG8_BAR; PG8_MMA(1, 1, At, B1); PG8_BAR;
            }
        }
        if constexpr (ALIGN_EPI) { if (wr == 0) PG8_BAR; }
        if constexpr (!Epi::AFTER_DRAIN) { E(acc, cur, wr, wc, fr, fq); S.done(cur); }
        if (!has_next) break;
#pragma unroll
        for (int a = 0; a < 2; ++a)
#pragma unroll
            for (int b = 0; b < 2; ++b)
#pragma unroll
                for (int m = 0; m < 4; ++m)
#pragma unroll
                    for (int n = 0; n < 2; ++n) acc[a][b][m][n] = (f32x4){0.f, 0.f, 0.f, 0.f};
        cur = nxt; cA = nA; cB = nB; ++ui;
        if constexpr (ALIGN_EPI) { if (wr == 1) PG8_BAR; }
    }
    PG8_WAIT_V(0);
    if constexpr (!ALIGN_EPI) { if (wr == 0) PG8_BAR; }
    PG8_BAR;
    if constexpr (Epi::AFTER_DRAIN) { E.fused(acc, cur, wr, wc, fr, fq, lds, wid, lane); S.done(cur); }
#undef PG8_SA
#undef PG8_SB
#undef PG8_STAGE
#undef PG8_LDA
#undef PG8_LDB
#undef PG8_MMA
#undef PG8_WAIT_V
#undef PG8_WAIT_L
#undef PG8_BAR
#undef PG8_SCHED
}
}
using pg8::bf16_t; using pg8::bf16x8; using pg8::f32x4; using pg8::u32x4; using pg8::cvt_pk_bf16;
#define GAS __attribute__((address_space(1)))
#define LAS __attribute__((address_space(3)))
typedef float f32x16 __attribute__((ext_vector_type(16)));
typedef float f32x2 __attribute__((ext_vector_type(2)));
typedef unsigned u32x2 __attribute__((ext_vector_type(2)));
typedef GAS unsigned gu32;
#define RLX_AGENT __ATOMIC_RELAXED, __HIP_MEMORY_SCOPE_AGENT
#define LDS_WAIT() asm volatile("s_waitcnt lgkmcnt(0)" ::: "memory")
#define MFMA32(a, b, c) __builtin_amdgcn_mfma_f32_32x32x16_bf16((a), (b), (c), 0, 0, 0)

constexpr int NWAVES = 8, NTHR = 512;
constexpr int BATCH = 4, SEQ = 4096, DM = 1024, DEPTH = 4, M = BATCH * SEQ, NIN = 2832, NP = 3072;
constexpr float EPS = 1e-6f;
constexpr int PC_AVAL = 0, PC_AGLU = 256, PC_AGATE = 512, PC_BQ = 768, PC_BK = 1024, PC_BV = 1152, PC_BGATE = 1280, PC_CX = 1536, PC_CGATE = 1792,
              PC_DQ = 2048, PC_DK = 2176, PC_DV = 2304, PC_DGATE = 2560, PC_DLR = 2816;
__host__ __device__ __forceinline__ int win_remap(int n) { return n < 2560 ? n : (n < 2816 ? n + 16 : (n < 2832 ? n - 256 : -1)); }
constexpr size_t MiB = 1u << 20;
constexpr size_t WS_CTL = 0, CTL_ZERO_BYTES = 1 * MiB;
constexpr size_t WS_WIN = 2 * MiB;
constexpr size_t WS_WOUT = 26 * MiB;
constexpr size_t WS_APW = 34 * MiB;
constexpr size_t WS_WR = WS_APW + 512 * 1024, WS_WI = WS_WR + 128 * 1024;
constexpr size_t WS_SSQ = 35 * MiB;
constexpr size_t WS_XB = 36 * MiB;
constexpr size_t WS_Y = 68 * MiB;
constexpr size_t WS_PROJ = 100 * MiB;
constexpr size_t WS_GC = 200 * MiB;
constexpr size_t WS_GD = 201 * MiB;
constexpr size_t WS_BIAS = 204 * MiB;
constexpr size_t WS_END = 205 * MiB;
constexpr int CW_BAR = 4096;
constexpr int CW_TEAM = 65536;
constexpr int CW_PCNT = 131072;
constexpr int CW_GDONE = CW_PCNT + 64 * 256;
constexpr int CW_Q = 16384;
constexpr int RING_BYTES = 131072, LDSCTL_OFF = RING_BYTES, MISC_OFF = LDSCTL_OFF + 320, LDS_BYTES = 147456;

__device__ __forceinline__ float bf_lo(unsigned w) { return __uint_as_float(w << 16); }
__device__ __forceinline__ float bf_hi(unsigned w) { return __uint_as_float(w & 0xffff0000u); }
__device__ __forceinline__ unsigned f2bf(float f) { unsigned u = __float_as_uint(f); return (u + 0x7fffu + ((u >> 16) & 1u)) >> 16; }
typedef __bf16 bf16v2 __attribute__((ext_vector_type(2)));
__device__ __forceinline__ unsigned pk2(float lo, float hi) { const f32x2 f = {lo, hi}; const bf16v2 b = __builtin_convertvector(f, bf16v2); return __builtin_bit_cast(unsigned, b); }
__device__ __forceinline__ float fexp(float x) { return __builtin_amdgcn_exp2f(x * 1.4426950408889634f); }
__device__ __forceinline__ float frcp(float x) { return __builtin_amdgcn_rcpf(x); }
__device__ __forceinline__ float sigm(float x) { return frcp(1.f + fexp(-x)); }
__device__ __forceinline__ float silu(float x) { return x * sigm(x); }
__device__ __forceinline__ float rsq(float x) { return __builtin_amdgcn_rsqf(x); }
__device__ __forceinline__ float log1p_01(float e) { return __builtin_amdgcn_logf(1.0f + e) * 0.6931471805599453f; }
__device__ __forceinline__ float one_minus_exp(float x) { const float p = -x * (1.0f + x * (0.5f + x * (1.0f / 6.0f + x * (1.0f / 24.0f + x * (1.0f / 120.0f + x * (1.0f / 720.0f)))))); return x > -0.25f ? p : 1.0f - fexp(x); }
__device__ __forceinline__ void unpack8(const u32x4 w, float (&f)[8]) { f[0] = bf_lo(w.x); f[1] = bf_hi(w.x); f[2] = bf_lo(w.y); f[3] = bf_hi(w.y); f[4] = bf_lo(w.z); f[5] = bf_hi(w.z); f[6] = bf_lo(w.w); f[7] = bf_hi(w.w); }
__device__ __forceinline__ u32x4 pack8(const float (&f)[8]) { u32x4 w; w.x = pk2(f[0], f[1]); w.y = pk2(f[2], f[3]); w.z = pk2(f[4], f[5]); w.w = pk2(f[6], f[7]); return w; }
__device__ __forceinline__ bf16x8 as_frag(const u32x4 w) { return __builtin_bit_cast(bf16x8, w); }
__device__ __forceinline__ bf16x8 frag_from_acc(const f32x16& a, int s8) { u32x4 w; w.x = pk2(a[s8 + 0], a[s8 + 1]); w.y = pk2(a[s8 + 2], a[s8 + 3]); w.z = pk2(a[s8 + 4], a[s8 + 5]); w.w = pk2(a[s8 + 6], a[s8 + 7]); return as_frag(w); }
__device__ __forceinline__ float wave_sum(float v) { return xsum32(sum32(v)); }
#define XB_TMO      128
#define XB_XCNT(j)  (256  + 64 * (j))
#define XB_XSUB(j)  (1280 + 64 * (j))
#define XB_XGEN(j)  (2304 + 64 * (j))
#define XB_TOP      3328
#define XB_TOPGEN   3392
#define XCD_BAR_WORDS 3456
#define XB_SPIN_CAP (1u << 18)

__device__ __forceinline__ unsigned xb_ld(unsigned* p)              { return __hip_atomic_load(p, __ATOMIC_RELAXED, __HIP_MEMORY_SCOPE_AGENT); }
__device__ __forceinline__ unsigned xb_add(unsigned* p, unsigned v) { return __hip_atomic_fetch_add(p, v, __ATOMIC_RELAXED, __HIP_MEMORY_SCOPE_AGENT); }
__device__ __forceinline__ unsigned xb_xcc_id() { return (unsigned)__builtin_amdgcn_s_getreg((3 << 11) | 20) & 0xFu; }
#define XB_SPIN(cond, bar) do { unsigned _sp = 0; while (cond) { __builtin_amdgcn_s_sleep(1); \
    if ((++_sp & 255u) == 0u) { if (xb_ld(&(bar)[XB_TMO])) break; if (_sp > XB_SPIN_CAP) { atomicAdd(&(bar)[XB_TMO], 1u); break; } } } } while (0)

struct XcdBarrier {
    unsigned* bar; unsigned x;
    volatile LAS unsigned* st;
};

__device__ __forceinline__ XcdBarrier xcd_barrier_post(unsigned* bar, volatile LAS unsigned* st) {
    XcdBarrier b; b.bar = bar; b.x = xb_xcc_id(); b.st = st;
    if (threadIdx.x == 0) (void)xb_add(&bar[XB_XCNT(b.x)], 1u);
    return b;
}
__device__ __forceinline__ void xcd_barrier_complete(unsigned* bar, unsigned x, unsigned& nloc, unsigned& nx) {
    const unsigned G = gridDim.x * gridDim.y * gridDim.z;
    unsigned sum, cnt, mine, sp = 0u;
    for (;;) {
        sum = 0u; cnt = 0u; mine = 0u;
#pragma unroll
        for (unsigned j = 0; j < 16; ++j) { const unsigned c = xb_ld(&bar[XB_XCNT(j)]); sum += c; cnt += (c > 0u) ? 1u : 0u; mine = (j == x) ? c : mine; }
        if (sum == G) break;
        __builtin_amdgcn_s_sleep(1);
        if ((++sp & 255u) == 0u) { if (xb_ld(&bar[XB_TMO])) break; if (sp > XB_SPIN_CAP) { atomicAdd(&bar[XB_TMO], 1u); break; } }
    }
    nloc = mine > 0u ? mine : 1u; nx = cnt > 0u ? cnt : 1u;
}

__device__ __forceinline__ void xcd_barrier(const XcdBarrier& b) {
    asm volatile("s_waitcnt vmcnt(0)" ::: "memory");
    __syncthreads();
    if (threadIdx.x == 0) {
        unsigned* bar = b.bar;
        __builtin_amdgcn_s_waitcnt(0);
        unsigned nloc = b.st[0], nx = b.st[1];
        if (nloc == 0u) { xcd_barrier_complete(bar, b.x, nloc, nx); b.st[0] = nloc; b.st[1] = nx; }
        const unsigned old = xb_add(&bar[XB_XSUB(b.x)], 1u);
        const unsigned gen = old / nloc;
        if (old + 1u == (gen + 1u) * nloc) {
            __builtin_amdgcn_fence(__ATOMIC_RELEASE, "agent");
            asm volatile("s_waitcnt vmcnt(0)" ::: "memory");
            const unsigned og = xb_add(&bar[XB_TOP], 1u);
            const unsigned tg = og / nx;
            if (og + 1u == (tg + 1u) * nx) xb_add(&bar[XB_TOPGEN], 1u);
            else XB_SPIN(xb_ld(&bar[XB_TOPGEN]) == tg, bar);
            __builtin_amdgcn_fence(__ATOMIC_ACQUIRE, "agent");
            xb_add(&bar[XB_XGEN(b.x)], 1u);
            asm volatile("s_waitcnt vmcnt(0)" ::: "memory");
        } else {
            XB_SPIN(xb_ld(&bar[XB_XGEN(b.x)]) == gen, bar);
            __builtin_amdgcn_fence(__ATOMIC_ACQUIRE, "agent");
            asm volatile("s_waitcnt vmcnt(0)" ::: "memory");
        }
    }
    __syncthreads();
}
template <int S8> __device__ __forceinline__ bf16x8 frag_acc(const f32x16& a) { u32x4 w; w.x = pk2(a[S8 + 0], a[S8 + 1]); w.y = pk2(a[S8 + 2], a[S8 + 3]); w.z = pk2(a[S8 + 4], a[S8 + 5]); w.w = pk2(a[S8 + 6], a[S8 + 7]); return as_frag(w); }

struct Args { const float* in[23]; float* out; unsigned char* ws; };
typedef __attribute__((address_space(4))) const Args CArgs;
__device__ __forceinline__ CArgs* get_args() { CArgs* p = (CArgs*)__builtin_amdgcn_kernarg_segment_ptr(); asm volatile("" : "+s"(p)); return p; }
enum { I_X = 0, I_NORM_G, I_W_IN, I_A_CONV_W, I_A_CONV_B, I_A_LN_G, I_A_LN_B, I_A_PW, I_B_Q_G, I_B_K_G, I_B_SINKS, I_REL_BIAS, I_C_CONV_W, I_C_CONV_B, I_C_W_R, I_C_B_R, I_C_W_I, I_C_B_I, I_C_LAMBDA, I_D_W_UP, I_D_B_UP, I_D_NORM_G, I_W_OUT };
struct Frame { LAS unsigned char* lds; volatile LAS unsigned* MISC; int tid, lane, wave, G; };
#define WSP(T, off) ((T*)(A->ws + (off)))

template <bool REMAP>
__device__ __forceinline__ void transpose_item(const float* W, int ldw, const float* gk, bf16_t* WT, int ldt, int k0, int n0, LAS float* scr, int lane) {
    const int nn = n0 + (lane & 31); const int col = REMAP ? win_remap(nn) : nn, colc = col < 0 ? 0 : col;
    const float* wp = W + (size_t)(k0 + (lane >> 5)) * ldw + colc;
    float v[32];
#pragma unroll
    for (int i = 0; i < 32; ++i) v[i] = wp[(size_t)(2 * i) * ldw];
    const int c = lane & 7;
    f32x4 g0 = (f32x4){1.f, 1.f, 1.f, 1.f}, g1 = g0; if (gk) { g0 = *(const f32x4*)(gk + k0 + 8 * c); g1 = *(const f32x4*)(gk + k0 + 8 * c + 4); }
#pragma unroll
    for (int i = 0; i < 32; ++i) scr[(2 * i + (lane >> 5)) * 33 + (lane & 31)] = col < 0 ? 0.f : v[i];
    LDS_WAIT(); asm volatile("" ::: "memory");
#pragma unroll
    for (int j = 0; j < 4; ++j) { const int n = (lane >> 3) + 8 * j; const LAS float* s = scr + (8 * c) * 33 + n;
        u32x4 o; o.x = pk2(s[0 * 33] * g0.x, s[1 * 33] * g0.y); o.y = pk2(s[2 * 33] * g0.z, s[3 * 33] * g0.w); o.z = pk2(s[4 * 33] * g1.x, s[5 * 33] * g1.y); o.w = pk2(s[6 * 33] * g1.z, s[7 * 33] * g1.w);
        *(u32x4*)(WT + (size_t)(n0 + n) * ldt + k0 + 8 * c) = o; }
    LDS_WAIT(); asm volatile("" ::: "memory");
}
constexpr int I_IN = 16 * 96, I_OUT = 16 * 32, I_PW = 4 * 8, I_G = 4 * 2, I_L = I_IN + I_OUT + I_PW + 2 * I_G;
__device__ __forceinline__ void convert_item(Frame& F, int l, int r) {
    CArgs* A = get_args(); const float* norm_g = A->in[I_NORM_G]; const float* w_in = A->in[I_W_IN]; const float* a_pw = A->in[I_A_PW]; const float* c_w_r = A->in[I_C_W_R]; const float* c_w_i = A->in[I_C_W_I]; const float* w_out = A->in[I_W_OUT];
    bf16_t* WtIn = WSP(bf16_t, WS_WIN); bf16_t* WtOut = WSP(bf16_t, WS_WOUT); bf16_t* ApwT = WSP(bf16_t, WS_APW); bf16_t* WrT = WSP(bf16_t, WS_WR); bf16_t* WiT = WSP(bf16_t, WS_WI);
    LAS float* scr = (LAS float*)(F.lds + F.wave * 16384);
    if (r < I_IN) { const int kb = r / 96, nb = r % 96; transpose_item<true>(w_in + (size_t)l * DM * NIN, NIN, norm_g + l * DM, WtIn + (size_t)l * NP * DM, DM, 64 * kb, 32 * nb, scr, F.lane); return; } r -= I_IN;
    if (r < I_OUT) { const int kb = r / 32, nb = r % 32; transpose_item<false>(w_out + (size_t)l * DM * DM, DM, nullptr, WtOut + (size_t)l * DM * DM, DM, 64 * kb, 32 * nb, scr, F.lane); return; } r -= I_OUT;
    if (r < I_PW) { const int kb = r / 8, nb = r % 8; transpose_item<false>(a_pw + (size_t)l * 65536, 256, nullptr, ApwT + (size_t)l * 65536, 256, 64 * kb, 32 * nb, scr, F.lane); return; } r -= I_PW;
    if (r < I_G) { const int blk = r / 2, nb = r % 2; transpose_item<false>(c_w_r + (size_t)(l * 4 + blk) * 4096, 64, nullptr, WrT + (size_t)(l * 4 + blk) * 4096, 64, 0, 32 * nb, scr, F.lane); return; } r -= I_G;
    { const int blk = r / 2, nb = r % 2; transpose_item<false>(c_w_i + (size_t)(l * 4 + blk) * 4096, 64, nullptr, WiT + (size_t)(l * 4 + blk) * 4096, 64, 0, 32 * nb, scr, F.lane); }
}
__device__ __forceinline__ void p0_prologue(Frame& F) {
    CArgs* A = get_args(); const float* x = A->in[I_X]; bf16_t* XB = WSP(bf16_t, WS_XB); float* SSQ = WSP(float, WS_SSQ);
    const int gw = blockIdx.x * NWAVES + F.wave, NGW = F.G * NWAVES;
    for (int it = gw; it < I_L; it += NGW) convert_item(F, 0, it);
    { const float* rel_bias = A->in[I_REL_BIAS]; float* BT = WSP(float, WS_BIAS);
      for (int i = gw * 64 + F.lane; i < 4 * 5 * 16 * 64; i += NGW * 64) { const int e = i & 3, ln = (i >> 2) & 63, q4 = (i >> 8) & 3, kt = (i >> 10) % 5, hd = (i >> 10) / 5;
          const int dist = (ln & 31) - (e + 8 * q4) - 4 * (ln >> 5) + 128 - 32 * kt; float v = -INFINITY;
          if (dist >= 0 && dist < 128) { int bucket = dist; if (dist >= 16) { bucket = 16 + (int)(logf((float)dist / 16.0f) / 2.0794415416798357f * 16.0f); bucket = bucket < 31 ? bucket : 31; } v = rel_bias[bucket * 4 + hd]; }
          BT[i] = v; } }
    for (int m = gw; m < M; m += 2 * NGW) {
        const f32x4* xr0 = (const f32x4*)(x + (size_t)m * DM) + F.lane; const int m1 = (m + NGW < M) ? m + NGW : m; const f32x4* xr1 = (const f32x4*)(x + (size_t)m1 * DM) + F.lane; f32x4 v0[4], v1[4]; float s0 = 0.f, s1 = 0.f;
#pragma unroll
        for (int j = 0; j < 4; ++j) { v0[j] = xr0[64 * j]; v1[j] = xr1[64 * j]; }
#pragma unroll
        for (int j = 0; j < 4; ++j) { s0 += (v0[j].x * v0[j].x + v0[j].y * v0[j].y) + (v0[j].z * v0[j].z + v0[j].w * v0[j].w); s1 += (v1[j].x * v1[j].x + v1[j].y * v1[j].y) + (v1[j].z * v1[j].z + v1[j].w * v1[j].w); }
        s0 = wave_sum(s0); s1 = wave_sum(s1);
        u32x2* o0 = (u32x2*)(XB + (size_t)m * DM) + F.lane; u32x2* o1 = (u32x2*)(XB + (size_t)m1 * DM) + F.lane;
#pragma unroll
        for (int j = 0; j < 4; ++j) { u32x2 w; w.x = pk2(v0[j].x, v0[j].y); w.y = pk2(v0[j].z, v0[j].w); o0[64 * j] = w; w.x = pk2(v1[j].x, v1[j].y); w.y = pk2(v1[j].z, v1[j].w); o1[64 * j] = w; }
        if (F.lane < 16) { SSQ[(size_t)m * 16 + F.lane] = (F.lane == 0) ? s0 : 0.f; SSQ[(size_t)m1 * 16 + F.lane] = (F.lane == 0) ? s1 : 0.f; }
    }
}

constexpr int A_TA = 64, A_ROWS = A_TA + 30, A_S_OFF = A_ROWS * 512, A_S_STRIDE = 528;
__device__ __forceinline__ void mixer_a(Frame& F, int l, int unit) {
    CArgs* A = get_args(); const float* a_conv_w = A->in[I_A_CONV_W]; const float* a_conv_b = A->in[I_A_CONV_B]; const float* a_ln_g = A->in[I_A_LN_G]; const float* a_ln_b = A->in[I_A_LN_B]; bf16_t* ApwT = WSP(bf16_t, WS_APW); bf16_t* Y = WSP(bf16_t, WS_Y); bf16_t* PROJ = WSP(bf16_t, WS_PROJ);
    LAS unsigned char* lds = F.lds; const int tid = F.tid, lane = F.lane, w = F.wave;
    const int b = unit >> 6, t0 = (unit & 63) * A_TA; const size_t m0 = (size_t)b * SEQ + t0;
    const int pA = tid & 127, tgA = tid >> 7, c0A = 2 * pA;
    float w0[31], w1[31];
#pragma unroll
    for (int j = 0; j < 31; ++j) { const f32x2 ww = *(const f32x2*)(a_conv_w + ((size_t)l * 31 + j) * 256 + c0A); w0[j] = ww.x; w1[j] = ww.y; }
    const f32x2 cb = *(const f32x2*)(a_conv_b + l * 256 + c0A), lg = *(const f32x2*)(a_ln_g + l * 256 + c0A), lb = *(const f32x2*)(a_ln_b + l * 256 + c0A);
    { u32x4 vw[6], gw[6];
#pragma unroll
      for (int k = 0; k < 6; ++k) { const int it = tid + k * NTHR, itc = it < A_ROWS * 32 ? it : A_ROWS * 32 - 1, r = itc >> 5, p = itc & 31, tok = t0 + r - 30, tokc = tok < 0 ? 0 : tok;
          const bf16_t* rp = PROJ + ((size_t)b * SEQ + tokc) * NP + 8 * p; vw[k] = *(const u32x4*)(rp + PC_AVAL); gw[k] = *(const u32x4*)(rp + PC_AGLU); }
#pragma unroll
      for (int k = 0; k < 6; ++k) { const int it = tid + k * NTHR, r = it >> 5, p = it & 31, tok = t0 + r - 30;
          float v[8], g[8]; unpack8(vw[k], v); unpack8(gw[k], g);
#pragma unroll
          for (int j = 0; j < 8; ++j) v[j] = tok < 0 ? 0.f : v[j] * sigm(g[j]);
          if (it < A_ROWS * 32) *(LAS u32x4*)(lds + r * 512 + p * 16) = pack8(v); } }
    __syncthreads();
    bf16x8 af[16];
    { const bf16_t* ap = ApwT + (size_t)l * 65536 + (size_t)(32 * w + (lane & 31)) * 256 + 8 * (lane >> 5);
#pragma unroll
      for (int ks = 0; ks < 16; ++ks) af[ks] = *(const bf16x8*)(ap + 16 * ks); }
    { const int p = pA, tg = tgA;
#pragma unroll 1
      for (int blk = 0; blk < 2; ++blk) { const int base = 16 * tg + 8 * blk;
        f32x2 in[38];
#pragma unroll
        for (int i = 0; i < 38; ++i) { const unsigned wv = *(const LAS unsigned*)(lds + (base + i) * 512 + p * 4); in[i] = (f32x2){bf_lo(wv), bf_hi(wv)}; }
        f32x2 acc[8];
#pragma unroll
        for (int o = 0; o < 8; ++o) acc[o] = cb;
#pragma unroll
        for (int j = 0; j < 31; ++j) { const f32x2 wj = {w0[j], w1[j]};
#pragma unroll
            for (int o = 0; o < 8; ++o) acc[o] = __builtin_elementwise_fma(wj, in[o + j], acc[o]); }
        float sv[8], qv[8];
#pragma unroll
        for (int o = 0; o < 8; ++o) { sv[o] = acc[o].x + acc[o].y; qv[o] = acc[o].x * acc[o].x + acc[o].y * acc[o].y; }
#pragma unroll
        for (int o = 0; o < 8; ++o) { sv[o] = sum32(sv[o]); qv[o] = sum32(qv[o]); }
#pragma unroll
        for (int o = 0; o < 8; ++o) { const float mean = sv[o] * (1.f / 64.f), var = fmaxf(qv[o] * (1.f / 64.f) - mean * mean, 0.f), rstd = rsq(var + EPS);
            const float v0 = (acc[o].x - mean) * rstd * lg.x + lb.x, v1 = (acc[o].y - mean) * rstd * lg.y + lb.y;
            *(LAS unsigned*)(lds + A_S_OFF + (base + o) * A_S_STRIDE + p * 4) = pk2(silu(v0), silu(v1)); } } }
    __syncthreads();
    { const int r = lane & 31, h = lane >> 5;
      u32x2 gwA[2][4];
#pragma unroll
      for (int tt = 0; tt < 2; ++tt)
#pragma unroll
          for (int g4 = 0; g4 < 4; ++g4) gwA[tt][g4] = *(const u32x2*)(PROJ + (m0 + 32 * tt + r) * NP + PC_AGATE + 32 * w + 8 * g4 + 4 * h);
      f32x16 acc[2];
#pragma unroll
      for (int tt = 0; tt < 2; ++tt) { acc[tt] = (f32x16)(0.f);
#pragma unroll
          for (int ks = 0; ks < 16; ++ks) { const bf16x8 bfr = *(const LAS bf16x8*)(lds + A_S_OFF + (32 * tt + r) * A_S_STRIDE + (16 * ks + 8 * h) * 2); acc[tt] = MFMA32(af[ks], bfr, acc[tt]); } }
#pragma unroll
      for (int tt = 0; tt < 2; ++tt) { const size_t tok = m0 + 32 * tt + r;
#pragma unroll
          for (int g4 = 0; g4 < 4; ++g4) { const int n = 32 * w + 8 * g4 + 4 * h; const u32x2 gw = gwA[tt][g4];
              u32x2 o; o.x = pk2(acc[tt][4 * g4 + 0] * silu(bf_lo(gw.x)), acc[tt][4 * g4 + 1] * silu(bf_hi(gw.x))); o.y = pk2(acc[tt][4 * g4 + 2] * silu(bf_lo(gw.y)), acc[tt][4 * g4 + 3] * silu(bf_hi(gw.y)));
              *(u32x2*)(Y + tok * DM + n) = o; } } }
    __syncthreads();
}

constexpr int B_VT_OFF = 256 * 144, B_VT_STRIDE = 536;
__device__ __forceinline__ void mixer_b(Frame& F, int l, int unit) {
    CArgs* A = get_args(); const float* b_q_g = A->in[I_B_Q_G]; const float* b_k_g = A->in[I_B_K_G]; const float* b_sinks = A->in[I_B_SINKS]; bf16_t* Y = WSP(bf16_t, WS_Y); bf16_t* PROJ = WSP(bf16_t, WS_PROJ);
    LAS unsigned char* lds = F.lds; const int tid = F.tid, lane = F.lane, w = F.wave;
    const int b = unit >> 6, qb = (unit >> 1) & 31, kvh = unit & 1, t0 = qb * 128;
    { float kg[8]; const int pc = tid & 7;
#pragma unroll
      for (int j = 0; j < 8; ++j) kg[j] = b_k_g[l * 64 + 8 * pc + j];
#pragma unroll
      for (int it = 0; it < 4; ++it) { const int i = it * NTHR + tid, key = i >> 3, tok = t0 - 128 + key; u32x4 kw = (u32x4){0u, 0u, 0u, 0u}, vw = kw;
        { const int tokc = tok < 0 ? 0 : tok; const bf16_t* rp = PROJ + ((size_t)b * SEQ + tokc) * NP + kvh * 64 + 8 * pc; kw = *(const u32x4*)(rp + PC_BK); vw = *(const u32x4*)(rp + PC_BV);
          if (tok < 0) { kw = (u32x4){0u, 0u, 0u, 0u}; vw = kw; } }
        float kf[8]; unpack8(kw, kf); float ss = 0.f;
#pragma unroll
        for (int j = 0; j < 8; ++j) ss = fmaf(kf[j], kf[j], ss);
        ss = sum8(ss);
        const float rs = rsq(ss * (1.f / 64.f) + EPS);
#pragma unroll
        for (int j = 0; j < 8; ++j) kf[j] = kf[j] * rs * kg[j];
        *(LAS u32x4*)(lds + key * 144 + pc * 16) = pack8(kf);
        const unsigned vv[4] = {vw.x, vw.y, vw.z, vw.w};
#pragma unroll
        for (int j = 0; j < 8; ++j) *(LAS bf16_t*)(lds + B_VT_OFF + (8 * pc + j) * B_VT_STRIDE + key * 2) = (bf16_t)((vv[j >> 1] >> (16 * (j & 1))) & 0xffffu); } }
    const int g = w >> 2, s = w & 3, head = 2 * kvh + g, r = lane & 31, h = lane >> 5;
    const size_t tokq = (size_t)b * SEQ + t0 + 32 * s + r;
    bf16x8 qf[4];
    { float q[32]; const bf16_t* qrow = PROJ + tokq * NP + PC_BQ + head * 64 + 8 * h; float ss = 0.f;
#pragma unroll
      for (int ks = 0; ks < 4; ++ks) { const u32x4 wv = *(const u32x4*)(qrow + 16 * ks); float t8[8]; unpack8(wv, t8);
#pragma unroll
          for (int j = 0; j < 8; ++j) { q[8 * ks + j] = t8[j]; ss = fmaf(t8[j], t8[j], ss); } }
      ss = xsum32(ss);
      const float rs = rsq(ss * (1.f / 64.f) + EPS) * 0.125f;
#pragma unroll
      for (int ks = 0; ks < 4; ++ks) { float t8[8];
#pragma unroll
          for (int j = 0; j < 8; ++j) t8[j] = q[8 * ks + j] * rs * b_q_g[l * 64 + 16 * ks + 8 * h + j];
          qf[ks] = as_frag(pack8(t8)); } }
    u32x2 gwB[2][4];
#pragma unroll
    for (int et = 0; et < 2; ++et)
#pragma unroll
        for (int g4 = 0; g4 < 4; ++g4) gwB[et][g4] = *(const u32x2*)(PROJ + tokq * NP + PC_BGATE + head * 64 + 32 * et + 8 * g4 + 4 * h);
    f32x16 S[5];
    { const f32x4* bt = (const f32x4*)(WSP(float, WS_BIAS)) + (size_t)head * 5 * 4 * 64 + lane;
#pragma unroll
      for (int kt = 0; kt < 5; ++kt)
#pragma unroll
          for (int q4 = 0; q4 < 4; ++q4) { const f32x4 v = bt[(kt * 4 + q4) * 64]; S[kt][4 * q4 + 0] = v.x; S[kt][4 * q4 + 1] = v.y; S[kt][4 * q4 + 2] = v.z; S[kt][4 * q4 + 3] = v.w; } }
    __syncthreads();
#pragma unroll
    for (int kt = 0; kt < 5; ++kt) { const int kb = 32 * (s + kt);
#pragma unroll
        for (int ks = 0; ks < 4; ++ks) { const bf16x8 a = *(const LAS bf16x8*)(lds + (kb + r) * 144 + (16 * ks + 8 * h) * 2); S[kt] = MFMA32(a, qf[ks], S[kt]); } }
    const float sink = b_sinks[l * 4 + head]; float mx = sink;
#pragma unroll
    for (int kt = 0; kt < 5; ++kt) { const bool dead = (t0 == 0) && (s + kt < 4);
#pragma unroll
        for (int rg = 0; rg < 16; ++rg) { const float v = dead ? -INFINITY : S[kt][rg]; S[kt][rg] = v; mx = fmaxf(mx, v); } }
    mx = xmax32(mx);
    float sum = 0.f;
#pragma unroll
    for (int kt = 0; kt < 5; ++kt)
#pragma unroll
        for (int rg = 0; rg < 16; ++rg) { const float p = fexp(S[kt][rg] - mx); S[kt][rg] = p; sum += p; }
    sum = xsum32(sum);
    const float inv = 1.0f / (sum + fexp(sink - mx));
    f32x16 O[2]; O[0] = (f32x16)(0.f); O[1] = (f32x16)(0.f);
#define B_PV(kt, SP) do { const bf16x8 pf = frag_acc<8 * SP>(S[kt]); const int kb = 32 * (s + kt) + 16 * SP + 4 * h; \
        _Pragma("unroll") for (int et = 0; et < 2; ++et) { const LAS unsigned char* vp = lds + B_VT_OFF + (32 * et + r) * B_VT_STRIDE + kb * 2; \
            const u32x2 lo = *(const LAS u32x2*)vp, hi = *(const LAS u32x2*)(vp + 16); O[et] = MFMA32(as_frag((u32x4){lo.x, lo.y, hi.x, hi.y}), pf, O[et]); } } while (0)
#pragma unroll
    for (int kt = 0; kt < 5; ++kt) { B_PV(kt, 0); B_PV(kt, 1); }
#undef B_PV
#pragma unroll
    for (int et = 0; et < 2; ++et)
#pragma unroll
        for (int g4 = 0; g4 < 4; ++g4) { const int d = 32 * et + 8 * g4 + 4 * h; const u32x2 gw = gwB[et][g4];
            u32x2 o; o.x = pk2(O[et][4 * g4 + 0] * inv * silu(bf_lo(gw.x)), O[et][4 * g4 + 1] * inv * silu(bf_hi(gw.x))); o.y = pk2(O[et][4 * g4 + 2] * inv * silu(bf_lo(gw.y)), O[et][4 * g4 + 3] * inv * silu(bf_hi(gw.y)));
            *(u32x2*)(Y + tokq * DM + 256 + head * 64 + d) = o; }
    __syncthreads();
}
constexpr int C_AA = 128 * 144, C_UU = C_AA + 64 * 129 * 4, C_SEG = C_UU + 64 * 129 * 4, C_CARRY = C_SEG + 4096, C_CST = C_CARRY + 512, C_LOOK = C_CST + 1024;
constexpr unsigned SPIN_CAP = 1u << 16;
__device__ __forceinline__ void gr_store(unsigned long long* g, unsigned tag, float v) { __hip_atomic_store(g, ((unsigned long long)tag << 32) | (unsigned long long)__float_as_uint(v), __ATOMIC_RELAXED, __HIP_MEMORY_SCOPE_AGENT); }
__device__ __forceinline__ unsigned long long gr_load(const unsigned long long* g) { return __hip_atomic_load(g, __ATOMIC_RELAXED, __HIP_MEMORY_SCOPE_AGENT); }
__device__ __forceinline__ void mixer_c(Frame& F, int l, int unit, unsigned* qh, unsigned& nxt) {
    CArgs* A = get_args(); const float* c_conv_w = A->in[I_C_CONV_W]; const float* c_conv_b = A->in[I_C_CONV_B]; const float* c_b_r = A->in[I_C_B_R]; const float* c_b_i = A->in[I_C_B_I]; const float* c_lambda = A->in[I_C_LAMBDA]; bf16_t* WrT = WSP(bf16_t, WS_WR); bf16_t* WiT = WSP(bf16_t, WS_WI); bf16_t* Y = WSP(bf16_t, WS_Y); bf16_t* PROJ = WSP(bf16_t, WS_PROJ);
    unsigned long long* GC = WSP(unsigned long long, WS_GC);
    LAS unsigned char* lds = F.lds; const int tid = F.tid, lane = F.lane, w = F.wave;
    const int tile = unit >> 4, b = (unit >> 2) & 3, n = unit & 3, t0 = tile * 128; const unsigned tag = (unsigned)l + 1u;
    LAS float* Aa = (LAS float*)(lds + C_AA); LAS float* Uu = (LAS float*)(lds + C_UU); LAS float* SegX = (LAS float*)(lds + C_SEG); LAS float* Carry = (LAS float*)(lds + C_CARRY); LAS float* Cst = (LAS float*)(lds + C_CST); LAS float* LookY = (LAS float*)(lds + C_LOOK);
    const int pc = tid & 7, trow = tid >> 3;
    const int tt = w & 3, mt = w >> 2, r = lane & 31, h = lane >> 5;
    const int sc = tid & 63, seg = tid >> 6;
    u32x4 gwC[2];
#pragma unroll
    for (int it = 0; it < 2; ++it) gwC[it] = *(const u32x4*)(PROJ + ((size_t)b * SEQ + t0 + trow + 64 * it) * NP + PC_CGATE + 64 * n + 8 * pc);
    if (tid < 64) { const int cg = l * 256 + 64 * n + tid;
        Cst[4 * tid + 0] = c_b_r[cg]; Cst[4 * tid + 1] = c_b_i[cg]; Cst[4 * tid + 2] = -8.0f * log1pf(expf(-c_lambda[cg])); Cst[4 * tid + 3] = 0.f; }
    { float cw[4][8], cb[8];
#pragma unroll
      for (int j = 0; j < 8; ++j) { cb[j] = c_conv_b[l * 256 + 64 * n + 8 * pc + j];
#pragma unroll
          for (int jj = 0; jj < 4; ++jj) cw[jj][j] = c_conv_w[((size_t)l * 4 + jj) * 256 + 64 * n + 8 * pc + j]; }
#pragma unroll
      for (int it = 0; it < 2; ++it) { const int t = trow + 64 * it, tok = t0 + t; float acc[8];
#pragma unroll
          for (int j = 0; j < 8; ++j) acc[j] = cb[j];
#pragma unroll
          for (int jj = 0; jj < 4; ++jj) { const int tk = tok - 3 + jj, tkc = tk < 0 ? 0 : tk;
              const u32x4 wv = *(const u32x4*)(PROJ + ((size_t)b * SEQ + tkc) * NP + PC_CX + 64 * n + 8 * pc); float x8[8]; unpack8(wv, x8); const float m = tk < 0 ? 0.f : 1.f;
#pragma unroll
              for (int j = 0; j < 8; ++j) acc[j] = fmaf(cw[jj][j] * m, x8[j], acc[j]); }
          *(LAS u32x4*)(lds + t * 144 + pc * 16) = pack8(acc); } }
    __syncthreads();
    { bf16x8 wrf[4], wif[4];
#pragma unroll
      for (int ks = 0; ks < 4; ++ks) { const size_t o = ((size_t)(l * 4 + n) * 64 + 32 * mt + r) * 64 + 16 * ks + 8 * h; wrf[ks] = *(const bf16x8*)(WrT + o); wif[ks] = *(const bf16x8*)(WiT + o); }
      f32x16 R = (f32x16)(0.f), I = (f32x16)(0.f);
#pragma unroll
      for (int ks = 0; ks < 4; ++ks) { const bf16x8 bfr = *(const LAS bf16x8*)(lds + (32 * tt + r) * 144 + (16 * ks + 8 * h) * 2); R = MFMA32(wrf[ks], bfr, R); I = MFMA32(wif[ks], bfr, I); }
      const int t = 32 * tt + r;
#pragma unroll
      for (int g4 = 0; g4 < 4; ++g4) { const int c0 = 32 * mt + 8 * g4 + 4 * h; const u32x2 xw = *(const LAS u32x2*)(lds + t * 144 + c0 * 2);
          const float xc[4] = {bf_lo(xw.x), bf_hi(xw.x), bf_lo(xw.y), bf_hi(xw.y)};
#pragma unroll
          for (int j = 0; j < 4; ++j) { const f32x4 cs = *(const LAS f32x4*)(Cst + 4 * (c0 + j));
              const float rr = sigm(R[4 * g4 + j] + cs.x), ii = sigm(I[4 * g4 + j] + cs.y), la = cs.z * rr, a = fexp(la), u = __builtin_amdgcn_sqrtf(fmaxf(one_minus_exp(2.0f * la), 0.f)) * (ii * xc[j]);
              Aa[(c0 + j) * 129 + t] = a; Uu[(c0 + j) * 129 + t] = u; }
          __builtin_amdgcn_sched_barrier(0); } }
    __syncthreads();
    float a[16], u[16];
    { float Ap = 1.f, Hp = 0.f;
#pragma unroll
      for (int i = 0; i < 16; ++i) { a[i] = Aa[sc * 129 + 16 * seg + i]; u[i] = Uu[sc * 129 + 16 * seg + i]; }
#pragma unroll
      for (int i = 0; i < 16; ++i) { Hp = fmaf(a[i], Hp, u[i]); Ap *= a[i]; }
      SegX[(seg * 64 + sc) * 2] = Ap; SegX[(seg * 64 + sc) * 2 + 1] = Hp; }
    __syncthreads();
    { unsigned long long* gbase = GC + ((size_t)((b * 4 + n) * 32) * 128) + 2 * lane;
      if (w == 0) { float At = 1.f, Ht = 0.f;
#pragma unroll
          for (int s2 = 0; s2 < 8; ++s2) { const float As = SegX[(s2 * 64 + lane) * 2], Hs = SegX[(s2 * 64 + lane) * 2 + 1]; Ht = fmaf(As, Ht, Hs); At *= As; }
          gr_store(gbase + (size_t)tile * 128, tag, At); gr_store(gbase + (size_t)tile * 128 + 1, tag, Ht); }
      float Aw = 1.f, Hw = 0.f; const int p0 = 4 * w;
      if (p0 < tile) { unsigned long long ga[4], gh[4]; unsigned spins = 0;
          for (;;) { bool ok = true;
#pragma unroll
              for (int k = 0; k < 4; ++k) { const int p = (p0 + k < tile) ? p0 + k : tile - 1; ga[k] = gr_load(gbase + (size_t)p * 128); gh[k] = gr_load(gbase + (size_t)p * 128 + 1);
                  ok = ok && ((unsigned)(ga[k] >> 32) == tag) && ((unsigned)(gh[k] >> 32) == tag); }
              if (__all(ok) || ++spins > SPIN_CAP) break;
              __builtin_amdgcn_s_sleep(2); }
#pragma unroll
          for (int k = 0; k < 4; ++k) if (p0 + k < tile) { const float Ap = __uint_as_float((unsigned)ga[k]), Hp = __uint_as_float((unsigned)gh[k]); Hw = fmaf(Ap, Hw, Hp); Aw *= Ap; } }
      LookY[(w * 64 + lane) * 2] = Aw; LookY[(w * 64 + lane) * 2 + 1] = Hw; }
    __syncthreads();
    if (tid == 0) nxt = __hip_atomic_fetch_add(qh, 1u, __ATOMIC_RELAXED, __HIP_MEMORY_SCOPE_AGENT);
    { float hh = 0.f;
#pragma unroll
      for (int w2 = 0; w2 < 8; ++w2) hh = fmaf(LookY[(w2 * 64 + sc) * 2], hh, LookY[(w2 * 64 + sc) * 2 + 1]);
      for (int s2 = 0; s2 < seg; ++s2) hh = fmaf(SegX[(s2 * 64 + sc) * 2], hh, SegX[(s2 * 64 + sc) * 2 + 1]);
#pragma unroll
      for (int i = 0; i < 16; ++i) { hh = fmaf(a[i], hh, u[i]); Uu[sc * 129 + 16 * seg + i] = hh; } }
    __syncthreads();
#pragma unroll
    for (int it = 0; it < 2; ++it) { const int t = trow + 64 * it; const size_t tokg = (size_t)b * SEQ + t0 + t;
        float g8[8], y8[8]; unpack8(gwC[it], g8);
#pragma unroll
        for (int j = 0; j < 8; ++j) y8[j] = Uu[(8 * pc + j) * 129 + t] * silu(g8[j]);
        *(u32x4*)(Y + tokg * DM + 512 + 64 * n + 8 * pc) = pack8(y8); }
    __syncthreads();
}

typedef short s16x4 __attribute__((ext_vector_type(4)));
__device__ __forceinline__ u32x2 tr_read4(const LAS unsigned char* p) { const s16x4 v = __builtin_amdgcn_ds_read_tr16_b64_v4i16((LAS s16x4*)p); return __builtin_bit_cast(u32x2, v); }

constexpr int D_WAVE = 14464, D_VT = 5120, D_DEC = 14336, D_SST = 8 * D_WAVE, D_SIN = D_SST  , D_PDL = D_SST + 8192;
static_assert(D_PDL + 128 <= RING_BYTES, "mixer D LDS map");
constexpr int GD_STRIDE = 2112;
__device__ __forceinline__ void mixer_d(Frame& F, int l, int unit) {
    CArgs* A = get_args(); const float* d_w_up = A->in[I_D_W_UP]; const float* d_b_up = A->in[I_D_B_UP]; const float* d_norm_g = A->in[I_D_NORM_G]; bf16_t* Y = WSP(bf16_t, WS_Y); bf16_t* PROJ = WSP(bf16_t, WS_PROJ);
    unsigned long long* GD = WSP(unsigned long long, WS_GD);
    const int tid = F.tid, lane = F.lane, w = F.wave;
    const int grp = unit >> 4, b = (unit >> 2) & 3, head = unit & 3, r = lane & 31, h = lane >> 5; const unsigned tag = (unsigned)l + 1u;
    LAS unsigned char* scr = F.lds + w * D_WAVE; LAS unsigned char* VT = scr + D_VT; LAS float* Dec = (LAS float*)(scr + D_DEC); LAS f32x4* Sst = (LAS f32x4*)(F.lds + D_SST); LAS f32x4* Sin = (LAS f32x4*)(F.lds + D_SIN); LAS float* Pdl = (LAS float*)(F.lds + D_PDL);
    bf16x8 wupf; { float t8[8];
#pragma unroll
        for (int j = 0; j < 8; ++j) t8[j] = d_w_up[((size_t)l * 16 + 8 * h + j) * 128 + 32 * head + r];
        wupf = as_frag(pack8(t8)); }
    const float bup = d_b_up[l * 128 + 32 * head + r];
    Sst[tid] = (f32x4){0.f, 0.f, 0.f, 0.f}; if (tid < 32) Pdl[tid] = 1.f;
    __syncthreads();
    const int chunk = 8 * grp + w; const size_t mrow0 = (size_t)b * SEQ + 64 * chunk;
    float qv[32], kv[32], bb[32];
    f32x16 G[2];
#pragma unroll
    for (int tile = 0; tile < 2; ++tile) { const bf16x8 lrf = *(const bf16x8*)(PROJ + (mrow0 + 32 * tile + r) * NP + PC_DLR + 8 * h); G[tile] = MFMA32(lrf, wupf, (f32x16)(0.f)); }
    { const bf16_t* qbase = PROJ + mrow0 * NP + PC_DQ + 32 * head; const unsigned loff = (unsigned)(4 * h * NP + r);
#pragma unroll
      for (int i = 0; i < 32; ++i) { const unsigned o = loff + (unsigned)((32 * (i >> 4) + 8 * ((i >> 2) & 3) + (i & 3)) * NP);
          qv[i] = __uint_as_float((unsigned)qbase[o] << 16); kv[i] = __uint_as_float((unsigned)qbase[o + (PC_DK - PC_DQ)] << 16); } }
    float run = 0.f;
#pragma unroll
    for (int k = 0; k < 8; ++k) { float c[4];
#pragma unroll
        for (int j = 0; j < 4; ++j) { const float z = G[k >> 2][4 * (k & 3) + j] + bup; const float gl = -(fmaxf(-z, 0.f) + log1p_01(fexp(-fabsf(z)))) * (1.f / 16.f); c[j] = (j ? c[j - 1] : 0.f) + gl; }
        const float tot = c[3], ptot = xget32(tot, h); const float pre = run + (h ? ptot : 0.f);
#pragma unroll
        for (int j = 0; j < 4; ++j) bb[4 * k + j] = pre + c[j];
        run += tot + ptot; }
    const float blast = run, dec = fexp(blast);
    if (h == 0) Dec[r] = dec;
#pragma unroll
    for (int i = 0; i < 32; ++i) { const int t = 32 * (i >> 4) + 8 * ((i >> 2) & 3) + 4 * h + (i & 3); *(LAS bf16_t*)(scr + t * 80 + r * 2) = (bf16_t)f2bf(qv[i] * 0.17677669529663687f * fexp(bb[i])); }
    __builtin_amdgcn_wave_barrier(); asm volatile("" ::: "memory");
    bf16x8 qB[2][2], qP[2][2];
#pragma unroll
    for (int it = 0; it < 2; ++it)
#pragma unroll
        for (int ks = 0; ks < 2; ++ks) { const LAS unsigned char* p = scr + (32 * it + r) * 80; qB[it][ks] = *(const LAS bf16x8*)(p + (16 * ks + 8 * h) * 2);
            const u32x2 lo = *(const LAS u32x2*)(p + (16 * ks + 4 * h) * 2), hi = *(const LAS u32x2*)(p + (16 * ks + 8 + 4 * h) * 2); qP[it][ks] = as_frag((u32x4){lo.x, lo.y, hi.x, hi.y}); }
    __builtin_amdgcn_wave_barrier(); asm volatile("" ::: "memory");
#pragma unroll
    for (int i = 0; i < 32; ++i) { const int t = 32 * (i >> 4) + 8 * ((i >> 2) & 3) + 4 * h + (i & 3); *(LAS bf16_t*)(scr + t * 80 + r * 2) = (bf16_t)f2bf(kv[i] * fexp(-bb[i])); }
    __builtin_amdgcn_wave_barrier(); asm volatile("" ::: "memory");
    bf16x8 kA[2][2];
#pragma unroll
    for (int jt = 0; jt < 2; ++jt)
#pragma unroll
        for (int ks = 0; ks < 2; ++ks) kA[jt][ks] = *(const LAS bf16x8*)(scr + (32 * jt + r) * 80 + (16 * ks + 8 * h) * 2);
    __builtin_amdgcn_wave_barrier(); asm volatile("" ::: "memory");
#pragma unroll
    for (int k = 0; k < 8; ++k) { const int t = 32 * (k >> 2) + 8 * (k & 3) + 4 * h; u32x2 o;
        o.x = pk2(kv[4 * k + 0] * fexp(blast - bb[4 * k + 0]), kv[4 * k + 1] * fexp(blast - bb[4 * k + 1])); o.y = pk2(kv[4 * k + 2] * fexp(blast - bb[4 * k + 2]), kv[4 * k + 3] * fexp(blast - bb[4 * k + 3]));
        *(LAS u32x2*)(scr + r * 144 + t * 2) = o; }
    __builtin_amdgcn_wave_barrier(); asm volatile("" ::: "memory");
    bf16x8 keA[4];
#pragma unroll
    for (int ks = 0; ks < 4; ++ks) keA[ks] = *(const LAS bf16x8*)(scr + r * 144 + (16 * ks + 8 * h) * 2);
#pragma unroll
    for (int i8 = 0; i8 < 8; ++i8) { const int tv = 8 * i8 + (lane >> 3), pc = lane & 7; const u32x4 vw = *(const u32x4*)(PROJ + (mrow0 + tv) * NP + PC_DV + 64 * head + 8 * pc);
        *(LAS u32x4*)(VT + tv * 144 + pc * 16) = vw; }
    const LAS unsigned char* vrb = VT + ((lane & 15) >> 2) * 144 + (16 * ((lane >> 4) & 1) + 4 * (lane & 3)) * 2;
    __builtin_amdgcn_wave_barrier(); asm volatile("" ::: "memory");
    bf16x8 P[3][2];
#define D_ATT(idx, jt, it) do { f32x16 acc = (f32x16)(0.f); acc = MFMA32(kA[jt][0], qB[it][0], acc); acc = MFMA32(kA[jt][1], qB[it][1], acc); \
    if (jt == it) { const int rr = r - 4 * h; _Pragma("unroll") for (int rg = 0; rg < 16; ++rg) { acc[rg] = (rr < (rg & 3) + 8 * (rg >> 2)) ? 0.f : acc[rg]; } } \
    P[idx][0] = frag_acc<0>(acc); P[idx][1] = frag_acc<8>(acc); } while (0)
    D_ATT(0, 0, 0); __builtin_amdgcn_sched_barrier(0); D_ATT(1, 0, 1); __builtin_amdgcn_sched_barrier(0); D_ATT(2, 1, 1); __builtin_amdgcn_sched_barrier(0);
#undef D_ATT
    f32x16 ds[2];
#pragma unroll
    for (int et = 0; et < 2; ++et) { ds[et] = (f32x16)(0.f);
#pragma unroll
        for (int ks = 0; ks < 4; ++ks) { const LAS unsigned char* vp = vrb + (16 * ks + 8 * h) * 144 + 64 * et; const u32x2 lo = tr_read4(vp), hi = tr_read4(vp + 4 * 144);
            ds[et] = MFMA32(keA[ks], as_frag((u32x4){lo.x, lo.y, hi.x, hi.y}), ds[et]); } }
    f32x16 L[2]; float pdv[16], dv[16];
#pragma unroll
    for (int q4 = 0; q4 < 4; ++q4) { const f32x4 v = *(const LAS f32x4*)(Dec + 8 * q4 + 4 * h); dv[4 * q4 + 0] = v.x; dv[4 * q4 + 1] = v.y; dv[4 * q4 + 2] = v.z; dv[4 * q4 + 3] = v.w; }
#pragma unroll 1
    for (int step = 0; step < 8; ++step) {
        if (w == step) {
#pragma unroll
            for (int q4 = 0; q4 < 4; ++q4) { const f32x4 v = *(const LAS f32x4*)(Pdl + 8 * q4 + 4 * h); pdv[4 * q4 + 0] = v.x; pdv[4 * q4 + 1] = v.y; pdv[4 * q4 + 2] = v.z; pdv[4 * q4 + 3] = v.w; }
#pragma unroll
            for (int et = 0; et < 2; ++et)
#pragma unroll
                for (int q4 = 0; q4 < 4; ++q4) { const f32x4 v = Sst[(et * 4 + q4) * 64 + lane]; L[et][4 * q4 + 0] = v.x; L[et][4 * q4 + 1] = v.y; L[et][4 * q4 + 2] = v.z; L[et][4 * q4 + 3] = v.w;
                    f32x4 nv; nv.x = fmaf(v.x, dv[4 * q4 + 0], ds[et][4 * q4 + 0]); nv.y = fmaf(v.y, dv[4 * q4 + 1], ds[et][4 * q4 + 1]); nv.z = fmaf(v.z, dv[4 * q4 + 2], ds[et][4 * q4 + 2]); nv.w = fmaf(v.w, dv[4 * q4 + 3], ds[et][4 * q4 + 3]);
                    Sst[(et * 4 + q4) * 64 + lane] = nv; }
            if (lane < 32) Pdl[lane] = Pdl[lane] * Dec[lane]; }
        __syncthreads(); }
    { unsigned long long* gmine = GD + (size_t)((b * 4 + head) * 8 + grp) * GD_STRIDE; const f32x4 sv = Sst[tid];
      gr_store(gmine + 4 * tid + 0, tag, sv.x); gr_store(gmine + 4 * tid + 1, tag, sv.y); gr_store(gmine + 4 * tid + 2, tag, sv.z); gr_store(gmine + 4 * tid + 3, tag, sv.w);
      if (tid < 32) gr_store(gmine + 2048 + tid, tag, Pdl[tid]);
      f32x4 sin = (f32x4){0.f, 0.f, 0.f, 0.f}; const int d0 = 8 * ((tid >> 6) & 3) + 4 * ((tid >> 5) & 1);
      const unsigned long long* gb = GD + (size_t)((b * 4 + head) * 8) * GD_STRIDE;
      for (int p0 = 0; p0 < grp; p0 += 4) { unsigned long long gs[4][4], gd[4][4]; unsigned spins = 0;
          for (;;) { bool ok = true;
#pragma unroll
              for (int k = 0; k < 4; ++k) { const int p = (p0 + k < grp) ? p0 + k : grp - 1; const unsigned long long* gp = gb + (size_t)p * GD_STRIDE;
#pragma unroll
                  for (int e = 0; e < 4; ++e) { gs[k][e] = gr_load(gp + 4 * tid + e); gd[k][e] = gr_load(gp + 2048 + d0 + e); ok = ok && ((unsigned)(gs[k][e] >> 32) == tag) && ((unsigned)(gd[k][e] >> 32) == tag); } }
              if (__all(ok) || ++spins > SPIN_CAP) break;
              __builtin_amdgcn_s_sleep(2); }
#pragma unroll
          for (int k = 0; k < 4; ++k) if (p0 + k < grp) {
              sin.x = fmaf(sin.x, __uint_as_float((unsigned)gd[k][0]), __uint_as_float((unsigned)gs[k][0])); sin.y = fmaf(sin.y, __uint_as_float((unsigned)gd[k][1]), __uint_as_float((unsigned)gs[k][1]));
              sin.z = fmaf(sin.z, __uint_as_float((unsigned)gd[k][2]), __uint_as_float((unsigned)gs[k][2])); sin.w = fmaf(sin.w, __uint_as_float((unsigned)gd[k][3]), __uint_as_float((unsigned)gs[k][3])); } }
      Sin[tid] = sin; }
    __syncthreads();
    bf16x8 SA[2][2];
#pragma unroll
    for (int et = 0; et < 2; ++et) {
#pragma unroll
        for (int q4 = 0; q4 < 4; ++q4) { const f32x4 v = Sin[(et * 4 + q4) * 64 + lane]; L[et][4 * q4 + 0] = fmaf(pdv[4 * q4 + 0], v.x, L[et][4 * q4 + 0]); L[et][4 * q4 + 1] = fmaf(pdv[4 * q4 + 1], v.y, L[et][4 * q4 + 1]);
            L[et][4 * q4 + 2] = fmaf(pdv[4 * q4 + 2], v.z, L[et][4 * q4 + 2]); L[et][4 * q4 + 3] = fmaf(pdv[4 * q4 + 3], v.w, L[et][4 * q4 + 3]); }
        SA[et][0] = frag_acc<0>(L[et]); SA[et][1] = frag_acc<8>(L[et]); }
#pragma unroll
    for (int it = 0; it < 2; ++it) { f32x16 o[2]; o[0] = (f32x16)(0.f); o[1] = (f32x16)(0.f);
#pragma unroll
        for (int jt = 0; jt <= it; ++jt) { const int idx = (jt == 0) ? it : 2;
#pragma unroll
            for (int sp = 0; sp < 2; ++sp)
#pragma unroll
                for (int et = 0; et < 2; ++et) { const LAS unsigned char* vp = vrb + (32 * jt + 16 * sp + 4 * h) * 144 + 64 * et; const u32x2 lo = tr_read4(vp), hi = tr_read4(vp + 8 * 144);
                    o[et] = MFMA32(as_frag((u32x4){lo.x, lo.y, hi.x, hi.y}), P[idx][sp], o[et]); } }
#pragma unroll
        for (int ks = 0; ks < 2; ++ks)
#pragma unroll
            for (int et = 0; et < 2; ++et) o[et] = MFMA32(SA[et][ks], qP[it][ks], o[et]);
        float ss = 0.f;
#pragma unroll
        for (int et = 0; et < 2; ++et)
#pragma unroll
            for (int rg = 0; rg < 16; ++rg) ss = fmaf(o[et][rg], o[et][rg], ss);
        ss = xsum32(ss);
        const float rstd = rsq(ss * (1.f / 64.f) + EPS); const size_t tok = mrow0 + 32 * it + r;
#pragma unroll
        for (int et = 0; et < 2; ++et)
#pragma unroll
            for (int g4 = 0; g4 < 4; ++g4) { const int e = 32 * et + 8 * g4 + 4 * h; const f32x4 ng = *(const f32x4*)(d_norm_g + l * 64 + e); const u32x2 gw = *(const u32x2*)(PROJ + tok * NP + PC_DGATE + 64 * head + e);
                u32x2 ov; ov.x = pk2(o[et][4 * g4 + 0] * rstd * ng.x * silu(bf_lo(gw.x)), o[et][4 * g4 + 1] * rstd * ng.y * silu(bf_hi(gw.x)));
                ov.y = pk2(o[et][4 * g4 + 2] * rstd * ng.z * silu(bf_lo(gw.y)), o[et][4 * g4 + 3] * rstd * ng.w * silu(bf_hi(gw.y)));
                *(u32x2*)(Y + tok * DM + 768 + 64 * head + e) = ov; } }
    __syncthreads();
}

constexpr int U_D = 128, U_C = 512, U_B = 256, U_A = 256, U_MIX = U_C + U_D + U_B + U_A, U_W = (I_L + NWAVES - 1) / NWAVES;
__global__ void __launch_bounds__(NTHR, 2) fwd_kernel(Args args) {
    extern __shared__ __attribute__((aligned(16))) unsigned char lds_raw[];
    Frame F;
    F.lds = (LAS unsigned char*)lds_raw; F.MISC = (volatile LAS unsigned*)(F.lds + MISC_OFF);
    F.tid = threadIdx.x; F.lane = F.tid & 63; F.wave = __builtin_amdgcn_readfirstlane(F.tid >> 6); F.G = gridDim.x;
    for (int u = F.tid; u < 256; u += NTHR) ((LAS unsigned*)(F.lds + LDSCTL_OFF))[u] = 0u;
    __syncthreads();
    XcdBarrier bar = xcd_barrier_post((unsigned*)(args.ws + WS_CTL) + CW_BAR, F.MISC + 8);
#define GRID_BAR() xcd_barrier(bar)
    p0_prologue(F);
    GRID_BAR();
#pragma unroll 1
    for (int l = 0; l < DEPTH; ++l) {
        { CArgs* A = get_args();
          pg8::Gemm g{WSP(bf16_t, WS_XB), WSP(bf16_t, WS_WIN) + (size_t)l * NP * DM, M, NP, DM}; pg8::StaticOrder S; S.init(M, NP, F.G, (int)blockIdx.x);
          pg8::EpiProj E{WSP(bf16_t, WS_PROJ), NP, WSP(float, WS_SSQ), __builtin_amdgcn_make_buffer_rsrc(WSP(bf16_t, WS_PROJ), 0, (int)((size_t)M * NP * 2), 0x00020000)};
          pg8::gemm_phase<pg8::EpiProj, pg8::StaticOrder, true, true>(F.lds, g, S, E); }
        int all_seen = 1;
        if (F.G == 256) { all_seen = 0;
            asm volatile("s_waitcnt vmcnt(0)" ::: "memory"); __syncthreads();
            if (F.tid == 0) { const int c = (int)blockIdx.x; unsigned* ctl = (unsigned*)(args.ws + WS_CTL);
                __hip_atomic_fetch_add(ctl + CW_PCNT + 64 * (l * 64 + 8 * (c & 7) + ((c >> 3) & 7)), 1u, RLX_AGENT); __hip_atomic_fetch_add(ctl + CW_GDONE + 64 * l, 1u, RLX_AGENT); }
        } else GRID_BAR();
        { CArgs* A = get_args(); unsigned* qh = WSP(unsigned, WS_CTL) + CW_Q + 64 * l;
          __syncthreads();
          if (F.tid == 0) F.MISC[16] = __hip_atomic_fetch_add(qh, 1u, RLX_AGENT);
          __syncthreads();
          int u = (int)F.MISC[16];
          const int U_TOTAL = U_MIX + (l + 1 < DEPTH ? U_W : 0);
          while (u < U_TOTAL) {
              const bool pre = u >= U_D + U_C;
              unsigned nxt = 0u; if (pre && F.tid == 0) nxt = __hip_atomic_fetch_add(qh, 1u, RLX_AGENT);
              if (!all_seen) {
                  if (F.tid == 0) { int need = 1, bb = 0, lo = 0, hi = 0;
                      if (u < U_D) { bb = (u >> 2) & 3; lo = 512 * (u >> 4); hi = lo + 511; }
                      else if (u < U_C + U_D) { const int uc = u - U_D; bb = (uc >> 2) & 3; lo = 128 * (uc >> 4) - 3; hi = lo + 130; }
                      else if (u < U_C + U_D + U_A) { const int ua = u - U_C - U_D; bb = ua >> 6; lo = 64 * (ua & 63) - 30; hi = lo + 93; }
                      else if (u < U_MIX) { const int ub = u - U_C - U_D - U_A; bb = ub >> 6; lo = 128 * ((ub >> 1) & 31) - 128; hi = lo + 255; }
                      else need = 0;
                      unsigned* ctl = (unsigned*)(A->ws + WS_CTL); unsigned* pc = ctl + CW_PCNT + 64 * (l * 64 + 16 * bb);
                      const int p0 = (lo < 0 ? 0 : lo) >> 8, p1 = hi >> 8; unsigned sp = 0;
                      if (need) while ((__hip_atomic_load(pc + 64 * p0, RLX_AGENT) < 4u || __hip_atomic_load(pc + 64 * p1, RLX_AGENT) < 4u) && ++sp < (1u << 20)) __builtin_amdgcn_s_sleep(1);
                      const unsigned gd = __hip_atomic_load(ctl + CW_GDONE + 64 * l, RLX_AGENT);
                      __builtin_amdgcn_fence(__ATOMIC_ACQUIRE, "agent"); asm volatile("s_waitcnt vmcnt(0)" ::: "memory");
                      F.MISC[18] = (gd >= (unsigned)F.G) ? 1u : 0u; }
                  __syncthreads();
                  all_seen = (int)F.MISC[18];
              }
              Frame FL = F; { int t = F.tid; asm volatile("" : "+v"(t)); FL.tid = t; FL.lane = t & 63; FL.wave = __builtin_amdgcn_readfirstlane(t >> 6); }
              if (u < U_D) { mixer_d(FL, l, u); }
              else if (u < U_C + U_D) { mixer_c(FL, l, u - U_D, qh, nxt); }
              else if (u < U_C + U_D + U_A) { mixer_a(FL, l, u - U_C - U_D); }
              else if (u < U_MIX) { mixer_b(FL, l, u - U_C - U_D - U_A); }
              else { const int it = (u - U_MIX) * NWAVES + FL.wave; if (it < I_L) convert_item(FL, l + 1, it); __syncthreads(); }
              if (F.tid == 0) F.MISC[16] = (pre || (u >= U_D && u < U_D + U_C)) ? nxt : __hip_atomic_fetch_add(qh, 1u, RLX_AGENT);
              __syncthreads();
              u = (int)F.MISC[16];
          }
        }
        GRID_BAR();
        { CArgs* A = get_args();
          pg8::Gemm g{WSP(bf16_t, WS_Y), WSP(bf16_t, WS_WOUT) + (size_t)l * DM * DM, M, DM, DM}; pg8::StaticOrder S; S.init(M, DM, F.G, (int)blockIdx.x);
          pg8::EpiRes E{A->in[I_X], A->out, WSP(bf16_t, WS_XB), WSP(float, WS_SSQ), l == 0 ? 0 : (l + 1 < DEPTH ? 1 : 2), __builtin_amdgcn_make_buffer_rsrc(WSP(bf16_t, WS_XB), 0, (int)((size_t)M * DM * 2), 0x00020000)};
          pg8::gemm_phase<pg8::EpiRes, pg8::StaticOrder, true, true>(F.lds, g, S, E); }
        if (l + 1 < DEPTH) {
            if (F.G == 256) {
                asm volatile("s_waitcnt vmcnt(0)" ::: "memory"); __syncthreads();
                if (F.tid == 0) { unsigned* cnt = (unsigned*)(args.ws + WS_CTL) + CW_TEAM + 64 * (l * 64 + ((int)blockIdx.x & 63));
                    __hip_atomic_fetch_add(cnt, 1u, RLX_AGENT);
                    unsigned sp = 0; while (__hip_atomic_load(cnt, RLX_AGENT) < 4u && ++sp < (1u << 20)) __builtin_amdgcn_s_sleep(1);
                    __builtin_amdgcn_fence(__ATOMIC_ACQUIRE, "agent"); asm volatile("s_waitcnt vmcnt(0)" ::: "memory"); }
                __syncthreads();
            } else GRID_BAR();
        }
    }
}

extern "C" void kernel_launch(void* const* d_in, const int* in_sizes, int n_in, void* d_out, int out_size, void* d_ws, size_t ws_size, hipStream_t stream) {
    static int grid = 0;
    if (grid == 0) {
        if (n_in != 23 || in_sizes[0] != M * DM || out_size != M * DM || ws_size < WS_END) { fprintf(stderr, "kernel_launch: unexpected problem shape (n_in %d, in0 %d, out %d, ws %zu)\n", n_in, n_in > 0 ? in_sizes[0] : -1, out_size, ws_size); grid = -1; return; }
        int dev = 0, cus = 0, per_cu = 0;
        if (hipGetDevice(&dev) != hipSuccess || hipDeviceGetAttribute(&cus, hipDeviceAttributeMultiprocessorCount, dev) != hipSuccess) { grid = -1; return; }
        if (hipFuncSetAttribute((const void*)fwd_kernel, hipFuncAttributeMaxDynamicSharedMemorySize, LDS_BYTES) != hipSuccess) { fprintf(stderr, "kernel_launch: hipFuncSetAttribute failed\n"); grid = -1; return; }
        if (hipOccupancyMaxActiveBlocksPerMultiprocessor(&per_cu, (const void*)fwd_kernel, NTHR, LDS_BYTES) != hipSuccess || per_cu < 1) { fprintf(stderr, "kernel_launch: occupancy query says %d blocks per CU\n", per_cu); grid = -1; (void)hipGetLastError(); return; }
        grid = cus * per_cu < 256 ? cus * per_cu : 256;
    }
    if (grid <= 0) return;
    (void)hipMemsetAsync((char*)d_ws + WS_CTL, 0, CTL_ZERO_BYTES, stream);
    Args a{};
    for (int i = 0; i < 23; ++i) a.in[i] = (const float*)d_in[i];
    a.out = (float*)d_out; a.ws = (unsigned char*)d_ws;
    void* kargs[] = {&a};
    hipError_t e = hipLaunchCooperativeKernel((const void*)fwd_kernel, dim3(grid), dim3(NTHR), kargs, LDS_BYTES, stream);
    if (e != hipSuccess) fprintf(stderr, "kernel_launch: cooperative launch failed: %s (grid %d)\n", hipGetErrorString(e), grid);
}
```

```cpp
#include <hip/hip_runtime.h>
#include <cstdio>
#include <cstdint>
template <int CTRL> __device__ __forceinline__ float dpp(float x) { return __builtin_bit_cast(float, __builtin_amdgcn_mov_dpp(__builtin_bit_cast(int, x), CTRL, 0xf, 0xf, true)); }
constexpr int DPP_XOR1 = 0xB1, DPP_XOR2 = 0x4E, DPP_XOR7 = 0x141, DPP_XOR8 = 0x128;
__device__ __forceinline__ float sum8(float v) { v += dpp<DPP_XOR1>(v); v += dpp<DPP_XOR2>(v); v += dpp<DPP_XOR7>(v); return v; }
__device__ __forceinline__ float sum16(float v) { v = sum8(v); v += dpp<DPP_XOR8>(v); return v; }
__device__ __forceinline__ float xsum16(float x) { auto s = __builtin_amdgcn_permlane16_swap(__float_as_uint(x), __float_as_uint(x), false, false); return __uint_as_float(s[0]) + __uint_as_float(s[1]); }
__device__ __forceinline__ float xsum32(float x) { auto s = __builtin_amdgcn_permlane32_swap(__float_as_uint(x), __float_as_uint(x), false, false); return __uint_as_float(s[0]) + __uint_as_float(s[1]); }
__device__ __forceinline__ float xmax32(float x) { auto s = __builtin_amdgcn_permlane32_swap(__float_as_uint(x), __float_as_uint(x), false, false); return fmaxf(__uint_as_float(s[0]), __uint_as_float(s[1])); }
__device__ __forceinline__ float xget32(float x, int hi) { auto s = __builtin_amdgcn_permlane32_swap(__float_as_uint(x), __float_as_uint(x), false, false); return __uint_as_float(hi ? s[0] : s[1]); }
__device__ __forceinline__ float sum32(float v) { return xsum16(sum16(v)); }
namespace pg8 {
#define PG8_LAS __attribute__((address_space(3)))
typedef unsigned short bf16_t;
typedef short bf16x8 __attribute__((ext_vector_type(8)));
typedef float f32x4 __attribute__((ext_vector_type(4)));
typedef unsigned u32x4 __attribute__((ext_vector_type(4)));
constexpr int BM = 256, BK = 64, HALF = 128, HTB = HALF * BK * 2  , STAGE_BYTES = 8 * HTB, NXCD = 8, WGM = 8;

__host__ __device__ __forceinline__ int lds_byte(int r, int c) { const int st = (r >> 4) * 2 + (c >> 5), rr = r & 15, cc = c & 31, ob = rr * 64 + cc * 2; return st * 1024 + (ob ^ (((ob >> 9) & 1) << 5)); }
__host__ __device__ __forceinline__ void stage_rc(int b, int& R, int& C) { const int st = b / 1024, sb = b % 1024, swz = sb ^ (((sb >> 9) & 1) << 5); R = (st >> 1) * 16 + swz / 64; C = (st & 1) * 32 + (swz % 64) / 2; }
__host__ __device__ __forceinline__ int perm32(int rho) { const int n = rho >> 4, i = rho & 15; return 8 * (i >> 2) + 4 * n + (i & 3); }

struct Unit { int pm, pn; };
struct Gemm { const bf16_t* A; const bf16_t* Bt; int M, N, K; };

struct StaticOrder {
    int nM, nN, nwg, G, c;
    __host__ __device__ void init(int M, int N, int G_, int c_) { nM = M / BM; nN = N / BM; nwg = nM * nN; G = G_; c = c_; }
    __host__ __device__ bool next(int i, Unit& u) const {
        const long L = (long)i * G + c; if (L >= nwg) return false;
        int wgid = (int)L; { const int q = nwg / NXCD, r = nwg % NXCD, xcd = wgid % NXCD, off = wgid / NXCD; wgid = (xcd < r ? xcd * (q + 1) : r * (q + 1) + (xcd - r) * q) + off; }
        const int nig = WGM * nN, gid = wgid / nig, fm = gid * WGM, gsz = (nM - fm) < WGM ? (nM - fm) : WGM;
        u.pm = fm + ((wgid % nig) % gsz); u.pn = (wgid % nig) / gsz; return true;
    }
    __device__ __forceinline__ void a_ready(const Unit&) const {}
    __device__ __forceinline__ void done(const Unit&) const {}
};

__device__ __forceinline__ unsigned cvt_pk_bf16(float lo, float hi) { unsigned r; asm volatile("v_cvt_pk_bf16_f32 %0, %1, %2" : "=v"(r) : "v"(lo), "v"(hi)); return r; }
struct EpiProj {
    static constexpr bool PERM = true, AFTER_DRAIN = false;
    bf16_t* O; int ldc; const float* ssq; __amdgpu_buffer_rsrc_t rsrc;
    __device__ __forceinline__ void operator()(const f32x4 (&acc)[2][2][4][2], const Unit& u, int wr, int wc, int fr, int fq) const {
        const int row0 = u.pm * BM + wr * 64 + fr, col0 = u.pn * BM + wc * 32 + 8 * fq;
#pragma unroll
        for (int ai = 0; ai < 2; ++ai)
#pragma unroll
            for (int m = 0; m < 4; ++m) { const int row = row0 + ai * HALF + m * 16;
                const f32x4 s4 = *(const f32x4*)(ssq + (size_t)row * 16 + 4 * fq);
                float s = (s4[0] + s4[1]) + (s4[2] + s4[3]); s = xsum32(xsum16(s));
                const float rs = 1.0f / sqrtf(s * (1.0f / 1024.0f) + 1e-6f);
                const unsigned boff = (unsigned)(((size_t)row * ldc + col0) * 2);
#pragma unroll
                for (int bj = 0; bj < 2; ++bj) { const f32x4 v0 = acc[ai][bj][m][0] * rs, v1 = acc[ai][bj][m][1] * rs;
                    u32x4 w; w.x = cvt_pk_bf16(v0[0], v0[1]); w.y = cvt_pk_bf16(v0[2], v0[3]); w.z = cvt_pk_bf16(v1[0], v1[1]); w.w = cvt_pk_bf16(v1[2], v1[3]);
                    __builtin_amdgcn_raw_buffer_store_b128(w, rsrc, boff + bj * HALF * 2, 0,   16); } }
    }
};
struct EpiRes {
    static constexpr bool PERM = true, AFTER_DRAIN = false;
    const float* xin; float* xout; bf16_t* xb; float* ssq; int mode; __amdgpu_buffer_rsrc_t rsrc;
    __device__ __forceinline__ void operator()(const f32x4 (&acc)[2][2][4][2], const Unit& u, int wr, int wc, int fr, int fq) const {
        const int row0 = u.pm * BM + wr * 64 + fr, col0 = u.pn * BM + wc * 32 + 8 * fq;
#pragma unroll
        for (int ai = 0; ai < 2; ++ai)
#pragma unroll
            for (int m = 0; m < 4; ++m) { const int row = row0 + ai * HALF + m * 16; float ss = 0.f;
#pragma unroll
                for (int bj = 0; bj < 2; ++bj) { const size_t off = (size_t)row * 1024 + col0 + bj * HALF; f32x4 x0, x1;
                    if (mode == 0) { x0 = *(const f32x4*)(xin + off); x1 = *(const f32x4*)(xin + off + 4); }
                    else { const u32x4 w = *(const u32x4*)(xb + off); x0 = (f32x4){__uint_as_float(w.x << 16), __uint_as_float(w.x & 0xffff0000u), __uint_as_float(w.y << 16), __uint_as_float(w.y & 0xffff0000u)};
                        x1 = (f32x4){__uint_as_float(w.z << 16), __uint_as_float(w.z & 0xffff0000u), __uint_as_float(w.w << 16), __uint_as_float(w.w & 0xffff0000u)}; }
                    x0 = x0 + acc[ai][bj][m][0]; x1 = x1 + acc[ai][bj][m][1];
                    if (mode == 2) { *(f32x4*)(xout + off) = x0; *(f32x4*)(xout + off + 4) = x1; }
                    else { u32x4 w; w.x = cvt_pk_bf16(x0[0], x0[1]); w.y = cvt_pk_bf16(x0[2], x0[3]); w.z = cvt_pk_bf16(x1[0], x1[1]); w.w = cvt_pk_bf16(x1[2], x1[3]);
                        __builtin_amdgcn_raw_buffer_store_b128(w, rsrc, (unsigned)(off * 2), 0,   16);
                        const float r0 = __uint_as_float(w.x << 16), r1 = __uint_as_float(w.x & 0xffff0000u), r2 = __uint_as_float(w.y << 16), r3 = __uint_as_float(w.y & 0xffff0000u),
                                    r4 = __uint_as_float(w.z << 16), r5 = __uint_as_float(w.z & 0xffff0000u), r6 = __uint_as_float(w.w << 16), r7 = __uint_as_float(w.w & 0xffff0000u);
                        ss += (r0 * r0 + r1 * r1) + (r2 * r2 + r3 * r3) + (r4 * r4 + r5 * r5) + (r6 * r6 + r7 * r7); } }
                if (mode != 2) { ss = xsum32(xsum16(ss)); if (fq == 0) __hip_atomic_store(ssq + (size_t)row * 16 + u.pn * 4 + wc, ss, __ATOMIC_RELAXED, __HIP_MEMORY_SCOPE_AGENT); } }
    }
};

template <class Epi, class Sched, bool ALIGN_EPI = false, bool SP2 = false>
__device__ __forceinline__ void gemm_phase(PG8_LAS unsigned char* lds, const Gemm g, const Sched& S, const Epi& E) {
    int tid_ = threadIdx.x; asm volatile("" : "+v"(tid_));
    const int tid = tid_, wid = __builtin_amdgcn_readfirstlane(tid >> 6), lane = tid & 63, wr = wid >> 2, wc = wid & 3, fr = lane & 15, fq = lane >> 4;
    const int K = g.K, nt = K / BK;
    unsigned voffA[2], voffB[2];
#pragma unroll
    for (int i = 0; i < 2; ++i) { int R, C; stage_rc(tid * 16 + i * 8192, R, C); const int Rb = Epi::PERM ? ((R & ~31) + perm32(R & 31)) : R;
        voffA[i] = (unsigned)(R * K + C) * 2u; voffB[i] = (unsigned)(Rb * K + C) * 2u; }
    const size_t kstep = (size_t)(BK * 2);
    const size_t hstep = (size_t)HALF * K * 2;
    const size_t tstep = 2 * hstep;
    const unsigned ldsw = (unsigned)wid * 1024u;
    const int aoff = lds_byte(wr * 64 + fr, fq * 8), boff = lds_byte(wc * 32 + fr, fq * 8);
#define PG8_SA(b, h) (((b) * 2 + (h)) * HTB)
#define PG8_SB(b, h) ((4 + (b) * 2 + (h)) * HTB)
#define PG8_STAGE(bufoff, gbase, voff) do { _Pragma("unroll") for (int _i = 0; _i < 2; ++_i) \
        __builtin_amdgcn_global_load_lds((const unsigned*)((const char*)(gbase) + (voff)[_i]), (PG8_LAS unsigned*)(lds + (bufoff) + ldsw + _i * 8192), 16, 0, 0); } while (0)
#define PG8_LDA(dst, b, h) do { _Pragma("unroll") for (int m = 0; m < 4; ++m) _Pragma("unroll") for (int k = 0; k < 2; ++k) dst[m][k] = *(const PG8_LAS bf16x8*)(lds + PG8_SA(b, h) + aoff + m * 2048 + k * 1024); } while (0)
#define PG8_LDB(dst, b, h) do { _Pragma("unroll") for (int n = 0; n < 2; ++n) _Pragma("unroll") for (int k = 0; k < 2; ++k) dst[n][k] = *(const PG8_LAS bf16x8*)(lds + PG8_SB(b, h) + boff + n * 2048 + k * 1024); } while (0)
#define PG8_MMA(ai, bj, At, Bt) do { __builtin_amdgcn_s_setprio(1); _Pragma("unroll") for (int m = 0; m < 4; ++m) _Pragma("unroll") for (int n = 0; n < 2; ++n) _Pragma("unroll") for (int k = 0; k < 2; ++k) \
        acc[ai][bj][m][n] = __builtin_amdgcn_mfma_f32_16x16x32_bf16(Bt[n][k], At[m][k], acc[ai][bj][m][n], 0, 0, 0); __builtin_amdgcn_s_setprio(0); } while (0)
#define PG8_WAIT_V(n) asm volatile("s_waitcnt vmcnt(" #n ")" ::: "memory")
#define PG8_WAIT_L(n) asm volatile("s_waitcnt lgkmcnt(" #n ")" ::: "memory")
#define PG8_BAR __builtin_amdgcn_s_barrier()
#define PG8_SCHED __builtin_amdgcn_sched_barrier(0)
    Unit cur, nxt; int ui = 0;
    if (!S.next(0, cur)) return;
    f32x4 acc[2][2][4][2];
#pragma unroll
    for (int a = 0; a < 2; ++a)
#pragma unroll
        for (int b = 0; b < 2; ++b)
#pragma unroll
            for (int m = 0; m < 4; ++m)
#pragma unroll
                for (int n = 0; n < 2; ++n) acc[a][b][m][n] = (f32x4){0.f, 0.f, 0.f, 0.f};
    bf16x8 At[4][2], B0[2][2], B1[2][2];
    const char* cA = (const char*)g.A + (size_t)cur.pm * tstep; const char* cB = (const char*)g.Bt + (size_t)cur.pn * tstep;
    S.a_ready(cur);
    if constexpr (SP2) {
        PG8_STAGE(PG8_SB(0, 0), cB, voffB); PG8_STAGE(PG8_SB(0, 1), cB + hstep, voffB); PG8_STAGE(PG8_SA(0, 0), cA, voffA); PG8_STAGE(PG8_SA(0, 1), cA + hstep, voffA);
        if (wr == 1) PG8_BAR;
        PG8_WAIT_V(2); PG8_BAR;
        PG8_STAGE(PG8_SB(1, 0), cB + kstep, voffB); PG8_STAGE(PG8_SA(1, 0), cA + kstep, voffA); PG8_STAGE(PG8_SB(1, 1), cB + hstep + kstep, voffB);
        PG8_WAIT_V(6); PG8_BAR;
    } else {
        PG8_STAGE(PG8_SB(0, 0), cB, voffB); PG8_STAGE(PG8_SA(0, 0), cA, voffA); PG8_STAGE(PG8_SB(0, 1), cB + hstep, voffB); PG8_STAGE(PG8_SA(0, 1), cA + hstep, voffA);
        if (wr == 1) PG8_BAR;
        PG8_WAIT_V(4); PG8_BAR;
        PG8_STAGE(PG8_SB(1, 0), cB + kstep, voffB); PG8_STAGE(PG8_SA(1, 0), cA + kstep, voffA); PG8_STAGE(PG8_SB(1, 1), cB + hstep + kstep, voffB);
        PG8_WAIT_V(6); PG8_BAR;
    }
    for (;;) {
        const bool has_next = S.next(ui + 1, nxt);
        const char* nA = has_next ? (const char*)g.A + (size_t)nxt.pm * tstep : cA; const char* nB = has_next ? (const char*)g.Bt + (size_t)nxt.pn * tstep : cB;
        for (int t = 0; t < nt; t += 2) {
            const bool last = (t == nt - 2);
            const char* a1 = cA + (size_t)(t + 1) * kstep;
            const char* a2 = last ? nA : cA + (size_t)(t + 2) * kstep; const char* b2 = last ? nB : cB + (size_t)(t + 2) * kstep;
            const char* a3 = a2 + kstep; const char* b3 = b2 + kstep;
            if (last && has_next) S.a_ready(nxt);
            if constexpr (SP2) {
            PG8_LDB(B0, 0, 0); PG8_LDB(B1, 0, 1); PG8_SCHED; PG8_LDA(At, 0, 0); PG8_STAGE(PG8_SA(1, 1), a1 + hstep, voffA);
            PG8_WAIT_V(8); PG8_WAIT_L(0); PG8_BAR; PG8_MMA(0, 0, At, B0); PG8_MMA(0, 1, At, B1); PG8_BAR; PG8_SCHED;
            PG8_LDA(At, 0, 1); PG8_STAGE(PG8_SB(0, 0), b2, voffB); PG8_STAGE(PG8_SB(0, 1), b2 + hstep, voffB); PG8_STAGE(PG8_SA(0, 0), a2, voffA);
            PG8_WAIT_V(8); PG8_WAIT_L(0); PG8_BAR; PG8_MMA(1, 0, At, B0); PG8_MMA(1, 1, At, B1); PG8_BAR; PG8_SCHED;
            PG8_LDB(B0, 1, 0); PG8_LDB(B1, 1, 1); PG8_SCHED; PG8_LDA(At, 1, 0); PG8_STAGE(PG8_SA(0, 1), a2 + hstep, voffA);
            PG8_WAIT_V(8); PG8_WAIT_L(0); PG8_BAR; PG8_MMA(0, 0, At, B0); PG8_MMA(0, 1, At, B1); PG8_BAR; PG8_SCHED;
            PG8_LDA(At, 1, 1); PG8_STAGE(PG8_SB(1, 0), b3, voffB); PG8_STAGE(PG8_SB(1, 1), b3 + hstep, voffB); PG8_STAGE(PG8_SA(1, 0), a3, voffA);
            PG8_WAIT_V(8); PG8_WAIT_L(0); PG8_BAR; PG8_MMA(1, 0, At, B0); PG8_MMA(1, 1, At, B1); PG8_BAR; PG8_SCHED;
            } else {
            PG8_LDB(B0, 0, 0); PG8_SCHED; PG8_LDA(At, 0, 0); PG8_STAGE(PG8_SA(1, 1), a1 + hstep, voffA);
            PG8_WAIT_L(8); PG8_BAR; PG8_WAIT_L(0); PG8_MMA(0, 0, At, B0); PG8_BAR; PG8_SCHED;
            PG8_LDB(B1, 0, 1); PG8_STAGE(PG8_SB(0, 0), b2, voffB);
            PG8_BAR; PG8_WAIT_L(0); PG8_MMA(0, 1, At, B1); PG8_BAR;
            PG8_LDA(At, 0, 1); PG8_STAGE(PG8_SA(0, 0), a2, voffA);
            PG8_BAR; PG8_WAIT_L(0); PG8_MMA(1, 0, At, B0); PG8_BAR; PG8_SCHED;
            PG8_STAGE(PG8_SB(0, 1), b2 + hstep, voffB);
            PG8_WAIT_V(6); PG8_BAR; PG8_MMA(1, 1, At, B1); PG8_BAR;
            PG8_LDB(B0, 1, 0); PG8_SCHED; PG8_LDA(At, 1, 0); PG8_STAGE(PG8_SA(0, 1), a2 + hstep, voffA);
            PG8_WAIT_L(8); PG8_BAR; PG8_WAIT_L(0); PG8_MMA(0, 0, At, B0); PG8_BAR; PG8_SCHED;
            PG8_LDB(B1, 1, 1); PG8_STAGE(PG8_SB(1, 0), b3, voffB);
            PG8_BAR; PG8_WAIT_L(0); PG8_MMA(0, 1, At, B1); PG8_BAR;
            PG8_LDA(At, 1, 1); PG8_STAGE(PG8_SA(1, 0), a3, voffA);
            PG8_BAR; PG8_WAIT_L(0); PG8_MMA(1, 0, At, B0); PG8_BAR; PG8_SCHED;
            PG8_STAGE(PG8_SB(1, 1), b3 + hstep, voffB);
            PG8_WAIT_V(6); PG8_BAR; PG8_MMA(1, 1, At, B1); PG8_BAR;
            }
        }
        if constexpr (ALIGN_EPI) { if (wr == 0) PG8_BAR; }
        if constexpr (!Epi::AFTER_DRAIN) { E(acc, cur, wr, wc, fr, fq); S.done(cur); }
        if (!has_next) break;
#pragma unroll
        for (int a = 0; a < 2; ++a)
#pragma unroll
            for (int b = 0; b < 2; ++b)
#pragma unroll
                for (int m = 0; m < 4; ++m)
#pragma unroll
                    for (int n = 0; n < 2; ++n) acc[a][b][m][n] = (f32x4){0.f, 0.f, 0.f, 0.f};
        cur = nxt; cA = nA; cB = nB; ++ui;
        if constexpr (ALIGN_EPI) { if (wr == 1) PG8_BAR; }
    }
    PG8_WAIT_V(0);
    if constexpr (!ALIGN_EPI) { if (wr == 0) PG8_BAR; }
    PG8_BAR;
    if constexpr (Epi::AFTER_DRAIN) { E.fused(acc, cur, wr, wc, fr, fq, lds, wid, lane); S.done(cur); }
#undef PG8_SA
#undef PG8_SB
#undef PG8_STAGE
#undef PG8_LDA
#undef PG8_LDB
#undef PG8_MMA
#undef PG8_WAIT_V
#undef PG8_WAIT_L
#undef PG8_BAR
#undef PG8_SCHED
}
}
using pg8::bf16_t; using pg8::bf16x8; using pg8::f32x4; using pg8::u32x4; using pg8::cvt_pk_bf16;
#define GAS __attribute__((address_space(1)))
#define LAS __attribute__((address_space(3)))
typedef float f32x16 __attribute__((ext_vector_type(16)));
typedef float f32x2 __attribute__((ext_vector_type(2)));
typedef unsigned u32x2 __attribute__((ext_vector_type(2)));
typedef GAS unsigned gu32;
#define RLX_AGENT __ATOMIC_RELAXED, __HIP_MEMORY_SCOPE_AGENT
#define LDS_WAIT() asm volatile("s_waitcnt lgkmcnt(0)" ::: "memory")
#define MFMA32(a, b, c) __builtin_amdgcn_mfma_f32_32x32x16_bf16((a), (b), (c), 0, 0, 0)

constexpr int NWAVES = 8, NTHR = 512;
constexpr int BATCH = 4, SEQ = 4096, DM = 1024, DEPTH = 4, M = BATCH * SEQ, NIN = 2832, NP = 3072;
constexpr float EPS = 1e-6f;
constexpr int PC_AVAL = 0, PC_AGLU = 256, PC_AGATE = 512, PC_BQ = 768, PC_BK = 1024, PC_BV = 1152, PC_BGATE = 1280, PC_CX = 1536, PC_CGATE = 1792,
              PC_DQ = 2048, PC_DK = 2176, PC_DV = 2304, PC_DGATE = 2560, PC_DLR = 2816;
__host__ __device__ __forceinline__ int win_remap(int n) { return n < 2560 ? n : (n < 2816 ? n + 16 : (n < 2832 ? n - 256 : -1)); }
constexpr size_t MiB = 1u << 20;
constexpr size_t WS_CTL = 0, CTL_ZERO_BYTES = 1 * MiB;
constexpr size_t WS_WIN = 2 * MiB;
constexpr size_t WS_WOUT = 26 * MiB;
constexpr size_t WS_APW = 34 * MiB;
constexpr size_t WS_WR = WS_APW + 512 * 1024, WS_WI = WS_WR + 128 * 1024;
constexpr size_t WS_SSQ = 35 * MiB;
constexpr size_t WS_XB = 36 * MiB;
constexpr size_t WS_Y = 68 * MiB;
constexpr size_t WS_PROJ = 100 * MiB;
constexpr size_t WS_GC = 200 * MiB;
constexpr size_t WS_GD = 201 * MiB;
constexpr size_t WS_BIAS = 204 * MiB;
constexpr size_t WS_END = 205 * MiB;
constexpr int CW_BAR = 4096;
constexpr int CW_TEAM = 65536;
constexpr int CW_PCNT = 131072;
constexpr int CW_GDONE = CW_PCNT + 64 * 256;
constexpr int CW_Q = 16384;
constexpr int RING_BYTES = 131072, LDSCTL_OFF = RING_BYTES, MISC_OFF = LDSCTL_OFF + 320, LDS_BYTES = 147456;

__device__ __forceinline__ float bf_lo(unsigned w) { return __uint_as_float(w << 16); }
__device__ __forceinline__ float bf_hi(unsigned w) { return __uint_as_float(w & 0xffff0000u); }
__device__ __forceinline__ unsigned f2bf(float f) { unsigned u = __float_as_uint(f); return (u + 0x7fffu + ((u >> 16) & 1u)) >> 16; }
typedef __bf16 bf16v2 __attribute__((ext_vector_type(2)));
__device__ __forceinline__ unsigned pk2(float lo, float hi) { const f32x2 f = {lo, hi}; const bf16v2 b = __builtin_convertvector(f, bf16v2); return __builtin_bit_cast(unsigned, b); }
__device__ __forceinline__ float fexp(float x) { return __builtin_amdgcn_exp2f(x * 1.4426950408889634f); }
__device__ __forceinline__ float frcp(float x) { return __builtin_amdgcn_rcpf(x); }
__device__ __forceinline__ float sigm(float x) { return frcp(1.f + fexp(-x)); }
__device__ __forceinline__ float silu(float x) { return x * sigm(x); }
__device__ __forceinline__ float rsq(float x) { return __builtin_amdgcn_rsqf(x); }
__device__ __forceinline__ float log1p_01(float e) { return __builtin_amdgcn_logf(1.0f + e) * 0.6931471805599453f; }
__device__ __forceinline__ float one_minus_exp(float x) { const float p = -x * (1.0f + x * (0.5f + x * (1.0f / 6.0f + x * (1.0f / 24.0f + x * (1.0f / 120.0f + x * (1.0f / 720.0f)))))); return x > -0.25f ? p : 1.0f - fexp(x); }
__device__ __forceinline__ void unpack8(const u32x4 w, float (&f)[8]) { f[0] = bf_lo(w.x); f[1] = bf_hi(w.x); f[2] = bf_lo(w.y); f[3] = bf_hi(w.y); f[4] = bf_lo(w.z); f[5] = bf_hi(w.z); f[6] = bf_lo(w.w); f[7] = bf_hi(w.w); }
__device__ __forceinline__ u32x4 pack8(const float (&f)[8]) { u32x4 w; w.x = pk2(f[0], f[1]); w.y = pk2(f[2], f[3]); w.z = pk2(f[4], f[5]); w.w = pk2(f[6], f[7]); return w; }
__device__ __forceinline__ bf16x8 as_frag(const u32x4 w) { return __builtin_bit_cast(bf16x8, w); }
__device__ __forceinline__ bf16x8 frag_from_acc(const f32x16& a, int s8) { u32x4 w; w.x = pk2(a[s8 + 0], a[s8 + 1]); w.y = pk2(a[s8 + 2], a[s8 + 3]); w.z = pk2(a[s8 + 4], a[s8 + 5]); w.w = pk2(a[s8 + 6], a[s8 + 7]); return as_frag(w); }
__device__ __forceinline__ float wave_sum(float v) { return xsum32(sum32(v)); }
#define XB_TMO      128
#define XB_XCNT(j)  (256  + 64 * (j))
#define XB_XSUB(j)  (1280 + 64 * (j))
#define XB_XGEN(j)  (2304 + 64 * (j))
#define XB_TOP      3328
#define XB_TOPGEN   3392
#define XCD_BAR_WORDS 3456
#define XB_SPIN_CAP (1u << 18)

__device__ __forceinline__ unsigned xb_ld(unsigned* p)              { return __hip_atomic_load(p, __ATOMIC_RELAXED, __HIP_MEMORY_SCOPE_AGENT); }
__device__ __forceinline__ unsigned xb_add(unsigned* p, unsigned v) { return __hip_atomic_fetch_add(p, v, __ATOMIC_RELAXED, __HIP_MEMORY_SCOPE_AGENT); }
__device__ __forceinline__ unsigned xb_xcc_id() { return (unsigned)__builtin_amdgcn_s_getreg((3 << 11) | 20) & 0xFu; }
#define XB_SPIN(cond, bar) do { unsigned _sp = 0; while (cond) { __builtin_amdgcn_s_sleep(1); \
    if ((++_sp & 255u) == 0u) { if (xb_ld(&(bar)[XB_TMO])) break; if (_sp > XB_SPIN_CAP) { atomicAdd(&(bar)[XB_TMO], 1u); break; } } } } while (0)

struct XcdBarrier {
    unsigned* bar; unsigned x;
    volatile LAS unsigned* st;
};

__device__ __forceinline__ XcdBarrier xcd_barrier_post(unsigned* bar, volatile LAS unsigned* st) {
    XcdBarrier b; b.bar = bar; b.x = xb_xcc_id(); b.st = st;
    if (threadIdx.x == 0) (void)xb_add(&bar[XB_XCNT(b.x)], 1u);
    return b;
}
__device__ __forceinline__ void xcd_barrier_complete(unsigned* bar, unsigned x, unsigned& nloc, unsigned& nx) {
    const unsigned G = gridDim.x * gridDim.y * gridDim.z;
    unsigned sum, cnt, mine, sp = 0u;
    for (;;) {
        sum = 0u; cnt = 0u; mine = 0u;
#pragma unroll
        for (unsigned j = 0; j < 16; ++j) { const unsigned c = xb_ld(&bar[XB_XCNT(j)]); sum += c; cnt += (c > 0u) ? 1u : 0u; mine = (j == x) ? c : mine; }
        if (sum == G) break;
        __builtin_amdgcn_s_sleep(1);
        if ((++sp & 255u) == 0u) { if (xb_ld(&bar[XB_TMO])) break; if (sp > XB_SPIN_CAP) { atomicAdd(&bar[XB_TMO], 1u); break; } }
    }
    nloc = mine > 0u ? mine : 1u; nx = cnt > 0u ? cnt : 1u;
}

__device__ __forceinline__ void xcd_barrier(const XcdBarrier& b) {
    asm volatile("s_waitcnt vmcnt(0)" ::: "memory");
    __syncthreads();
    if (threadIdx.x == 0) {
        unsigned* bar = b.bar;
        __builtin_amdgcn_s_waitcnt(0);
        unsigned nloc = b.st[0], nx = b.st[1];
        if (nloc == 0u) { xcd_barrier_complete(bar, b.x, nloc, nx); b.st[0] = nloc; b.st[1] = nx; }
        const unsigned old = xb_add(&bar[XB_XSUB(b.x)], 1u);
        const unsigned gen = old / nloc;
        if (old + 1u == (gen + 1u) * nloc) {
            __builtin_amdgcn_fence(__ATOMIC_RELEASE, "agent");
            asm volatile("s_waitcnt vmcnt(0)" ::: "memory");
            const unsigned og = xb_add(&bar[XB_TOP], 1u);
            const unsigned tg = og / nx;
            if (og + 1u == (tg + 1u) * nx) xb_add(&bar[XB_TOPGEN], 1u);
            else XB_SPIN(xb_ld(&bar[XB_TOPGEN]) == tg, bar);
            __builtin_amdgcn_fence(__ATOMIC_ACQUIRE, "agent");
            xb_add(&bar[XB_XGEN(b.x)], 1u);
            asm volatile("s_waitcnt vmcnt(0)" ::: "memory");
        } else {
            XB_SPIN(xb_ld(&bar[XB_XGEN(b.x)]) == gen, bar);
            __builtin_amdgcn_fence(__ATOMIC_ACQUIRE, "agent");
            asm volatile("s_waitcnt vmcnt(0)" ::: "memory");
        }
    }
    __syncthreads();
}
template <int S8> __device__ __forceinline__ bf16x8 frag_acc(const f32x16& a) { u32x4 w; w.x = pk2(a[S8 + 0], a[S8 + 1]); w.y = pk2(a[S8 + 2], a[S8 + 3]); w.z = pk2(a[S8 + 4], a[S8 + 5]); w.w = pk2(a[S8 + 6], a[S8 + 7]); return as_frag(w); }

struct Args { const float* in[23]; float* out; unsigned char* ws; };
typedef __attribute__((address_space(4))) const Args CArgs;
__device__ __forceinline__ CArgs* get_args() { CArgs* p = (CArgs*)__builtin_amdgcn_kernarg_segment_ptr(); asm volatile("" : "+s"(p)); return p; }
enum { I_X = 0, I_NORM_G, I_W_IN, I_A_CONV_W, I_A_CONV_B, I_A_LN_G, I_A_LN_B, I_A_PW, I_B_Q_G, I_B_K_G, I_B_SINKS, I_REL_BIAS, I_C_CONV_W, I_C_CONV_B, I_C_W_R, I_C_B_R, I_C_W_I, I_C_B_I, I_C_LAMBDA, I_D_W_UP, I_D_B_UP, I_D_NORM_G, I_W_OUT };
struct Frame { LAS unsigned char* lds; volatile LAS unsigned* MISC; int tid, lane, wave, G; };
#define WSP(T, off) ((T*)(A->ws + (off)))

template <bool REMAP>
__device__ __forceinline__ void transpose_item(const float* W, int ldw, const float* gk, bf16_t* WT, int ldt, int k0, int n0, LAS float* scr, int lane) {
    const int nn = n0 + (lane & 31); const int col = REMAP ? win_remap(nn) : nn, colc = col < 0 ? 0 : col;
    const float* wp = W + (size_t)(k0 + (lane >> 5)) * ldw + colc;
    float v[32];
#pragma unroll
    for (int i = 0; i < 32; ++i) v[i] = wp[(size_t)(2 * i) * ldw];
    const int c = lane & 7;
    f32x4 g0 = (f32x4){1.f, 1.f, 1.f, 1.f}, g1 = g0; if (gk) { g0 = *(const f32x4*)(gk + k0 + 8 * c); g1 = *(const f32x4*)(gk + k0 + 8 * c + 4); }
#pragma unroll
    for (int i = 0; i < 32; ++i) scr[(2 * i + (lane >> 5)) * 33 + (lane & 31)] = col < 0 ? 0.f : v[i];
    LDS_WAIT(); asm volatile("" ::: "memory");
#pragma unroll
    for (int j = 0; j < 4; ++j) { const int n = (lane >> 3) + 8 * j; const LAS float* s = scr + (8 * c) * 33 + n;
        u32x4 o; o.x = pk2(s[0 * 33] * g0.x, s[1 * 33] * g0.y); o.y = pk2(s[2 * 33] * g0.z, s[3 * 33] * g0.w); o.z = pk2(s[4 * 33] * g1.x, s[5 * 33] * g1.y); o.w = pk2(s[6 * 33] * g1.z, s[7 * 33] * g1.w);
        *(u32x4*)(WT + (size_t)(n0 + n) * ldt + k0 + 8 * c) = o; }
    LDS_WAIT(); asm volatile("" ::: "memory");
}
constexpr int I_IN = 16 * 96, I_OUT = 16 * 32, I_PW = 4 * 8, I_G = 4 * 2, I_L = I_IN + I_OUT + I_PW + 2 * I_G;
__device__ __forceinline__ void convert_item(Frame& F, int l, int r) {
    CArgs* A = get_args(); const float* norm_g = A->in[I_NORM_G]; const float* w_in = A->in[I_W_IN]; const float* a_pw = A->in[I_A_PW]; const float* c_w_r = A->in[I_C_W_R]; const float* c_w_i = A->in[I_C_W_I]; const float* w_out = A->in[I_W_OUT];
    bf16_t* WtIn = WSP(bf16_t, WS_WIN); bf16_t* WtOut = WSP(bf16_t, WS_WOUT); bf16_t* ApwT = WSP(bf16_t, WS_APW); bf16_t* WrT = WSP(bf16_t, WS_WR); bf16_t* WiT = WSP(bf16_t, WS_WI);
    LAS float* scr = (LAS float*)(F.lds + F.wave * 16384);
    if (r < I_IN) { const int kb = r / 96, nb = r % 96; transpose_item<true>(w_in + (size_t)l * DM * NIN, NIN, norm_g + l * DM, WtIn + (size_t)l * NP * DM, DM, 64 * kb, 32 * nb, scr, F.lane); return; } r -= I_IN;
    if (r < I_OUT) { const int kb = r / 32, nb = r % 32; transpose_item<false>(w_out + (size_t)l * DM * DM, DM, nullptr, WtOut + (size_t)l * DM * DM, DM, 64 * kb, 32 * nb, scr, F.lane); return; } r -= I_OUT;
    if (r < I_PW) { const int kb = r / 8, nb = r % 8; transpose_item<false>(a_pw + (size_t)l * 65536, 256, nullptr, ApwT + (size_t)l * 65536, 256, 64 * kb, 32 * nb, scr, F.lane); return; } r -= I_PW;
    if (r < I_G) { const int blk = r / 2, nb = r % 2; transpose_item<false>(c_w_r + (size_t)(l * 4 + blk) * 4096, 64, nullptr, WrT + (size_t)(l * 4 + blk) * 4096, 64, 0, 32 * nb, scr, F.lane); return; } r -= I_G;
    { const int blk = r / 2, nb = r % 2; transpose_item<false>(c_w_i + (size_t)(l * 4 + blk) * 4096, 64, nullptr, WiT + (size_t)(l * 4 + blk) * 4096, 64, 0, 32 * nb, scr, F.lane); }
}
__device__ __forceinline__ void p0_prologue(Frame& F) {
    CArgs* A = get_args(); const float* x = A->in[I_X]; bf16_t* XB = WSP(bf16_t, WS_XB); float* SSQ = WSP(float, WS_SSQ);
    const int gw = blockIdx.x * NWAVES + F.wave, NGW = F.G * NWAVES;
    for (int it = gw; it < I_L; it += NGW) convert_item(F, 0, it);
    { const float* rel_bias = A->in[I_REL_BIAS]; float* BT = WSP(float, WS_BIAS);
      for (int i = gw * 64 + F.lane; i < 4 * 5 * 16 * 64; i += NGW * 64) { const int e = i & 3, ln = (i >> 2) & 63, q4 = (i >> 8) & 3, kt = (i >> 10) % 5, hd = (i >> 10) / 5;
          const int dist = (ln & 31) - (e + 8 * q4) - 4 * (ln >> 5) + 128 - 32 * kt; float v = -INFINITY;
          if (dist >= 0 && dist < 128) { int bucket = dist; if (dist >= 16) { bucket = 16 + (int)(logf((float)dist / 16.0f) / 2.0794415416798357f * 16.0f); bucket = bucket < 31 ? bucket : 31; } v = rel_bias[bucket * 4 + hd]; }
          BT[i] = v; } }
    for (int m = gw; m < M; m += 2 * NGW) {
        const f32x4* xr0 = (const f32x4*)(x + (size_t)m * DM) + F.lane; const int m1 = (m + NGW < M) ? m + NGW : m; const f32x4* xr1 = (const f32x4*)(x + (size_t)m1 * DM) + F.lane; f32x4 v0[4], v1[4]; float s0 = 0.f, s1 = 0.f;
#pragma unroll
        for (int j = 0; j < 4; ++j) { v0[j] = xr0[64 * j]; v1[j] = xr1[64 * j]; }
#pragma unroll
        for (int j = 0; j < 4; ++j) { s0 += (v0[j].x * v0[j].x + v0[j].y * v0[j].y) + (v0[j].z * v0[j].z + v0[j].w * v0[j].w); s1 += (v1[j].x * v1[j].x + v1[j].y * v1[j].y) + (v1[j].z * v1[j].z + v1[j].w * v1[j].w); }
        s0 = wave_sum(s0); s1 = wave_sum(s1);
        u32x2* o0 = (u32x2*)(XB + (size_t)m * DM) + F.lane; u32x2* o1 = (u32x2*)(XB + (size_t)m1 * DM) + F.lane;
#pragma unroll
        for (int j = 0; j < 4; ++j) { u32x2 w; w.x = pk2(v0[j].x, v0[j].y); w.y = pk2(v0[j].z, v0[j].w); o0[64 * j] = w; w.x = pk2(v1[j].x, v1[j].y); w.y = pk2(v1[j].z, v1[j].w); o1[64 * j] = w; }
        if (F.lane < 16) { SSQ[(size_t)m * 16 + F.lane] = (F.lane == 0) ? s0 : 0.f; SSQ[(size_t)m1 * 16 + F.lane] = (F.lane == 0) ? s1 : 0.f; }
    }
}

constexpr int A_TA = 64, A_ROWS = A_TA + 30, A_S_OFF = A_ROWS * 512, A_S_STRIDE = 528;
__device__ __forceinline__ void mixer_a(Frame& F, int l, int unit) {
    CArgs* A = get_args(); const float* a_conv_w = A->in[I_A_CONV_W]; const float* a_conv_b = A->in[I_A_CONV_B]; const float* a_ln_g = A->in[I_A_LN_G]; const float* a_ln_b = A->in[I_A_LN_B]; bf16_t* ApwT = WSP(bf16_t, WS_APW); bf16_t* Y = WSP(bf16_t, WS_Y); bf16_t* PROJ = WSP(bf16_t, WS_PROJ);
    LAS unsigned char* lds = F.lds; const int tid = F.tid, lane = F.lane, w = F.wave;
    const int b = unit >> 6, t0 = (unit & 63) * A_TA; const size_t m0 = (size_t)b * SEQ + t0;
    const int pA = tid & 127, tgA = tid >> 7, c0A = 2 * pA;
    float w0[31], w1[31];
#pragma unroll
    for (int j = 0; j < 31; ++j) { const f32x2 ww = *(const f32x2*)(a_conv_w + ((size_t)l * 31 + j) * 256 + c0A); w0[j] = ww.x; w1[j] = ww.y; }
    const f32x2 cb = *(const f32x2*)(a_conv_b + l * 256 + c0A), lg = *(const f32x2*)(a_ln_g + l * 256 + c0A), lb = *(const f32x2*)(a_ln_b + l * 256 + c0A);
    { u32x4 vw[6], gw[6];
#pragma unroll
      for (int k = 0; k < 6; ++k) { const int it = tid + k * NTHR, itc = it < A_ROWS * 32 ? it : A_ROWS * 32 - 1, r = itc >> 5, p = itc & 31, tok = t0 + r - 30, tokc = tok < 0 ? 0 : tok;
          const bf16_t* rp = PROJ + ((size_t)b * SEQ + tokc) * NP + 8 * p; vw[k] = *(const u32x4*)(rp + PC_AVAL); gw[k] = *(const u32x4*)(rp + PC_AGLU); }
#pragma unroll
      for (int k = 0; k < 6; ++k) { const int it = tid + k * NTHR, r = it >> 5, p = it & 31, tok = t0 + r - 30;
          float v[8], g[8]; unpack8(vw[k], v); unpack8(gw[k], g);
#pragma unroll
          for (int j = 0; j < 8; ++j) v[j] = tok < 0 ? 0.f : v[j] * sigm(g[j]);
          if (it < A_ROWS * 32) *(LAS u32x4*)(lds + r * 512 + p * 16) = pack8(v); } }
    __syncthreads();
    bf16x8 af[16];
    { const bf16_t* ap = ApwT + (size_t)l * 65536 + (size_t)(32 * w + (lane & 31)) * 256 + 8 * (lane >> 5);
#pragma unroll
      for (int ks = 0; ks < 16; ++ks) af[ks] = *(const bf16x8*)(ap + 16 * ks); }
    { const int p = pA, tg = tgA;
#pragma unroll 1
      for (int blk = 0; blk < 2; ++blk) { const int base = 16 * tg + 8 * blk;
        f32x2 in[38];
#pragma unroll
        for (int i = 0; i < 38; ++i) { const unsigned wv = *(const LAS unsigned*)(lds + (base + i) * 512 + p * 4); in[i] = (f32x2){bf_lo(wv), bf_hi(wv)}; }
        f32x2 acc[8];
#pragma unroll
        for (int o = 0; o < 8; ++o) acc[o] = cb;
#pragma unroll
        for (int j = 0; j < 31; ++j) { const f32x2 wj = {w0[j], w1[j]};
#pragma unroll
            for (int o = 0; o < 8; ++o) acc[o] = __builtin_elementwise_fma(wj, in[o + j], acc[o]); }
        float sv[8], qv[8];
#pragma unroll
        for (int o = 0; o < 8; ++o) { sv[o] = acc[o].x + acc[o].y; qv[o] = acc[o].x * acc[o].x + acc[o].y * acc[o].y; }
#pragma unroll
        for (int o = 0; o < 8; ++o) { sv[o] = sum32(sv[o]); qv[o] = sum32(qv[o]); }
#pragma unroll
        for (int o = 0; o < 8; ++o) { const float mean = sv[o] * (1.f / 64.f), var = fmaxf(qv[o] * (1.f / 64.f) - mean * mean, 0.f), rstd = rsq(var + EPS);
            const float v0 = (acc[o].x - mean) * rstd * lg.x + lb.x, v1 = (acc[o].y - mean) * rstd * lg.y + lb.y;
            *(LAS unsigned*)(lds + A_S_OFF + (base + o) * A_S_STRIDE + p * 4) = pk2(silu(v0), silu(v1)); } } }
    __syncthreads();
    { const int r = lane & 31, h = lane >> 5;
      u32x2 gwA[2][4];
#pragma unroll
      for (int tt = 0; tt < 2; ++tt)
#pragma unroll
          for (int g4 = 0; g4 < 4; ++g4) gwA[tt][g4] = *(const u32x2*)(PROJ + (m0 + 32 * tt + r) * NP + PC_AGATE + 32 * w + 8 * g4 + 4 * h);
      f32x16 acc[2];
#pragma unroll
      for (int tt = 0; tt < 2; ++tt) { acc[tt] = (f32x16)(0.f);
#pragma unroll
          for (int ks = 0; ks < 16; ++ks) { const bf16x8 bfr = *(const LAS bf16x8*)(lds + A_S_OFF + (32 * tt + r) * A_S_STRIDE + (16 * ks + 8 * h) * 2); acc[tt] = MFMA32(af[ks], bfr, acc[tt]); } }
#pragma unroll
      for (int tt = 0; tt < 2; ++tt) { const size_t tok = m0 + 32 * tt + r;
#pragma unroll
          for (int g4 = 0; g4 < 4; ++g4) { const int n = 32 * w + 8 * g4 + 4 * h; const u32x2 gw = gwA[tt][g4];
              u32x2 o; o.x = pk2(acc[tt][4 * g4 + 0] * silu(bf_lo(gw.x)), acc[tt][4 * g4 + 1] * silu(bf_hi(gw.x))); o.y = pk2(acc[tt][4 * g4 + 2] * silu(bf_lo(gw.y)), acc[tt][4 * g4 + 3] * silu(bf_hi(gw.y)));
              *(u32x2*)(Y + tok * DM + n) = o; } } }
    __syncthreads();
}

constexpr int B_VT_OFF = 256 * 144, B_VT_STRIDE = 536;
__device__ __forceinline__ void mixer_b(Frame& F, int l, int unit) {
    CArgs* A = get_args(); const float* b_q_g = A->in[I_B_Q_G]; const float* b_k_g = A->in[I_B_K_G]; const float* b_sinks = A->in[I_B_SINKS]; bf16_t* Y = WSP(bf16_t, WS_Y); bf16_t* PROJ = WSP(bf16_t, WS_PROJ);
    LAS unsigned char* lds = F.lds; const int tid = F.tid, lane = F.lane, w = F.wave;
    const int b = unit >> 6, qb = (unit >> 1) & 31, kvh = unit & 1, t0 = qb * 128;
    { float kg[8]; const int pc = tid & 7;
#pragma unroll
      for (int j = 0; j < 8; ++j) kg[j] = b_k_g[l * 64 + 8 * pc + j];
#pragma unroll
      for (int it = 0; it < 4; ++it) { const int i = it * NTHR + tid, key = i >> 3, tok = t0 - 128 + key; u32x4 kw = (u32x4){0u, 0u, 0u, 0u}, vw = kw;
        { const int tokc = tok < 0 ? 0 : tok; const bf16_t* rp = PROJ + ((size_t)b * SEQ + tokc) * NP + kvh * 64 + 8 * pc; kw = *(const u32x4*)(rp + PC_BK); vw = *(const u32x4*)(rp + PC_BV);
          if (tok < 0) { kw = (u32x4){0u, 0u, 0u, 0u}; vw = kw; } }
        float kf[8]; unpack8(kw, kf); float ss = 0.f;
#pragma unroll
        for (int j = 0; j < 8; ++j) ss = fmaf(kf[j], kf[j], ss);
        ss = sum8(ss);
        const float rs = rsq(ss * (1.f / 64.f) + EPS);
#pragma unroll
        for (int j = 0; j < 8; ++j) kf[j] = kf[j] * rs * kg[j];
        *(LAS u32x4*)(lds + key * 144 + pc * 16) = pack8(kf);
        const unsigned vv[4] = {vw.x, vw.y, vw.z, vw.w};
#pragma unroll
        for (int j = 0; j < 8; ++j) *(LAS bf16_t*)(lds + B_VT_OFF + (8 * pc + j) * B_VT_STRIDE + key * 2) = (bf16_t)((vv[j >> 1] >> (16 * (j & 1))) & 0xffffu); } }
    const int g = w >> 2, s = w & 3, head = 2 * kvh + g, r = lane & 31, h = lane >> 5;
    const size_t tokq = (size_t)b * SEQ + t0 + 32 * s + r;
    bf16x8 qf[4];
    { float q[32]; const bf16_t* qrow = PROJ + tokq * NP + PC_BQ + head * 64 + 8 * h; float ss = 0.f;
#pragma unroll
      for (int ks = 0; ks < 4; ++ks) { const u32x4 wv = *(const u32x4*)(qrow + 16 * ks); float t8[8]; unpack8(wv, t8);
#pragma unroll
          for (int j = 0; j < 8; ++j) { q[8 * ks + j] = t8[j]; ss = fmaf(t8[j], t8[j], ss); } }
      ss = xsum32(ss);
      const float rs = rsq(ss * (1.f / 64.f) + EPS) * 0.125f;
#pragma unroll
      for (int ks = 0; ks < 4; ++ks) { float t8[8];
#pragma unroll
          for (int j = 0; j < 8; ++j) t8[j] = q[8 * ks + j] * rs * b_q_g[l * 64 + 16 * ks + 8 * h + j];
          qf[ks] = as_frag(pack8(t8)); } }
    u32x2 gwB[2][4];
#pragma unroll
    for (int et = 0; et < 2; ++et)
#pragma unroll
        for (int g4 = 0; g4 < 4; ++g4) gwB[et][g4] = *(const u32x2*)(PROJ + tokq * NP + PC_BGATE + head * 64 + 32 * et + 8 * g4 + 4 * h);
    f32x16 S[5];
    { const f32x4* bt = (const f32x4*)(WSP(float, WS_BIAS)) + (size_t)head * 5 * 4 * 64 + lane;
#pragma unroll
      for (int kt = 0; kt < 5; ++kt)
#pragma unroll
          for (int q4 = 0; q4 < 4; ++q4) { const f32x4 v = bt[(kt * 4 + q4) * 64]; S[kt][4 * q4 + 0] = v.x; S[kt][4 * q4 + 1] = v.y; S[kt][4 * q4 + 2] = v.z; S[kt][4 * q4 + 3] = v.w; } }
    __syncthreads();
#pragma unroll
    for (int kt = 0; kt < 5; ++kt) { const int kb = 32 * (s + kt);
#pragma unroll
        for (int ks = 0; ks < 4; ++ks) { const bf16x8 a = *(const LAS bf16x8*)(lds + (kb + r) * 144 + (16 * ks + 8 * h) * 2); S[kt] = MFMA32(a, qf[ks], S[kt]); } }
    const float sink = b_sinks[l * 4 + head]; float mx = sink;
#pragma unroll
    for (int kt = 0; kt < 5; ++kt) { const bool dead = (t0 == 0) && (s + kt < 4);
#pragma unroll
        for (int rg = 0; rg < 16; ++rg) { const float v = dead ? -INFINITY : S[kt][rg]; S[kt][rg] = v; mx = fmaxf(mx, v); } }
    mx = xmax32(mx);
    float sum = 0.f;
#pragma unroll
    for (int kt = 0; kt < 5; ++kt)
#pragma unroll
        for (int rg = 0; rg < 16; ++rg) { const float p = fexp(S[kt][rg] - mx); S[kt][rg] = p; sum += p; }
    sum = xsum32(sum);
    const float inv = 1.0f / (sum + fexp(sink - mx));
    f32x16 O[2]; O[0] = (f32x16)(0.f); O[1] = (f32x16)(0.f);
#define B_PV(kt, SP) do { const bf16x8 pf = frag_acc<8 * SP>(S[kt]); const int kb = 32 * (s + kt) + 16 * SP + 4 * h; \
        _Pragma("unroll") for (int et = 0; et < 2; ++et) { const LAS unsigned char* vp = lds + B_VT_OFF + (32 * et + r) * B_VT_STRIDE + kb * 2; \
            const u32x2 lo = *(const LAS u32x2*)vp, hi = *(const LAS u32x2*)(vp + 16); O[et] = MFMA32(as_frag((u32x4){lo.x, lo.y, hi.x, hi.y}), pf, O[et]); } } while (0)
#pragma unroll
    for (int kt = 0; kt < 5; ++kt) { B_PV(kt, 0); B_PV(kt, 1); }
#undef B_PV
#pragma unroll
    for (int et = 0; et < 2; ++et)
#pragma unroll
        for (int g4 = 0; g4 < 4; ++g4) { const int d = 32 * et + 8 * g4 + 4 * h; const u32x2 gw = gwB[et][g4];
            u32x2 o; o.x = pk2(O[et][4 * g4 + 0] * inv * silu(bf_lo(gw.x)), O[et][4 * g4 + 1] * inv * silu(bf_hi(gw.x))); o.y = pk2(O[et][4 * g4 + 2] * inv * silu(bf_lo(gw.y)), O[et][4 * g4 + 3] * inv * silu(bf_hi(gw.y)));
            *(u32x2*)(Y + tokq * DM + 256 + head * 64 + d) = o; }
    __syncthreads();
}
constexpr int C_AA = 128 * 144, C_UU = C_AA + 64 * 129 * 4, C_SEG = C_UU + 64 * 129 * 4, C_CARRY = C_SEG + 8192, C_CST = C_CARRY + 512, C_LOOK = C_CST + 1024;
constexpr unsigned SPIN_CAP = 1u << 16;
__device__ __forceinline__ void gr_store(unsigned long long* g, unsigned tag, float v) { __hip_atomic_store(g, ((unsigned long long)tag << 32) | (unsigned long long)__float_as_uint(v), __ATOMIC_RELAXED, __HIP_MEMORY_SCOPE_AGENT); }
__device__ __forceinline__ unsigned long long gr_load(const unsigned long long* g) { return __hip_atomic_load(g, __ATOMIC_RELAXED, __HIP_MEMORY_SCOPE_AGENT); }
__device__ __forceinline__ void mixer_c(Frame& F, int l, int unit, unsigned* qh, unsigned& nxt) {
    CArgs* A = get_args(); const float* c_conv_w = A->in[I_C_CONV_W]; const float* c_conv_b = A->in[I_C_CONV_B]; const float* c_b_r = A->in[I_C_B_R]; const float* c_b_i = A->in[I_C_B_I]; const float* c_lambda = A->in[I_C_LAMBDA]; bf16_t* WrT = WSP(bf16_t, WS_WR); bf16_t* WiT = WSP(bf16_t, WS_WI); bf16_t* Y = WSP(bf16_t, WS_Y); bf16_t* PROJ = WSP(bf16_t, WS_PROJ);
    unsigned long long* GC = WSP(unsigned long long, WS_GC);
    LAS unsigned char* lds = F.lds; const int tid = F.tid, lane = F.lane, w = F.wave;
    const int pair = unit >> 4, b = (unit >> 2) & 3, n = unit & 3; const unsigned tag = (unsigned)l + 1u;
    LAS float* Aa = (LAS float*)(lds + C_AA); LAS float* Uu = (LAS float*)(lds + C_UU); LAS float* SegX = (LAS float*)(lds + C_SEG); LAS float* Carry = (LAS float*)(lds + C_CARRY); LAS float* Cst = (LAS float*)(lds + C_CST); LAS float* LookY = (LAS float*)(lds + C_LOOK);
    const int pc = tid & 7, trow = tid >> 3;
    const int tt = w & 3, mt = w >> 2, r = lane & 31, h = lane >> 5;
    const int sc = tid & 63, seg = tid >> 6;
    u32x4 xin[2][2][4];
#pragma unroll
    for (int hf = 0; hf < 2; ++hf)
#pragma unroll
        for (int it = 0; it < 2; ++it) { const int tok = 128 * (2 * pair + hf) + trow + 64 * it; const bf16_t* rp = PROJ + (size_t)b * SEQ * NP + 64 * n + 8 * pc;
#pragma unroll
            for (int jj = 0; jj < 4; ++jj) { const int tk = tok - 3 + jj, tkc = tk < 0 ? 0 : tk; xin[hf][it][jj] = *(const u32x4*)(rp + (size_t)tkc * NP + PC_CX); } }
    if (tid < 64) { const int cg = l * 256 + 64 * n + tid;
        Cst[4 * tid + 0] = c_b_r[cg]; Cst[4 * tid + 1] = c_b_i[cg]; Cst[4 * tid + 2] = -8.0f * log1pf(expf(-c_lambda[cg])); Cst[4 * tid + 3] = 0.f; }
    bf16x8 wrf[4], wif[4];
#pragma unroll
    for (int ks = 0; ks < 4; ++ks) { const size_t o = ((size_t)(l * 4 + n) * 64 + 32 * mt + r) * 64 + 16 * ks + 8 * h; wrf[ks] = *(const bf16x8*)(WrT + o); wif[ks] = *(const bf16x8*)(WiT + o); }
    unsigned long long* gbase = GC + ((size_t)((b * 4 + n) * 32) * 128) + 2 * lane;
    float a[2][16], u[2][16];
#pragma unroll
    for (int hf = 0; hf < 2; ++hf) { const int tile = 2 * pair + hf, t0 = tile * 128; LAS float* Seg = SegX + 1024 * hf;
        float cw[4][8], cb[8];
#pragma unroll
        for (int j = 0; j < 8; ++j) { cb[j] = c_conv_b[l * 256 + 64 * n + 8 * pc + j];
#pragma unroll
            for (int jj = 0; jj < 4; ++jj) cw[jj][j] = c_conv_w[((size_t)l * 4 + jj) * 256 + 64 * n + 8 * pc + j]; }
#pragma unroll
        for (int it = 0; it < 2; ++it) { const int t = trow + 64 * it, tok = t0 + t; float acc[8];
#pragma unroll
            for (int j = 0; j < 8; ++j) acc[j] = cb[j];
#pragma unroll
            for (int jj = 0; jj < 4; ++jj) { float x8[8]; unpack8(xin[hf][it][jj], x8); const float m = (tok - 3 + jj) < 0 ? 0.f : 1.f;
#pragma unroll
                for (int j = 0; j < 8; ++j) acc[j] = fmaf(cw[jj][j] * m, x8[j], acc[j]); }
            *(LAS u32x4*)(lds + t * 144 + pc * 16) = pack8(acc); }
        __syncthreads();
        { f32x16 R = (f32x16)(0.f), I = (f32x16)(0.f);
#pragma unroll
          for (int ks = 0; ks < 4; ++ks) { const bf16x8 bfr = *(const LAS bf16x8*)(lds + (32 * tt + r) * 144 + (16 * ks + 8 * h) * 2); R = MFMA32(wrf[ks], bfr, R); I = MFMA32(wif[ks], bfr, I); }
          const int t = 32 * tt + r;
#pragma unroll
          for (int g4 = 0; g4 < 4; ++g4) { const int c0 = 32 * mt + 8 * g4 + 4 * h; const u32x2 xw = *(const LAS u32x2*)(lds + t * 144 + c0 * 2);
              const float xc[4] = {bf_lo(xw.x), bf_hi(xw.x), bf_lo(xw.y), bf_hi(xw.y)};
#pragma unroll
              for (int j = 0; j < 4; ++j) { const f32x4 cs = *(const LAS f32x4*)(Cst + 4 * (c0 + j));
                  const float rr = sigm(R[4 * g4 + j] + cs.x), ii = sigm(I[4 * g4 + j] + cs.y), la = cs.z * rr, av = fexp(la), uv = __builtin_amdgcn_sqrtf(fmaxf(one_minus_exp(2.0f * la), 0.f)) * (ii * xc[j]);
                  Aa[(c0 + j) * 129 + t] = av; Uu[(c0 + j) * 129 + t] = uv; }
              __builtin_amdgcn_sched_barrier(0); } }
        __syncthreads();
        { float Ap = 1.f, Hp = 0.f;
#pragma unroll
          for (int i = 0; i < 16; ++i) { a[hf][i] = Aa[sc * 129 + 16 * seg + i]; u[hf][i] = Uu[sc * 129 + 16 * seg + i]; }
#pragma unroll
          for (int i = 0; i < 16; ++i) { Hp = fmaf(a[hf][i], Hp, u[hf][i]); Ap *= a[hf][i]; }
          Seg[(seg * 64 + sc) * 2] = Ap; Seg[(seg * 64 + sc) * 2 + 1] = Hp; }
        __syncthreads();
        if (w == 0) { float At = 1.f, Ht = 0.f;
#pragma unroll
            for (int s2 = 0; s2 < 8; ++s2) { const float As = Seg[(s2 * 64 + lane) * 2], Hs = Seg[(s2 * 64 + lane) * 2 + 1]; Ht = fmaf(As, Ht, Hs); At *= As; }
            gr_store(gbase + (size_t)tile * 128, tag, At); gr_store(gbase + (size_t)tile * 128 + 1, tag, Ht); }
    }
    { const int tile = 2 * pair; float Aw = 1.f, Hw = 0.f; const int p0 = 4 * w;
      if (p0 < tile) { unsigned long long ga[4], gh[4]; unsigned spins = 0;
          for (;;) { bool ok = true;
#pragma unroll
              for (int k = 0; k < 4; ++k) { const int p = (p0 + k < tile) ? p0 + k : tile - 1; ga[k] = gr_load(gbase + (size_t)p * 128); gh[k] = gr_load(gbase + (size_t)p * 128 + 1);
                  ok = ok && ((unsigned)(ga[k] >> 32) == tag) && ((unsigned)(gh[k] >> 32) == tag); }
              if (__all(ok) || ++spins > SPIN_CAP) break;
              __builtin_amdgcn_s_sleep(2); }
#pragma unroll
          for (int k = 0; k < 4; ++k) if (p0 + k < tile) { const float Ap = __uint_as_float((unsigned)ga[k]), Hp = __uint_as_float((unsigned)gh[k]); Hw = fmaf(Ap, Hw, Hp); Aw *= Ap; } }
      LookY[(w * 64 + lane) * 2] = Aw; LookY[(w * 64 + lane) * 2 + 1] = Hw; }
    __syncthreads();
    if (tid == 0) nxt = __hip_atomic_fetch_add(qh, 1u, __ATOMIC_RELAXED, __HIP_MEMORY_SCOPE_AGENT);
#pragma unroll
    for (int hf = 0; hf < 2; ++hf) { const int t0 = (2 * pair + hf) * 128; const LAS float* Seg = SegX + 1024 * hf;
        u32x4 gwC[2];
#pragma unroll
        for (int it = 0; it < 2; ++it) gwC[it] = *(const u32x4*)(PROJ + ((size_t)b * SEQ + t0 + trow + 64 * it) * NP + PC_CGATE + 64 * n + 8 * pc);
        { float hh = 0.f;
          if (hf == 0) {
#pragma unroll
              for (int w2 = 0; w2 < 8; ++w2) hh = fmaf(LookY[(w2 * 64 + sc) * 2], hh, LookY[(w2 * 64 + sc) * 2 + 1]);
          } else hh = Carry[sc];
          for (int s2 = 0; s2 < seg; ++s2) hh = fmaf(Seg[(s2 * 64 + sc) * 2], hh, Seg[(s2 * 64 + sc) * 2 + 1]);
#pragma unroll
          for (int i = 0; i < 16; ++i) { hh = fmaf(a[hf][i], hh, u[hf][i]); Uu[sc * 129 + 16 * seg + i] = hh; }
          if (hf == 0 && seg == 7) Carry[sc] = hh; }
        __syncthreads();
#pragma unroll
        for (int it = 0; it < 2; ++it) { const int t = trow + 64 * it; const size_t tokg = (size_t)b * SEQ + t0 + t;
            float g8[8], y8[8]; unpack8(gwC[it], g8);
#pragma unroll
            for (int j = 0; j < 8; ++j) y8[j] = Uu[(8 * pc + j) * 129 + t] * silu(g8[j]);
            *(u32x4*)(Y + tokg * DM + 512 + 64 * n + 8 * pc) = pack8(y8); }
        if (hf == 0) __syncthreads();
    }
    __syncthreads();
}

typedef short s16x4 __attribute__((ext_vector_type(4)));
__device__ __forceinline__ u32x2 tr_read4(const LAS unsigned char* p) { const s16x4 v = __builtin_amdgcn_ds_read_tr16_b64_v4i16((LAS s16x4*)p); return __builtin_bit_cast(u32x2, v); }

constexpr int D_WAVE = 14464, D_VT = 5120, D_DEC = 14336, D_SST = 8 * D_WAVE, D_SIN = D_SST  , D_PDL = D_SST + 8192;
static_assert(D_PDL + 128 <= RING_BYTES, "mixer D LDS map");
constexpr int GD_STRIDE = 2112;
__device__ __forceinline__ void mixer_d(Frame& F, int l, int unit) {
    CArgs* A = get_args(); const float* d_w_up = A->in[I_D_W_UP]; const float* d_b_up = A->in[I_D_B_UP]; const float* d_norm_g = A->in[I_D_NORM_G]; bf16_t* Y = WSP(bf16_t, WS_Y); bf16_t* PROJ = WSP(bf16_t, WS_PROJ);
    unsigned long long* GD = WSP(unsigned long long, WS_GD);
    const int tid = F.tid, lane = F.lane, w = F.wave;
    const int grp = unit >> 4, b = (unit >> 2) & 3, head = unit & 3, r = lane & 31, h = lane >> 5; const unsigned tag = (unsigned)l + 1u;
    LAS unsigned char* scr = F.lds + w * D_WAVE; LAS unsigned char* VT = scr + D_VT; LAS float* Dec = (LAS float*)(scr + D_DEC); LAS f32x4* Sst = (LAS f32x4*)(F.lds + D_SST); LAS f32x4* Sin = (LAS f32x4*)(F.lds + D_SIN); LAS float* Pdl = (LAS float*)(F.lds + D_PDL);
    bf16x8 wupf; { float t8[8];
#pragma unroll
        for (int j = 0; j < 8; ++j) t8[j] = d_w_up[((size_t)l * 16 + 8 * h + j) * 128 + 32 * head + r];
        wupf = as_frag(pack8(t8)); }
    const float bup = d_b_up[l * 128 + 32 * head + r];
    Sst[tid] = (f32x4){0.f, 0.f, 0.f, 0.f}; if (tid < 32) Pdl[tid] = 1.f;
    __syncthreads();
    const int chunk = 8 * grp + w; const size_t mrow0 = (size_t)b * SEQ + 64 * chunk;
    float qv[32], kv[32], bb[32];
    f32x16 G[2];
#pragma unroll
    for (int tile = 0; tile < 2; ++tile) { const bf16x8 lrf = *(const bf16x8*)(PROJ + (mrow0 + 32 * tile + r) * NP + PC_DLR + 8 * h); G[tile] = MFMA32(lrf, wupf, (f32x16)(0.f)); }
    { const bf16_t* qbase = PROJ + mrow0 * NP + PC_DQ + 32 * head; const unsigned loff = (unsigned)(4 * h * NP + r);
#pragma unroll
      for (int i = 0; i < 32; ++i) { const unsigned o = loff + (unsigned)((32 * (i >> 4) + 8 * ((i >> 2) & 3) + (i & 3)) * NP);
          qv[i] = __uint_as_float((unsigned)qbase[o] << 16); kv[i] = __uint_as_float((unsigned)qbase[o + (PC_DK - PC_DQ)] << 16); } }
    float run = 0.f;
#pragma unroll
    for (int k = 0; k < 8; ++k) { float c[4];
#pragma unroll
        for (int j = 0; j < 4; ++j) { const float z = G[k >> 2][4 * (k & 3) + j] + bup; const float gl = -(fmaxf(-z, 0.f) + log1p_01(fexp(-fabsf(z)))) * (1.f / 16.f); c[j] = (j ? c[j - 1] : 0.f) + gl; }
        const float tot = c[3], ptot = xget32(tot, h); const float pre = run + (h ? ptot : 0.f);
#pragma unroll
        for (int j = 0; j < 4; ++j) bb[4 * k + j] = pre + c[j];
        run += tot + ptot; }
    const float blast = run, dec = fexp(blast);
    if (h == 0) Dec[r] = dec;
#pragma unroll
    for (int i = 0; i < 32; ++i) { const int t = 32 * (i >> 4) + 8 * ((i >> 2) & 3) + 4 * h + (i & 3); *(LAS bf16_t*)(scr + t * 80 + r * 2) = (bf16_t)f2bf(qv[i] * 0.17677669529663687f * fexp(bb[i])); }
    __builtin_amdgcn_wave_barrier(); asm volatile("" ::: "memory");
    bf16x8 qB[2][2], qP[2][2];
#pragma unroll
    for (int it = 0; it < 2; ++it)
#pragma unroll
        for (int ks = 0; ks < 2; ++ks) { const LAS unsigned char* p = scr + (32 * it + r) * 80; qB[it][ks] = *(const LAS bf16x8*)(p + (16 * ks + 8 * h) * 2);
            const u32x2 lo = *(const LAS u32x2*)(p + (16 * ks + 4 * h) * 2), hi = *(const LAS u32x2*)(p + (16 * ks + 8 + 4 * h) * 2); qP[it][ks] = as_frag((u32x4){lo.x, lo.y, hi.x, hi.y}); }
    __builtin_amdgcn_wave_barrier(); asm volatile("" ::: "memory");
#pragma unroll
    for (int i = 0; i < 32; ++i) { const int t = 32 * (i >> 4) + 8 * ((i >> 2) & 3) + 4 * h + (i & 3); *(LAS bf16_t*)(scr + t * 80 + r * 2) = (bf16_t)f2bf(kv[i] * fexp(-bb[i])); }
    __builtin_amdgcn_wave_barrier(); asm volatile("" ::: "memory");
    bf16x8 kA[2][2];
#pragma unroll
    for (int jt = 0; jt < 2; ++jt)
#pragma unroll
        for (int ks = 0; ks < 2; ++ks) kA[jt][ks] = *(const LAS bf16x8*)(scr + (32 * jt + r) * 80 + (16 * ks + 8 * h) * 2);
    __builtin_amdgcn_wave_barrier(); asm volatile("" ::: "memory");
#pragma unroll
    for (int k = 0; k < 8; ++k) { const int t = 32 * (k >> 2) + 8 * (k & 3) + 4 * h; u32x2 o;
        o.x = pk2(kv[4 * k + 0] * fexp(blast - bb[4 * k + 0]), kv[4 * k + 1] * fexp(blast - bb[4 * k + 1])); o.y = pk2(kv[4 * k + 2] * fexp(blast - bb[4 * k + 2]), kv[4 * k + 3] * fexp(blast - bb[4 * k + 3]));
        *(LAS u32x2*)(scr + r * 144 + t * 2) = o; }
    __builtin_amdgcn_wave_barrier(); asm volatile("" ::: "memory");
    bf16x8 keA[4];
#pragma unroll
    for (int ks = 0; ks < 4; ++ks) keA[ks] = *(const LAS bf16x8*)(scr + r * 144 + (16 * ks + 8 * h) * 2);
#pragma unroll
    for (int i8 = 0; i8 < 8; ++i8) { const int tv = 8 * i8 + (lane >> 3), pc = lane & 7; const u32x4 vw = *(const u32x4*)(PROJ + (mrow0 + tv) * NP + PC_DV + 64 * head + 8 * pc);
        *(LAS u32x4*)(VT + tv * 144 + pc * 16) = vw; }
    const LAS unsigned char* vrb = VT + ((lane & 15) >> 2) * 144 + (16 * ((lane >> 4) & 1) + 4 * (lane & 3)) * 2;
    __builtin_amdgcn_wave_barrier(); asm volatile("" ::: "memory");
    bf16x8 P[3][2];
#define D_ATT(idx, jt, it) do { f32x16 acc = (f32x16)(0.f); acc = MFMA32(kA[jt][0], qB[it][0], acc); acc = MFMA32(kA[jt][1], qB[it][1], acc); \
    if (jt == it) { const int rr = r - 4 * h; _Pragma("unroll") for (int rg = 0; rg < 16; ++rg) { acc[rg] = (rr < (rg & 3) + 8 * (rg >> 2)) ? 0.f : acc[rg]; } } \
    P[idx][0] = frag_acc<0>(acc); P[idx][1] = frag_acc<8>(acc); } while (0)
    D_ATT(0, 0, 0); __builtin_amdgcn_sched_barrier(0); D_ATT(1, 0, 1); __builtin_amdgcn_sched_barrier(0); D_ATT(2, 1, 1); __builtin_amdgcn_sched_barrier(0);
#undef D_ATT
    f32x16 ds[2];
#pragma unroll
    for (int et = 0; et < 2; ++et) { ds[et] = (f32x16)(0.f);
#pragma unroll
        for (int ks = 0; ks < 4; ++ks) { const LAS unsigned char* vp = vrb + (16 * ks + 8 * h) * 144 + 64 * et; const u32x2 lo = tr_read4(vp), hi = tr_read4(vp + 4 * 144);
            ds[et] = MFMA32(keA[ks], as_frag((u32x4){lo.x, lo.y, hi.x, hi.y}), ds[et]); } }
    f32x16 L[2]; float pdv[16], dv[16];
#pragma unroll
    for (int q4 = 0; q4 < 4; ++q4) { const f32x4 v = *(const LAS f32x4*)(Dec + 8 * q4 + 4 * h); dv[4 * q4 + 0] = v.x; dv[4 * q4 + 1] = v.y; dv[4 * q4 + 2] = v.z; dv[4 * q4 + 3] = v.w; }
#pragma unroll 1
    for (int step = 0; step < 8; ++step) {
        if (w == step) {
#pragma unroll
            for (int q4 = 0; q4 < 4; ++q4) { const f32x4 v = *(const LAS f32x4*)(Pdl + 8 * q4 + 4 * h); pdv[4 * q4 + 0] = v.x; pdv[4 * q4 + 1] = v.y; pdv[4 * q4 + 2] = v.z; pdv[4 * q4 + 3] = v.w; }
#pragma unroll
            for (int et = 0; et < 2; ++et)
#pragma unroll
                for (int q4 = 0; q4 < 4; ++q4) { const f32x4 v = Sst[(et * 4 + q4) * 64 + lane]; L[et][4 * q4 + 0] = v.x; L[et][4 * q4 + 1] = v.y; L[et][4 * q4 + 2] = v.z; L[et][4 * q4 + 3] = v.w;
                    f32x4 nv; nv.x = fmaf(v.x, dv[4 * q4 + 0], ds[et][4 * q4 + 0]); nv.y = fmaf(v.y, dv[4 * q4 + 1], ds[et][4 * q4 + 1]); nv.z = fmaf(v.z, dv[4 * q4 + 2], ds[et][4 * q4 + 2]); nv.w = fmaf(v.w, dv[4 * q4 + 3], ds[et][4 * q4 + 3]);
                    Sst[(et * 4 + q4) * 64 + lane] = nv; }
            if (lane < 32) Pdl[lane] = Pdl[lane] * Dec[lane]; }
        __syncthreads(); }
    { unsigned long long* gmine = GD + (size_t)((b * 4 + head) * 8 + grp) * GD_STRIDE; const f32x4 sv = Sst[tid];
      gr_store(gmine + 4 * tid + 0, tag, sv.x); gr_store(gmine + 4 * tid + 1, tag, sv.y); gr_store(gmine + 4 * tid + 2, tag, sv.z); gr_store(gmine + 4 * tid + 3, tag, sv.w);
      if (tid < 32) gr_store(gmine + 2048 + tid, tag, Pdl[tid]);
      f32x4 sin = (f32x4){0.f, 0.f, 0.f, 0.f}; const int d0 = 8 * ((tid >> 6) & 3) + 4 * ((tid >> 5) & 1);
      const unsigned long long* gb = GD + (size_t)((b * 4 + head) * 8) * GD_STRIDE;
      for (int p0 = 0; p0 < grp; p0 += 4) { unsigned long long gs[4][4], gd[4][4]; unsigned spins = 0;
          for (;;) { bool ok = true;
#pragma unroll
              for (int k = 0; k < 4; ++k) { const int p = (p0 + k < grp) ? p0 + k : grp - 1; const unsigned long long* gp = gb + (size_t)p * GD_STRIDE;
#pragma unroll
                  for (int e = 0; e < 4; ++e) { gs[k][e] = gr_load(gp + 4 * tid + e); gd[k][e] = gr_load(gp + 2048 + d0 + e); ok = ok && ((unsigned)(gs[k][e] >> 32) == tag) && ((unsigned)(gd[k][e] >> 32) == tag); } }
              if (__all(ok) || ++spins > SPIN_CAP) break;
              __builtin_amdgcn_s_sleep(2); }
#pragma unroll
          for (int k = 0; k < 4; ++k) if (p0 + k < grp) {
              sin.x = fmaf(sin.x, __uint_as_float((unsigned)gd[k][0]), __uint_as_float((unsigned)gs[k][0])); sin.y = fmaf(sin.y, __uint_as_float((unsigned)gd[k][1]), __uint_as_float((unsigned)gs[k][1]));
              sin.z = fmaf(sin.z, __uint_as_float((unsigned)gd[k][2]), __uint_as_float((unsigned)gs[k][2])); sin.w = fmaf(sin.w, __uint_as_float((unsigned)gd[k][3]), __uint_as_float((unsigned)gs[k][3])); } }
      Sin[tid] = sin; }
    __syncthreads();
    bf16x8 SA[2][2];
#pragma unroll
    for (int et = 0; et < 2; ++et) {
#pragma unroll
        for (int q4 = 0; q4 < 4; ++q4) { const f32x4 v = Sin[(et * 4 + q4) * 64 + lane]; L[et][4 * q4 + 0] = fmaf(pdv[4 * q4 + 0], v.x, L[et][4 * q4 + 0]); L[et][4 * q4 + 1] = fmaf(pdv[4 * q4 + 1], v.y, L[et][4 * q4 + 1]);
            L[et][4 * q4 + 2] = fmaf(pdv[4 * q4 + 2], v.z, L[et][4 * q4 + 2]); L[et][4 * q4 + 3] = fmaf(pdv[4 * q4 + 3], v.w, L[et][4 * q4 + 3]); }
        SA[et][0] = frag_acc<0>(L[et]); SA[et][1] = frag_acc<8>(L[et]); }
#pragma unroll
    for (int it = 0; it < 2; ++it) { f32x16 o[2]; o[0] = (f32x16)(0.f); o[1] = (f32x16)(0.f);
#pragma unroll
        for (int jt = 0; jt <= it; ++jt) { const int idx = (jt == 0) ? it : 2;
#pragma unroll
            for (int sp = 0; sp < 2; ++sp)
#pragma unroll
                for (int et = 0; et < 2; ++et) { const LAS unsigned char* vp = vrb + (32 * jt + 16 * sp + 4 * h) * 144 + 64 * et; const u32x2 lo = tr_read4(vp), hi = tr_read4(vp + 8 * 144);
                    o[et] = MFMA32(as_frag((u32x4){lo.x, lo.y, hi.x, hi.y}), P[idx][sp], o[et]); } }
#pragma unroll
        for (int ks = 0; ks < 2; ++ks)
#pragma unroll
            for (int et = 0; et < 2; ++et) o[et] = MFMA32(SA[et][ks], qP[it][ks], o[et]);
        float ss = 0.f;
#pragma unroll
        for (int et = 0; et < 2; ++et)
#pragma unroll
            for (int rg = 0; rg < 16; ++rg) ss = fmaf(o[et][rg], o[et][rg], ss);
        ss = xsum32(ss);
        const float rstd = rsq(ss * (1.f / 64.f) + EPS); const size_t tok = mrow0 + 32 * it + r;
#pragma unroll
        for (int et = 0; et < 2; ++et)
#pragma unroll
            for (int g4 = 0; g4 < 4; ++g4) { const int e = 32 * et + 8 * g4 + 4 * h; const f32x4 ng = *(const f32x4*)(d_norm_g + l * 64 + e); const u32x2 gw = *(const u32x2*)(PROJ + tok * NP + PC_DGATE + 64 * head + e);
                u32x2 ov; ov.x = pk2(o[et][4 * g4 + 0] * rstd * ng.x * silu(bf_lo(gw.x)), o[et][4 * g4 + 1] * rstd * ng.y * silu(bf_hi(gw.x)));
                ov.y = pk2(o[et][4 * g4 + 2] * rstd * ng.z * silu(bf_lo(gw.y)), o[et][4 * g4 + 3] * rstd * ng.w * silu(bf_hi(gw.y)));
                *(u32x2*)(Y + tok * DM + 768 + 64 * head + e) = ov; } }
    __syncthreads();
}

constexpr int U_D = 128, U_C = 256, U_B = 256, U_A = 256, U_MIX = U_C + U_D + U_B + U_A, U_W = (I_L + NWAVES - 1) / NWAVES;
__global__ void __launch_bounds__(NTHR, 2) fwd_kernel(Args args) {
    extern __shared__ __attribute__((aligned(16))) unsigned char lds_raw[];
    Frame F;
    F.lds = (LAS unsigned char*)lds_raw; F.MISC = (volatile LAS unsigned*)(F.lds + MISC_OFF);
    F.tid = threadIdx.x; F.lane = F.tid & 63; F.wave = __builtin_amdgcn_readfirstlane(F.tid >> 6); F.G = gridDim.x;
    for (int u = F.tid; u < 256; u += NTHR) ((LAS unsigned*)(F.lds + LDSCTL_OFF))[u] = 0u;
    __syncthreads();
    XcdBarrier bar = xcd_barrier_post((unsigned*)(args.ws + WS_CTL) + CW_BAR, F.MISC + 8);
#define GRID_BAR() xcd_barrier(bar)
    p0_prologue(F);
    GRID_BAR();
#pragma unroll 1
    for (int l = 0; l < DEPTH; ++l) {
        { CArgs* A = get_args();
          pg8::Gemm g{WSP(bf16_t, WS_XB), WSP(bf16_t, WS_WIN) + (size_t)l * NP * DM, M, NP, DM}; pg8::StaticOrder S; S.init(M, NP, F.G, (int)blockIdx.x);
          pg8::EpiProj E{WSP(bf16_t, WS_PROJ), NP, WSP(float, WS_SSQ), __builtin_amdgcn_make_buffer_rsrc(WSP(bf16_t, WS_PROJ), 0, (int)((size_t)M * NP * 2), 0x00020000)};
          pg8::gemm_phase<pg8::EpiProj, pg8::StaticOrder, true, true>(F.lds, g, S, E); }
        int all_seen = 1;
        if (F.G == 256) { all_seen = 0;
            asm volatile("s_waitcnt vmcnt(0)" ::: "memory"); __syncthreads();
            if (F.tid == 0) { const int c = (int)blockIdx.x; unsigned* ctl = (unsigned*)(args.ws + WS_CTL);
                __hip_atomic_fetch_add(ctl + CW_PCNT + 64 * (l * 64 + 8 * (c & 7) + ((c >> 3) & 7)), 1u, RLX_AGENT); __hip_atomic_fetch_add(ctl + CW_GDONE + 64 * l, 1u, RLX_AGENT); }
        } else GRID_BAR();
        { CArgs* A = get_args(); unsigned* qh = WSP(unsigned, WS_CTL) + CW_Q + 64 * l;
          __syncthreads();
          if (F.tid == 0) F.MISC[16] = __hip_atomic_fetch_add(qh, 1u, RLX_AGENT);
          __syncthreads();
          int u = (int)F.MISC[16];
          const int U_TOTAL = U_MIX + (l + 1 < DEPTH ? U_W : 0);
          while (u < U_TOTAL) {
              const bool pre = u >= U_D + U_C;
              unsigned nxt = 0u; if (pre && F.tid == 0) nxt = __hip_atomic_fetch_add(qh, 1u, RLX_AGENT);
              if (!all_seen) {
                  if (F.tid == 0) { int need = 1, bb = 0, lo = 0, hi = 0;
                      if (u < U_D) { bb = (u >> 2) & 3; lo = 512 * (u >> 4); hi = lo + 511; }
                      else if (u < U_C + U_D) { const int uc = u - U_D; bb = (uc >> 2) & 3; lo = 256 * (uc >> 4) - 3; hi = lo + 258; }
                      else if (u < U_C + U_D + U_A) { const int ua = u - U_C - U_D; bb = ua >> 6; lo = 64 * (ua & 63) - 30; hi = lo + 93; }
                      else if (u < U_MIX) { const int ub = u - U_C - U_D - U_A; bb = ub >> 6; lo = 128 * ((ub >> 1) & 31) - 128; hi = lo + 255; }
                      else need = 0;
                      unsigned* ctl = (unsigned*)(A->ws + WS_CTL); unsigned* pc = ctl + CW_PCNT + 64 * (l * 64 + 16 * bb);
                      const int p0 = (lo < 0 ? 0 : lo) >> 8, p1 = hi >> 8; unsigned sp = 0;
                      if (need) while ((__hip_atomic_load(pc + 64 * p0, RLX_AGENT) < 4u || __hip_atomic_load(pc + 64 * p1, RLX_AGENT) < 4u) && ++sp < (1u << 20)) __builtin_amdgcn_s_sleep(1);
                      const unsigned gd = __hip_atomic_load(ctl + CW_GDONE + 64 * l, RLX_AGENT);
                      __builtin_amdgcn_fence(__ATOMIC_ACQUIRE, "agent"); asm volatile("s_waitcnt vmcnt(0)" ::: "memory");
                      F.MISC[18] = (gd >= (unsigned)F.G) ? 1u : 0u; }
                  __syncthreads();
                  all_seen = (int)F.MISC[18];
              }
              Frame FL = F; { int t = F.tid; asm volatile("" : "+v"(t)); FL.tid = t; FL.lane = t & 63; FL.wave = __builtin_amdgcn_readfirstlane(t >> 6); }
              if (u < U_D) { mixer_d(FL, l, u); }
              else if (u < U_C + U_D) { mixer_c(FL, l, u - U_D, qh, nxt); }
              else if (u < U_C + U_D + U_A) { mixer_a(FL, l, u - U_C - U_D); }
              else if (u < U_MIX) { mixer_b(FL, l, u - U_C - U_D - U_A); }
              else { const int it = (u - U_MIX) * NWAVES + FL.wave; if (it < I_L) convert_item(FL, l + 1, it); __syncthreads(); }
              if (F.tid == 0) F.MISC[16] = (pre || (u >= U_D && u < U_D + U_C)) ? nxt : __hip_atomic_fetch_add(qh, 1u, RLX_AGENT);
              __syncthreads();
              u = (int)F.MISC[16];
          }
        }
        GRID_BAR();
        { CArgs* A = get_args();
          pg8::Gemm g{WSP(bf16_t, WS_Y), WSP(bf16_t, WS_WOUT) + (size_t)l * DM * DM, M, DM, DM}; pg8::StaticOrder S; S.init(M, DM, F.G, (int)blockIdx.x);
          pg8::EpiRes E{A->in[I_X], A->out, WSP(bf16_t, WS_XB), WSP(float, WS_SSQ), l == 0 ? 0 : (l + 1 < DEPTH ? 1 : 2), __builtin_amdgcn_make_buffer_rsrc(WSP(bf16_t, WS_XB), 0, (int)((size_t)M * DM * 2), 0x00020000)};
          pg8::gemm_phase<pg8::EpiRes, pg8::StaticOrder, true, true>(F.lds, g, S, E); }
        if (l + 1 < DEPTH) {
            if (F.G == 256) {
                asm volatile("s_waitcnt vmcnt(0)" ::: "memory"); __syncthreads();
                if (F.tid == 0) { unsigned* cnt = (unsigned*)(args.ws + WS_CTL) + CW_TEAM + 64 * (l * 64 + ((int)blockIdx.x & 63));
                    __hip_atomic_fetch_add(cnt, 1u, RLX_AGENT);
                    unsigned sp = 0; while (__hip_atomic_load(cnt, RLX_AGENT) < 4u && ++sp < (1u << 20)) __builtin_amdgcn_s_sleep(1);
                    __builtin_amdgcn_fence(__ATOMIC_ACQUIRE, "agent"); asm volatile("s_waitcnt vmcnt(0)" ::: "memory"); }
                __syncthreads();
            } else GRID_BAR();
        }
    }
}

extern "C" void kernel_launch(void* const* d_in, const int* in_sizes, int n_in, void* d_out, int out_size, void* d_ws, size_t ws_size, hipStream_t stream) {
    static int grid = 0;
    if (grid == 0) {
        if (n_in != 23 || in_sizes[0] != M * DM || out_size != M * DM || ws_size < WS_END) { fprintf(stderr, "kernel_launch: unexpected problem shape (n_in %d, in0 %d, out %d, ws %zu)\n", n_in, n_in > 0 ? in_sizes[0] : -1, out_size, ws_size); grid = -1; return; }
        int dev = 0, cus = 0, per_cu = 0;
        if (hipGetDevice(&dev) != hipSuccess || hipDeviceGetAttribute(&cus, hipDeviceAttributeMultiprocessorCount, dev) != hipSuccess) { grid = -1; return; }
        if (hipFuncSetAttribute((const void*)fwd_kernel, hipFuncAttributeMaxDynamicSharedMemorySize, LDS_BYTES) != hipSuccess) { fprintf(stderr, "kernel_launch: hipFuncSetAttribute failed\n"); grid = -1; return; }
        if (hipOccupancyMaxActiveBlocksPerMultiprocessor(&per_cu, (const void*)fwd_kernel, NTHR, LDS_BYTES) != hipSuccess || per_cu < 1) { fprintf(stderr, "kernel_launch: occupancy query says %d blocks per CU\n", per_cu); grid = -1; (void)hipGetLastError(); return; }
        grid = cus * per_cu < 256 ? cus * per_cu : 256;
    }
    if (grid <= 0) return;
    (void)hipMemsetAsync((char*)d_ws + WS_CTL, 0, CTL_ZERO_BYTES, stream);
    Args a{};
    for (int i = 0; i < 23; ++i) a.in[i] = (const float*)d_in[i];
    a.out = (float*)d_out; a.ws = (unsigned char*)d_ws;
    void* kargs[] = {&a};
    hipError_t e = hipLaunchCooperativeKernel((const void*)fwd_kernel, dim3(grid), dim3(NTHR), kargs, LDS_BYTES, stream);
    if (e != hipSuccess) fprintf(stderr, "kernel_launch: cooperative launch failed: %s (grid %d)\n", hipGetErrorString(e), grid);
}
```

```cpp
#include <hip/hip_runtime.h>
#include <cstdio>
#include <cstdint>
template <int CTRL> __device__ __forceinline__ float dpp(float x) { return __builtin_bit_cast(float, __builtin_amdgcn_mov_dpp(__builtin_bit_cast(int, x), CTRL, 0xf, 0xf, true)); }
constexpr int DPP_XOR1 = 0xB1, DPP_XOR2 = 0x4E, DPP_XOR7 = 0x141, DPP_XOR8 = 0x128;
__device__ __forceinline__ float sum8(float v) { v += dpp<DPP_XOR1>(v); v += dpp<DPP_XOR2>(v); v += dpp<DPP_XOR7>(v); return v; }
__device__ __forceinline__ float sum16(float v) { v = sum8(v); v += dpp<DPP_XOR8>(v); return v; }
__device__ __forceinline__ float xsum16(float x) { auto s = __builtin_amdgcn_permlane16_swap(__float_as_uint(x), __float_as_uint(x), false, false); return __uint_as_float(s[0]) + __uint_as_float(s[1]); }
__device__ __forceinline__ float xsum32(float x) { auto s = __builtin_amdgcn_permlane32_swap(__float_as_uint(x), __float_as_uint(x), false, false); return __uint_as_float(s[0]) + __uint_as_float(s[1]); }
__device__ __forceinline__ float xmax32(float x) { auto s = __builtin_amdgcn_permlane32_swap(__float_as_uint(x), __float_as_uint(x), false, false); return fmaxf(__uint_as_float(s[0]), __uint_as_float(s[1])); }
__device__ __forceinline__ float xget32(float x, int hi) { auto s = __builtin_amdgcn_permlane32_swap(__float_as_uint(x), __float_as_uint(x), false, false); return __uint_as_float(hi ? s[0] : s[1]); }
__device__ __forceinline__ float sum32(float v) { return xsum16(sum16(v)); }
namespace pg8 {
#define PG8_LAS __attribute__((address_space(3)))
typedef unsigned short bf16_t;
typedef short bf16x8 __attribute__((ext_vector_type(8)));
typedef float f32x4 __attribute__((ext_vector_type(4)));
typedef unsigned u32x4 __attribute__((ext_vector_type(4)));
constexpr int BM = 256, BK = 64, HALF = 128, HTB = HALF * BK * 2  , STAGE_BYTES = 8 * HTB, NXCD = 8, WGM = 8;

__host__ __device__ __forceinline__ int lds_byte(int r, int c) { const int st = (r >> 4) * 2 + (c >> 5), rr = r & 15, cc = c & 31, ob = rr * 64 + cc * 2; return st * 1024 + (ob ^ (((ob >> 9) & 1) << 5)); }
__host__ __device__ __forceinline__ void stage_rc(int b, int& R, int& C) { const int st = b / 1024, sb = b % 1024, swz = sb ^ (((sb >> 9) & 1) << 5); R = (st >> 1) * 16 + swz / 64; C = (st & 1) * 32 + (swz % 64) / 2; }
__host__ __device__ __forceinline__ int perm32(int rho) { const int n = rho >> 4, i = rho & 15; return 8 * (i >> 2) + 4 * n + (i & 3); }

struct Unit { int pm, pn; };
struct Gemm { const bf16_t* A; const bf16_t* Bt; int M, N, K; };

struct StaticOrder {
    int nM, nN, nwg, G, c;
    __host__ __device__ void init(int M, int N, int G_, int c_) { nM = M / BM; nN = N / BM; nwg = nM * nN; G = G_; c = c_; }
    __host__ __device__ bool next(int i, Unit& u) const {
        const long L = (long)i * G + c; if (L >= nwg) return false;
        int wgid = (int)L; { const int q = nwg / NXCD, r = nwg % NXCD, xcd = wgid % NXCD, off = wgid / NXCD; wgid = (xcd < r ? xcd * (q + 1) : r * (q + 1) + (xcd - r) * q) + off; }
        const int nig = WGM * nN, gid = wgid / nig, fm = gid * WGM, gsz = (nM - fm) < WGM ? (nM - fm) : WGM;
        u.pm = fm + ((wgid % nig) % gsz); u.pn = (wgid % nig) / gsz; return true;
    }
    __device__ __forceinline__ void a_ready(const Unit&) const {}
    __device__ __forceinline__ void done(const Unit&) const {}
};

__device__ __forceinline__ unsigned cvt_pk_bf16(float lo, float hi) { unsigned r; asm volatile("v_cvt_pk_bf16_f32 %0, %1, %2" : "=v"(r) : "v"(lo), "v"(hi)); return r; }
struct EpiProj {
    static constexpr bool PERM = true, AFTER_DRAIN = false;
    bf16_t* O; int ldc; const float* ssq; __amdgpu_buffer_rsrc_t rsrc;
    __device__ __forceinline__ void operator()(const f32x4 (&acc)[2][2][4][2], const Unit& u, int wr, int wc, int fr, int fq) const {
        const int row0 = u.pm * BM + wr * 64 + fr, col0 = u.pn * BM + wc * 32 + 8 * fq;
#pragma unroll
        for (int ai = 0; ai < 2; ++ai)
#pragma unroll
            for (int m = 0; m < 4; ++m) { const int row = row0 + ai * HALF + m * 16;
                const f32x4 s4 = *(const f32x4*)(ssq + (size_t)row * 16 + 4 * fq);
                float s = (s4[0] + s4[1]) + (s4[2] + s4[3]); s = xsum32(xsum16(s));
                const float rs = 1.0f / sqrtf(s * (1.0f / 1024.0f) + 1e-6f);
                const unsigned boff = (unsigned)(((size_t)row * ldc + col0) * 2);
#pragma unroll
                for (int bj = 0; bj < 2; ++bj) { const f32x4 v0 = acc[ai][bj][m][0] * rs, v1 = acc[ai][bj][m][1] * rs;
                    u32x4 w; w.x = cvt_pk_bf16(v0[0], v0[1]); w.y = cvt_pk_bf16(v0[2], v0[3]); w.z = cvt_pk_bf16(v1[0], v1[1]); w.w = cvt_pk_bf16(v1[2], v1[3]);
                    __builtin_amdgcn_raw_buffer_store_b128(w, rsrc, boff + bj * HALF * 2, 0,   16); } }
    }
};
struct EpiRes {
    static constexpr bool PERM = true, AFTER_DRAIN = false;
    const float* xin; float* xout; bf16_t* xb; float* ssq; int mode; __amdgpu_buffer_rsrc_t rsrc;
    __device__ __forceinline__ void operator()(const f32x4 (&acc)[2][2][4][2], const Unit& u, int wr, int wc, int fr, int fq) const {
        const int row0 = u.pm * BM + wr * 64 + fr, col0 = u.pn * BM + wc * 32 + 8 * fq;
#pragma unroll
        for (int ai = 0; ai < 2; ++ai)
#pragma unroll
            for (int m = 0; m < 4; ++m) { const int row = row0 + ai * HALF + m * 16; float ss = 0.f;
#pragma unroll
                for (int bj = 0; bj < 2; ++bj) { const size_t off = (size_t)row * 1024 + col0 + bj * HALF; f32x4 x0, x1;
                    if (mode == 0) { x0 = *(const f32x4*)(xin + off); x1 = *(const f32x4*)(xin + off + 4); }
                    else { const u32x4 w = *(const u32x4*)(xb + off); x0 = (f32x4){__uint_as_float(w.x << 16), __uint_as_float(w.x & 0xffff0000u), __uint_as_float(w.y << 16), __uint_as_float(w.y & 0xffff0000u)};
                        x1 = (f32x4){__uint_as_float(w.z << 16), __uint_as_float(w.z & 0xffff0000u), __uint_as_float(w.w << 16), __uint_as_float(w.w & 0xffff0000u)}; }
                    x0 = x0 + acc[ai][bj][m][0]; x1 = x1 + acc[ai][bj][m][1];
                    if (mode == 2) { *(f32x4*)(xout + off) = x0; *(f32x4*)(xout + off + 4) = x1; }
                    else { u32x4 w; w.x = cvt_pk_bf16(x0[0], x0[1]); w.y = cvt_pk_bf16(x0[2], x0[3]); w.z = cvt_pk_bf16(x1[0], x1[1]); w.w = cvt_pk_bf16(x1[2], x1[3]);
                        __builtin_amdgcn_raw_buffer_store_b128(w, rsrc, (unsigned)(off * 2), 0,   16);
                        const float r0 = __uint_as_float(w.x << 16), r1 = __uint_as_float(w.x & 0xffff0000u), r2 = __uint_as_float(w.y << 16), r3 = __uint_as_float(w.y & 0xffff0000u),
                                    r4 = __uint_as_float(w.z << 16), r5 = __uint_as_float(w.z & 0xffff0000u), r6 = __uint_as_float(w.w << 16), r7 = __uint_as_float(w.w & 0xffff0000u);
                        ss += (r0 * r0 + r1 * r1) + (r2 * r2 + r3 * r3) + (r4 * r4 + r5 * r5) + (r6 * r6 + r7 * r7); } }
                if (mode != 2) { ss = xsum32(xsum16(ss)); if (fq == 0) __hip_atomic_store(ssq + (size_t)row * 16 + u.pn * 4 + wc, ss, __ATOMIC_RELAXED, __HIP_MEMORY_SCOPE_AGENT); } }
    }
};

template <class Epi, class Sched, bool ALIGN_EPI = false, bool SP2 = false>
__device__ __forceinline__ void gemm_phase(PG8_LAS unsigned char* lds, const Gemm g, const Sched& S, const Epi& E) {
    int tid_ = threadIdx.x; asm volatile("" : "+v"(tid_));
    const int tid = tid_, wid = __builtin_amdgcn_readfirstlane(tid >> 6), lane = tid & 63, wr = wid >> 2, wc = wid & 3, fr = lane & 15, fq = lane >> 4;
    const int K = g.K, nt = K / BK;
    unsigned voffA[2], voffB[2];
#pragma unroll
    for (int i = 0; i < 2; ++i) { int R, C; stage_rc(tid * 16 + i * 8192, R, C); const int Rb = Epi::PERM ? ((R & ~31) + perm32(R & 31)) : R;
        voffA[i] = (unsigned)(R * K + C) * 2u; voffB[i] = (unsigned)(Rb * K + C) * 2u; }
    const size_t kstep = (size_t)(BK * 2);
    const size_t hstep = (size_t)HALF * K * 2;
    const size_t tstep = 2 * hstep;
    const unsigned ldsw = (unsigned)wid * 1024u;
    const int aoff = lds_byte(wr * 64 + fr, fq * 8), boff = lds_byte(wc * 32 + fr, fq * 8);
#define PG8_SA(b, h) (((b) * 2 + (h)) * HTB)
#define PG8_SB(b, h) ((4 + (b) * 2 + (h)) * HTB)
#define PG8_STAGE(bufoff, gbase, voff) do { _Pragma("unroll") for (int _i = 0; _i < 2; ++_i) \
        __builtin_amdgcn_global_load_lds((const unsigned*)((const char*)(gbase) + (voff)[_i]), (PG8_LAS unsigned*)(lds + (bufoff) + ldsw + _i * 8192), 16, 0, 0); } while (0)
#define PG8_LDA(dst, b, h) do { _Pragma("unroll") for (int m = 0; m < 4; ++m) _Pragma("unroll") for (int k = 0; k < 2; ++k) dst[m][k] = *(const PG8_LAS bf16x8*)(lds + PG8_SA(b, h) + aoff + m * 2048 + k * 1024); } while (0)
#define PG8_LDB(dst, b, h) do { _Pragma("unroll") for (int n = 0; n < 2; ++n) _Pragma("unroll") for (int k = 0; k < 2; ++k) dst[n][k] = *(const PG8_LAS bf16x8*)(lds + PG8_SB(b, h) + boff + n * 2048 + k * 1024); } while (0)
#define PG8_MMA(ai, bj, At, Bt) do { __builtin_amdgcn_s_setprio(1); _Pragma("unroll") for (int m = 0; m < 4; ++m) _Pragma("unroll") for (int n = 0; n < 2; ++n) _Pragma("unroll") for (int k = 0; k < 2; ++k) \
        acc[ai][bj][m][n] = __builtin_amdgcn_mfma_f32_16x16x32_bf16(Bt[n][k], At[m][k], acc[ai][bj][m][n], 0, 0, 0); __builtin_amdgcn_s_setprio(0); } while (0)
#define PG8_WAIT_V(n) asm volatile("s_waitcnt vmcnt(" #n ")" ::: "memory")
#define PG8_WAIT_L(n) asm volatile("s_waitcnt lgkmcnt(" #n ")" ::: "memory")
#define PG8_BAR __builtin_amdgcn_s_barrier()
#define PG8_SCHED __builtin_amdgcn_sched_barrier(0)
    Unit cur, nxt; int ui = 0;
    if (!S.next(0, cur)) return;
    f32x4 acc[2][2][4][2];
#pragma unroll
    for (int a = 0; a < 2; ++a)
#pragma unroll
        for (int b = 0; b < 2; ++b)
#pragma unroll
            for (int m = 0; m < 4; ++m)
#pragma unroll
                for (int n = 0; n < 2; ++n) acc[a][b][m][n] = (f32x4){0.f, 0.f, 0.f, 0.f};
    bf16x8 At[4][2], B0[2][2], B1[2][2];
    const char* cA = (const char*)g.A + (size_t)cur.pm * tstep; const char* cB = (const char*)g.Bt + (size_t)cur.pn * tstep;
    S.a_ready(cur);
    if constexpr (SP2) {
        PG8_STAGE(PG8_SB(0, 0), cB, voffB); PG8_STAGE(PG8_SB(0, 1), cB + hstep, voffB); PG8_STAGE(PG8_SA(0, 0), cA, voffA); PG8_STAGE(PG8_SA(0, 1), cA + hstep, voffA);
        if (wr == 1) PG8_BAR;
        PG8_WAIT_V(2); PG8_BAR;
        PG8_STAGE(PG8_SB(1, 0), cB + kstep, voffB); PG8_STAGE(PG8_SA(1, 0), cA + kstep, voffA); PG8_STAGE(PG8_SB(1, 1), cB + hstep + kstep, voffB);
        PG8_WAIT_V(6); PG8_BAR;
    } else {
        PG8_STAGE(PG8_SB(0, 0), cB, voffB); PG8_STAGE(PG8_SA(0, 0), cA, voffA); PG8_STAGE(PG8_SB(0, 1), cB + hstep, voffB); PG8_STAGE(PG8_SA(0, 1), cA + hstep, voffA);
        if (wr == 1) PG8_BAR;
        PG8_WAIT_V(4); PG8_BAR;
        PG8_STAGE(PG8_SB(1, 0), cB + kstep, voffB); PG8_STAGE(PG8_SA(1, 0), cA + kstep, voffA); PG8_STAGE(PG8_SB(1, 1), cB + hstep + kstep, voffB);
        PG8_WAIT_V(6); PG8_BAR;
    }
    for (;;) {
        const bool has_next = S.next(ui + 1, nxt);
        const char* nA = has_next ? (const char*)g.A + (size_t)nxt.pm * tstep : cA; const char* nB = has_next ? (const char*)g.Bt + (size_t)nxt.pn * tstep : cB;
        for (int t = 0; t < nt; t += 2) {
            const bool last = (t == nt - 2);
            const char* a1 = cA + (size_t)(t + 1) * kstep;
            const char* a2 = last ? nA : cA + (size_t)(t + 2) * kstep; const char* b2 = last ? nB : cB + (size_t)(t + 2) * kstep;
            const char* a3 = a2 + kstep; const char* b3 = b2 + kstep;
            if (last && has_next) S.a_ready(nxt);
            if constexpr (SP2) {
            PG8_LDB(B0, 0, 0); PG8_LDB(B1, 0, 1); PG8_SCHED; PG8_LDA(At, 0, 0); PG8_STAGE(PG8_SA(1, 1), a1 + hstep, voffA);
            PG8_WAIT_V(8); PG8_WAIT_L(0); PG8_BAR; PG8_MMA(0, 0, At, B0); PG8_MMA(0, 1, At, B1); PG8_BAR; PG8_SCHED;
            PG8_LDA(At, 0, 1); PG8_STAGE(PG8_SB(0, 0), b2, voffB); PG8_STAGE(PG8_SB(0, 1), b2 + hstep, voffB); PG8_STAGE(PG8_SA(0, 0), a2, voffA);
            PG8_WAIT_V(8); PG8_WAIT_L(0); PG8_BAR; PG8_MMA(1, 0, At, B0); PG8_MMA(1, 1, At, B1); PG8_BAR; PG8_SCHED;
            PG8_LDB(B0, 1, 0); PG8_LDB(B1, 1, 1); PG8_SCHED; PG8_LDA(At, 1, 0); PG8_STAGE(PG8_SA(0, 1), a2 + hstep, voffA);
            PG8_WAIT_V(8); PG8_WAIT_L(0); PG8_BAR; PG8_MMA(0, 0, At, B0); PG8_MMA(0, 1, At, B1); PG8_BAR; PG8_SCHED;
            PG8_LDA(At, 1, 1); PG8_STAGE(PG8_SB(1, 0), b3, voffB); PG8_STAGE(PG8_SB(1, 1), b3 + hstep, voffB); PG8_STAGE(PG8_SA(1, 0), a3, voffA);
            PG8_WAIT_V(8); PG8_WAIT_L(0); PG8_BAR; PG8_MMA(1, 0, At, B0); PG8_MMA(1, 1, At, B1); PG8_BAR; PG8_SCHED;
            } else {
            PG8_LDB(B0, 0, 0); PG8_SCHED; PG8_LDA(At, 0, 0); PG8_STAGE(PG8_SA(1, 1), a1 + hstep, voffA);
            PG8_WAIT_L(8); PG8_BAR; PG8_WAIT_L(0); PG8_MMA(0, 0, At, B0); PG8_BAR; PG8_SCHED;
            PG8_LDB(B1, 0, 1); PG8_STAGE(PG8_SB(0, 0), b2, voffB);
            PG8_BAR; PG8_WAIT_L(0); PG8_MMA(0, 1, At, B1); PG8_BAR;
            PG8_LDA(At, 0, 1); PG8_STAGE(PG8_SA(0, 0), a2, voffA);
            PG8_BAR; PG8_WAIT_L(0); PG8_MMA(1, 0, At, B0); PG8_BAR; PG8_SCHED;
            PG8_STAGE(PG8_SB(0, 1), b2 + hstep, voffB);
            PG8_WAIT_V(6); PG8_BAR; PG8_MMA(1, 1, At, B1); PG8_BAR;
            PG8_LDB(B0, 1, 0); PG8_SCHED; PG8_LDA(At, 1, 0); PG8_STAGE(PG8_SA(0, 1), a2 + hstep, voffA);
            PG8_WAIT_L(8); PG8_BAR; PG8_WAIT_L(0); PG8_MMA(0, 0, At, B0); PG8_BAR; PG8_SCHED;
            PG8_LDB(B1, 1, 1); PG8_STAGE(PG8_SB(1, 0), b3, voffB);
            PG8_BAR; PG8_WAIT_L(0); PG8_MMA(0, 1, At, B1); PG8_BAR;
            PG8_LDA(At, 1, 1); PG8_STAGE(PG8_SA(1, 0), a3, voffA);
            PG8_BAR; PG8_WAIT_L(0); PG8_MMA(1, 0, At, B0); PG8_BAR; PG8_SCHED;
            PG8_STAGE(PG8_SB(1, 1), b3 + hstep, voffB);
            PG8_WAIT_V(6); PG8_BAR; PG8_MMA(1, 1, At, B1); PG8_BAR;
            }
        }
        if constexpr (ALIGN_EPI) { if (wr == 0) PG8_BAR; }
        if constexpr (!Epi::AFTER_DRAIN) { E(acc, cur, wr, wc, fr, fq); S.done(cur); }
        if (!has_next) break;
#pragma unroll
        for (int a = 0; a < 2; ++a)
#pragma unroll
            for (int b = 0; b < 2; ++b)
#pragma unroll
                for (int m = 0; m < 4; ++m)
#pragma unroll
                    for (int n = 0; n < 2; ++n) acc[a][b][m][n] = (f32x4){0.f, 0.f, 0.f, 0.f};
        cur = nxt; cA = nA; cB = nB; ++ui;
        if constexpr (ALIGN_EPI) { if (wr == 1) PG8_BAR; }
    }
    PG8_WAIT_V(0);
    if constexpr (!ALIGN_EPI) { if (wr == 0) PG8_BAR; }
    PG8_BAR;
    if constexpr (Epi::AFTER_DRAIN) { E.fused(acc, cur, wr, wc, fr, fq, lds, wid, lane); S.done(cur); }
#undef PG8_SA
#undef PG8_SB
#undef PG8_STAGE
#undef PG8_LDA
#undef PG8_LDB
#undef PG8_MMA
#undef PG8_WAIT_V
#undef PG8_WAIT_L
#undef PG8_BAR
#undef PG8_SCHED
}
}
using pg8::bf16_t; using pg8::bf16x8; using pg8::f32x4; using pg8::u32x4; using pg8::cvt_pk_bf16;
#define GAS __attribute__((address_space(1)))
#define LAS __attribute__((address_space(3)))
typedef float f32x16 __attribute__((ext_vector_type(16)));
typedef float f32x2 __attribute__((ext_vector_type(2)));
typedef unsigned u32x2 __attribute__((ext_vector_type(2)));
typedef GAS unsigned gu32;
#define RLX_AGENT __ATOMIC_RELAXED, __HIP_MEMORY_SCOPE_AGENT
#define LDS_WAIT() asm volatile("s_waitcnt lgkmcnt(0)" ::: "memory")
#define MFMA32(a, b, c) __builtin_amdgcn_mfma_f32_32x32x16_bf16((a), (b), (c), 0, 0, 0)

constexpr int NWAVES = 8, NTHR = 512;
constexpr int BATCH = 4, SEQ = 4096, DM = 1024, DEPTH = 4, M = BATCH * SEQ, NIN = 2832, NP = 3072;
constexpr float EPS = 1e-6f;
constexpr int PC_AVAL = 0, PC_AGLU = 256, PC_AGATE = 512, PC_BQ = 768, PC_BK = 1024, PC_BV = 1152, PC_BGATE = 1280, PC_CX = 1536, PC_CGATE = 1792,
              PC_DQ = 2048, PC_DK = 2176, PC_DV = 2304, PC_DGATE = 2560, PC_DLR = 2816;
__host__ __device__ __forceinline__ int win_remap(int n) { return n < 2560 ? n : (n < 2816 ? n + 16 : (n < 2832 ? n - 256 : -1)); }
constexpr size_t MiB = 1u << 20;
constexpr size_t WS_CTL = 0, CTL_ZERO_BYTES = 1 * MiB;
constexpr size_t WS_WIN = 2 * MiB;
constexpr size_t WS_WOUT = 26 * MiB;
constexpr size_t WS_APW = 34 * MiB;
constexpr size_t WS_WR = WS_APW + 512 * 1024, WS_WI = WS_WR + 128 * 1024;
constexpr size_t WS_SSQ = 35 * MiB;
constexpr size_t WS_XB = 36 * MiB;
constexpr size_t WS_Y = 68 * MiB;
constexpr size_t WS_PROJ = 100 * MiB;
constexpr size_t WS_GC = 200 * MiB;
constexpr size_t WS_GD = 201 * MiB;
constexpr size_t WS_BIAS = 204 * MiB;
constexpr size_t WS_END = 205 * MiB;
constexpr int CW_BAR = 4096;
constexpr int CW_TEAM = 65536;
constexpr int CW_PCNT = 131072;
constexpr int CW_GDONE = CW_PCNT + 64 * 256;
constexpr int CW_Q = 16384;
constexpr int RING_BYTES = 131072, LDSCTL_OFF = RING_BYTES, MISC_OFF = LDSCTL_OFF + 320, LDS_BYTES = 147456;

__device__ __forceinline__ float bf_lo(unsigned w) { return __uint_as_float(w << 16); }
__device__ __forceinline__ float bf_hi(unsigned w) { return __uint_as_float(w & 0xffff0000u); }
__device__ __forceinline__ unsigned f2bf(float f) { unsigned u = __float_as_uint(f); return (u + 0x7fffu + ((u >> 16) & 1u)) >> 16; }
typedef __bf16 bf16v2 __attribute__((ext_vector_type(2)));
__device__ __forceinline__ unsigned pk2(float lo, float hi) { const f32x2 f = {lo, hi}; const bf16v2 b = __builtin_convertvector(f, bf16v2); return __builtin_bit_cast(unsigned, b); }
__device__ __forceinline__ float fexp(float x) { return __builtin_amdgcn_exp2f(x * 1.4426950408889634f); }
__device__ __forceinline__ float frcp(float x) { return __builtin_amdgcn_rcpf(x); }
__device__ __forceinline__ float sigm(float x) { return frcp(1.f + fexp(-x)); }
__device__ __forceinline__ float silu(float x) { return x * sigm(x); }
__device__ __forceinline__ float rsq(float x) { return __builtin_amdgcn_rsqf(x); }
__device__ __forceinline__ float log1p_01(float e) { return __builtin_amdgcn_logf(1.0f + e) * 0.6931471805599453f; }
__device__ __forceinline__ float one_minus_exp(float x) { const float p = -x * (1.0f + x * (0.5f + x * (1.0f / 6.0f + x * (1.0f / 24.0f + x * (1.0f / 120.0f + x * (1.0f / 720.0f)))))); return x > -0.25f ? p : 1.0f - fexp(x); }
__device__ __forceinline__ void unpack8(const u32x4 w, float (&f)[8]) { f[0] = bf_lo(w.x); f[1] = bf_hi(w.x); f[2] = bf_lo(w.y); f[3] = bf_hi(w.y); f[4] = bf_lo(w.z); f[5] = bf_hi(w.z); f[6] = bf_lo(w.w); f[7] = bf_hi(w.w); }
__device__ __forceinline__ u32x4 pack8(const float (&f)[8]) { u32x4 w; w.x = pk2(f[0], f[1]); w.y = pk2(f[2], f[3]); w.z = pk2(f[4], f[5]); w.w = pk2(f[6], f[7]); return w; }
__device__ __forceinline__ bf16x8 as_frag(const u32x4 w) { return __builtin_bit_cast(bf16x8, w); }
__device__ __forceinline__ bf16x8 frag_from_acc(const f32x16& a, int s8) { u32x4 w; w.x = pk2(a[s8 + 0], a[s8 + 1]); w.y = pk2(a[s8 + 2], a[s8 + 3]); w.z = pk2(a[s8 + 4], a[s8 + 5]); w.w = pk2(a[s8 + 6], a[s8 + 7]); return as_frag(w); }
__device__ __forceinline__ float wave_sum(float v) { return xsum32(sum32(v)); }
#define XB_TMO      128
#define XB_XCNT(j)  (256  + 64 * (j))
#define XB_XSUB(j)  (1280 + 64 * (j))
#define XB_XGEN(j)  (2304 + 64 * (j))
#define XB_TOP      3328
#define XB_TOPGEN   3392
#define XCD_BAR_WORDS 3456
#define XB_SPIN_CAP (1u << 18)

__device__ __forceinline__ unsigned xb_ld(unsigned* p)              { return __hip_atomic_load(p, __ATOMIC_RELAXED, __HIP_MEMORY_SCOPE_AGENT); }
__device__ __forceinline__ unsigned xb_add(unsigned* p, unsigned v) { return __hip_atomic_fetch_add(p, v, __ATOMIC_RELAXED, __HIP_MEMORY_SCOPE_AGENT); }
__device__ __forceinline__ unsigned xb_xcc_id() { return (unsigned)__builtin_amdgcn_s_getreg((3 << 11) | 20) & 0xFu; }
#define XB_SPIN(cond, bar) do { unsigned _sp = 0; while (cond) { __builtin_amdgcn_s_sleep(1); \
    if ((++_sp & 255u) == 0u) { if (xb_ld(&(bar)[XB_TMO])) break; if (_sp > XB_SPIN_CAP) { atomicAdd(&(bar)[XB_TMO], 1u); break; } } } } while (0)

struct XcdBarrier {
    unsigned* bar; unsigned x;
    volatile LAS unsigned* st;
};

__device__ __forceinline__ XcdBarrier xcd_barrier_post(unsigned* bar, volatile LAS unsigned* st) {
    XcdBarrier b; b.bar = bar; b.x = xb_xcc_id(); b.st = st;
    if (threadIdx.x == 0) (void)xb_add(&bar[XB_XCNT(b.x)], 1u);
    return b;
}
__device__ __forceinline__ void xcd_barrier_complete(unsigned* bar, unsigned x, unsigned& nloc, unsigned& nx) {
    const unsigned G = gridDim.x * gridDim.y * gridDim.z;
    unsigned sum, cnt, mine, sp = 0u;
    for (;;) {
        sum = 0u; cnt = 0u; mine = 0u;
#pragma unroll
        for (unsigned j = 0; j < 16; ++j) { const unsigned c = xb_ld(&bar[XB_XCNT(j)]); sum += c; cnt += (c > 0u) ? 1u : 0u; mine = (j == x) ? c : mine; }
        if (sum == G) break;
        __builtin_amdgcn_s_sleep(1);
        if ((++sp & 255u) == 0u) { if (xb_ld(&bar[XB_TMO])) break; if (sp > XB_SPIN_CAP) { atomicAdd(&bar[XB_TMO], 1u); break; } }
    }
    nloc = mine > 0u ? mine : 1u; nx = cnt > 0u ? cnt : 1u;
}

__device__ __forceinline__ void xcd_barrier(const XcdBarrier& b) {
    asm volatile("s_waitcnt vmcnt(0)" ::: "memory");
    __syncthreads();
    if (threadIdx.x == 0) {
        unsigned* bar = b.bar;
        __builtin_amdgcn_s_waitcnt(0);
        unsigned nloc = b.st[0], nx = b.st[1];
        if (nloc == 0u) { xcd_barrier_complete(bar, b.x, nloc, nx); b.st[0] = nloc; b.st[1] = nx; }
        const unsigned old = xb_add(&bar[XB_XSUB(b.x)], 1u);
        const unsigned gen = old / nloc;
        if (old + 1u == (gen + 1u) * nloc) {
            __builtin_amdgcn_fence(__ATOMIC_RELEASE, "agent");
            asm volatile("s_waitcnt vmcnt(0)" ::: "memory");
            const unsigned og = xb_add(&bar[XB_TOP], 1u);
            const unsigned tg = og / nx;
            if (og + 1u == (tg + 1u) * nx) xb_add(&bar[XB_TOPGEN], 1u);
            else XB_SPIN(xb_ld(&bar[XB_TOPGEN]) == tg, bar);
            __builtin_amdgcn_fence(__ATOMIC_ACQUIRE, "agent");
            xb_add(&bar[XB_XGEN(b.x)], 1u);
            asm volatile("s_waitcnt vmcnt(0)" ::: "memory");
        } else {
            XB_SPIN(xb_ld(&bar[XB_XGEN(b.x)]) == gen, bar);
            __builtin_amdgcn_fence(__ATOMIC_ACQUIRE, "agent");
            asm volatile("s_waitcnt vmcnt(0)" ::: "memory");
        }
    }
    __syncthreads();
}
template <int S8> __device__ __forceinline__ bf16x8 frag_acc(const f32x16& a) { u32x4 w; w.x = pk2(a[S8 + 0], a[S8 + 1]); w.y = pk2(a[S8 + 2], a[S8 + 3]); w.z = pk2(a[S8 + 4], a[S8 + 5]); w.w = pk2(a[S8 + 6], a[S8 + 7]); return as_frag(w); }

struct Args { const float* in[23]; float* out; unsigned char* ws; };
typedef __attribute__((address_space(4))) const Args CArgs;
__device__ __forceinline__ CArgs* get_args() { CArgs* p = (CArgs*)__builtin_amdgcn_kernarg_segment_ptr(); asm volatile("" : "+s"(p)); return p; }
enum { I_X = 0, I_NORM_G, I_W_IN, I_A_CONV_W, I_A_CONV_B, I_A_LN_G, I_A_LN_B, I_A_PW, I_B_Q_G, I_B_K_G, I_B_SINKS, I_REL_BIAS, I_C_CONV_W, I_C_CONV_B, I_C_W_R, I_C_B_R, I_C_W_I, I_C_B_I, I_C_LAMBDA, I_D_W_UP, I_D_B_UP, I_D_NORM_G, I_W_OUT };
struct Frame { LAS unsigned char* lds; volatile LAS unsigned* MISC; int tid, lane, wave, G; };
#define WSP(T, off) ((T*)(A->ws + (off)))

template <bool REMAP>
__device__ __forceinline__ void transpose_item(const float* W, int ldw, const float* gk, bf16_t* WT, int ldt, int k0, int n0, LAS float* scr, int lane) {
    const int nn = n0 + (lane & 31); const int col = REMAP ? win_remap(nn) : nn, colc = col < 0 ? 0 : col;
    const float* wp = W + (size_t)(k0 + (lane >> 5)) * ldw + colc;
    float v[32];
#pragma unroll
    for (int i = 0; i < 32; ++i) v[i] = wp[(size_t)(2 * i) * ldw];
    const int c = lane & 7;
    f32x4 g0 = (f32x4){1.f, 1.f, 1.f, 1.f}, g1 = g0; if (gk) { g0 = *(const f32x4*)(gk + k0 + 8 * c); g1 = *(const f32x4*)(gk + k0 + 8 * c + 4); }
#pragma unroll
    for (int i = 0; i < 32; ++i) scr[(2 * i + (lane >> 5)) * 33 + (lane & 31)] = col < 0 ? 0.f : v[i];
    LDS_WAIT(); asm volatile("" ::: "memory");
#pragma unroll
    for (int j = 0; j < 4; ++j) { const int n = (lane >> 3) + 8 * j; const LAS float* s = scr + (8 * c) * 33 + n;
        u32x4 o; o.x = pk2(s[0 * 33] * g0.x, s[1 * 33] * g0.y); o.y = pk2(s[2 * 33] * g0.z, s[3 * 33] * g0.w); o.z = pk2(s[4 * 33] * g1.x, s[5 * 33] * g1.y); o.w = pk2(s[6 * 33] * g1.z, s[7 * 33] * g1.w);
        *(u32x4*)(WT + (size_t)(n0 + n) * ldt + k0 + 8 * c) = o; }
    LDS_WAIT(); asm volatile("" ::: "memory");
}
constexpr int I_IN = 16 * 96, I_OUT = 16 * 32, I_PW = 4 * 8, I_G = 4 * 2, I_L = I_IN + I_OUT + I_PW + 2 * I_G;
__device__ __forceinline__ void convert_item(Frame& F, int l, int r) {
    CArgs* A = get_args(); const float* norm_g = A->in[I_NORM_G]; const float* w_in = A->in[I_W_IN]; const float* a_pw = A->in[I_A_PW]; const float* c_w_r = A->in[I_C_W_R]; const float* c_w_i = A->in[I_C_W_I]; const float* w_out = A->in[I_W_OUT];
    bf16_t* WtIn = WSP(bf16_t, WS_WIN); bf16_t* WtOut = WSP(bf16_t, WS_WOUT); bf16_t* ApwT = WSP(bf16_t, WS_APW); bf16_t* WrT = WSP(bf16_t, WS_WR); bf16_t* WiT = WSP(bf16_t, WS_WI);
    LAS float* scr = (LAS float*)(F.lds + F.wave * 16384);
    if (r < I_IN) { const int kb = r / 96, nb = r % 96; transpose_item<true>(w_in + (size_t)l * DM * NIN, NIN, norm_g + l * DM, WtIn + (size_t)l * NP * DM, DM, 64 * kb, 32 * nb, scr, F.lane); return; } r -= I_IN;
    if (r < I_OUT) { const int kb = r / 32, nb = r % 32; transpose_item<false>(w_out + (size_t)l * DM * DM, DM, nullptr, WtOut + (size_t)l * DM * DM, DM, 64 * kb, 32 * nb, scr, F.lane); return; } r -= I_OUT;
    if (r < I_PW) { const int kb = r / 8, nb = r % 8; transpose_item<false>(a_pw + (size_t)l * 65536, 256, nullptr, ApwT + (size_t)l * 65536, 256, 64 * kb, 32 * nb, scr, F.lane); return; } r -= I_PW;
    if (r < I_G) { const int blk = r / 2, nb = r % 2; transpose_item<false>(c_w_r + (size_t)(l * 4 + blk) * 4096, 64, nullptr, WrT + (size_t)(l * 4 + blk) * 4096, 64, 0, 32 * nb, scr, F.lane); return; } r -= I_G;
    { const int blk = r / 2, nb = r % 2; transpose_item<false>(c_w_i + (size_t)(l * 4 + blk) * 4096, 64, nullptr, WiT + (size_t)(l * 4 + blk) * 4096, 64, 0, 32 * nb, scr, F.lane); }
}
__device__ __forceinline__ void p0_prologue(Frame& F) {
    CArgs* A = get_args(); const float* x = A->in[I_X]; bf16_t* XB = WSP(bf16_t, WS_XB); float* SSQ = WSP(float, WS_SSQ);
    const int gw = blockIdx.x * NWAVES + F.wave, NGW = F.G * NWAVES;
    for (int it = gw; it < I_L; it += NGW) convert_item(F, 0, it);
    { const float* rel_bias = A->in[I_REL_BIAS]; float* BT = WSP(float, WS_BIAS);
      for (int i = gw * 64 + F.lane; i < 4 * 5 * 16 * 64; i += NGW * 64) { const int e = i & 3, ln = (i >> 2) & 63, q4 = (i >> 8) & 3, kt = (i >> 10) % 5, hd = (i >> 10) / 5;
          const int dist = (ln & 31) - (e + 8 * q4) - 4 * (ln >> 5) + 128 - 32 * kt; float v = -INFINITY;
          if (dist >= 0 && dist < 128) { int bucket = dist; if (dist >= 16) { bucket = 16 + (int)(logf((float)dist / 16.0f) / 2.0794415416798357f * 16.0f); bucket = bucket < 31 ? bucket : 31; } v = rel_bias[bucket * 4 + hd]; }
          BT[i] = v; } }
    for (int m = gw; m < M; m += 2 * NGW) {
        const f32x4* xr0 = (const f32x4*)(x + (size_t)m * DM) + F.lane; const int m1 = (m + NGW < M) ? m + NGW : m; const f32x4* xr1 = (const f32x4*)(x + (size_t)m1 * DM) + F.lane; f32x4 v0[4], v1[4]; float s0 = 0.f, s1 = 0.f;
#pragma unroll
        for (int j = 0; j < 4; ++j) { v0[j] = xr0[64 * j]; v1[j] = xr1[64 * j]; }
#pragma unroll
        for (int j = 0; j < 4; ++j) { s0 += (v0[j].x * v0[j].x + v0[j].y * v0[j].y) + (v0[j].z * v0[j].z + v0[j].w * v0[j].w); s1 += (v1[j].x * v1[j].x + v1[j].y * v1[j].y) + (v1[j].z * v1[j].z + v1[j].w * v1[j].w); }
        s0 = wave_sum(s0); s1 = wave_sum(s1);
        u32x2* o0 = (u32x2*)(XB + (size_t)m * DM) + F.lane; u32x2* o1 = (u32x2*)(XB + (size_t)m1 * DM) + F.lane;
#pragma unroll
        for (int j = 0; j < 4; ++j) { u32x2 w; w.x = pk2(v0[j].x, v0[j].y); w.y = pk2(v0[j].z, v0[j].w); o0[64 * j] = w; w.x = pk2(v1[j].x, v1[j].y); w.y = pk2(v1[j].z, v1[j].w); o1[64 * j] = w; }
        if (F.lane < 16) { SSQ[(size_t)m * 16 + F.lane] = (F.lane == 0) ? s0 : 0.f; SSQ[(size_t)m1 * 16 + F.lane] = (F.lane == 0) ? s1 : 0.f; }
    }
}

constexpr int A_TA = 64, A_ROWS = A_TA + 30, A_S_OFF = A_ROWS * 512, A_S_STRIDE = 528;
__device__ __forceinline__ void mixer_a(Frame& F, int l, int unit) {
    CArgs* A = get_args(); const float* a_conv_w = A->in[I_A_CONV_W]; const float* a_conv_b = A->in[I_A_CONV_B]; const float* a_ln_g = A->in[I_A_LN_G]; const float* a_ln_b = A->in[I_A_LN_B]; bf16_t* ApwT = WSP(bf16_t, WS_APW); bf16_t* Y = WSP(bf16_t, WS_Y); bf16_t* PROJ = WSP(bf16_t, WS_PROJ);
    LAS unsigned char* lds = F.lds; const int tid = F.tid, lane = F.lane, w = F.wave;
    const int b = unit >> 6, t0 = (unit & 63) * A_TA; const size_t m0 = (size_t)b * SEQ + t0;
    const int pA = tid & 127, tgA = tid >> 7, c0A = 2 * pA;
    float w0[31], w1[31];
#pragma unroll
    for (int j = 0; j < 31; ++j) { const f32x2 ww = *(const f32x2*)(a_conv_w + ((size_t)l * 31 + j) * 256 + c0A); w0[j] = ww.x; w1[j] = ww.y; }
    const f32x2 cb = *(const f32x2*)(a_conv_b + l * 256 + c0A), lg = *(const f32x2*)(a_ln_g + l * 256 + c0A), lb = *(const f32x2*)(a_ln_b + l * 256 + c0A);
    { u32x4 vw[6], gw[6];
#pragma unroll
      for (int k = 0; k < 6; ++k) { const int it = tid + k * NTHR, itc = it < A_ROWS * 32 ? it : A_ROWS * 32 - 1, r = itc >> 5, p = itc & 31, tok = t0 + r - 30, tokc = tok < 0 ? 0 : tok;
          const bf16_t* rp = PROJ + ((size_t)b * SEQ + tokc) * NP + 8 * p; vw[k] = *(const u32x4*)(rp + PC_AVAL); gw[k] = *(const u32x4*)(rp + PC_AGLU); }
#pragma unroll
      for (int k = 0; k < 6; ++k) { const int it = tid + k * NTHR, r = it >> 5, p = it & 31, tok = t0 + r - 30;
          float v[8], g[8]; unpack8(vw[k], v); unpack8(gw[k], g);
#pragma unroll
          for (int j = 0; j < 8; ++j) v[j] = tok < 0 ? 0.f : v[j] * sigm(g[j]);
          if (it < A_ROWS * 32) *(LAS u32x4*)(lds + r * 512 + p * 16) = pack8(v); } }
    __syncthreads();
    bf16x8 af[16];
    { const bf16_t* ap = ApwT + (size_t)l * 65536 + (size_t)(32 * w + (lane & 31)) * 256 + 8 * (lane >> 5);
#pragma unroll
      for (int ks = 0; ks < 16; ++ks) af[ks] = *(const bf16x8*)(ap + 16 * ks); }
    { const int p = pA, tg = tgA;
#pragma unroll 1
      for (int blk = 0; blk < 2; ++blk) { const int base = 16 * tg + 8 * blk;
        f32x2 in[38];
#pragma unroll
        for (int i = 0; i < 38; ++i) { const unsigned wv = *(const LAS unsigned*)(lds + (base + i) * 512 + p * 4); in[i] = (f32x2){bf_lo(wv), bf_hi(wv)}; }
        f32x2 acc[8];
#pragma unroll
        for (int o = 0; o < 8; ++o) acc[o] = cb;
#pragma unroll
        for (int j = 0; j < 31; ++j) { const f32x2 wj = {w0[j], w1[j]};
#pragma unroll
            for (int o = 0; o < 8; ++o) acc[o] = __builtin_elementwise_fma(wj, in[o + j], acc[o]); }
        float sv[8], qv[8];
#pragma unroll
        for (int o = 0; o < 8; ++o) { sv[o] = acc[o].x + acc[o].y; qv[o] = acc[o].x * acc[o].x + acc[o].y * acc[o].y; }
#pragma unroll
        for (int o = 0; o < 8; ++o) { sv[o] = sum32(sv[o]); qv[o] = sum32(qv[o]); }
#pragma unroll
        for (int o = 0; o < 8; ++o) { const float mean = sv[o] * (1.f / 64.f), var = fmaxf(qv[o] * (1.f / 64.f) - mean * mean, 0.f), rstd = rsq(var + EPS);
            const float v0 = (acc[o].x - mean) * rstd * lg.x + lb.x, v1 = (acc[o].y - mean) * rstd * lg.y + lb.y;
            *(LAS unsigned*)(lds + A_S_OFF + (base + o) * A_S_STRIDE + p * 4) = pk2(silu(v0), silu(v1)); } } }
    __syncthreads();
    { const int r = lane & 31, h = lane >> 5;
      u32x2 gwA[2][4];
#pragma unroll
      for (int tt = 0; tt < 2; ++tt)
#pragma unroll
          for (int g4 = 0; g4 < 4; ++g4) gwA[tt][g4] = *(const u32x2*)(PROJ + (m0 + 32 * tt + r) * NP + PC_AGATE + 32 * w + 8 * g4 + 4 * h);
      f32x16 acc[2];
#pragma unroll
      for (int tt = 0; tt < 2; ++tt) { acc[tt] = (f32x16)(0.f);
#pragma unroll
          for (int ks = 0; ks < 16; ++ks) { const bf16x8 bfr = *(const LAS bf16x8*)(lds + A_S_OFF + (32 * tt + r) * A_S_STRIDE + (16 * ks + 8 * h) * 2); acc[tt] = MFMA32(af[ks], bfr, acc[tt]); } }
#pragma unroll
      for (int tt = 0; tt < 2; ++tt) { const size_t tok = m0 + 32 * tt + r;
#pragma unroll
          for (int g4 = 0; g4 < 4; ++g4) { const int n = 32 * w + 8 * g4 + 4 * h; const u32x2 gw = gwA[tt][g4];
              u32x2 o; o.x = pk2(acc[tt][4 * g4 + 0] * silu(bf_lo(gw.x)), acc[tt][4 * g4 + 1] * silu(bf_hi(gw.x))); o.y = pk2(acc[tt][4 * g4 + 2] * silu(bf_lo(gw.y)), acc[tt][4 * g4 + 3] * silu(bf_hi(gw.y)));
              *(u32x2*)(Y + tok * DM + n) = o; } } }
    __syncthreads();
}

constexpr int B_VT_OFF = 256 * 144, B_VT_STRIDE = 536;
__device__ __forceinline__ void mixer_b(Frame& F, int l, int unit) {
    CArgs* A = get_args(); const float* b_q_g = A->in[I_B_Q_G]; const float* b_k_g = A->in[I_B_K_G]; const float* b_sinks = A->in[I_B_SINKS]; bf16_t* Y = WSP(bf16_t, WS_Y); bf16_t* PROJ = WSP(bf16_t, WS_PROJ);
    LAS unsigned char* lds = F.lds; const int tid = F.tid, lane = F.lane, w = F.wave;
    const int b = unit >> 6, qb = (unit >> 1) & 31, kvh = unit & 1, t0 = qb * 128;
    { float kg[8]; const int pc = tid & 7;
#pragma unroll
      for (int j = 0; j < 8; ++j) kg[j] = b_k_g[l * 64 + 8 * pc + j];
#pragma unroll
      for (int it = 0; it < 4; ++it) { const int i = it * NTHR + tid, key = i >> 3, tok = t0 - 128 + key; u32x4 kw = (u32x4){0u, 0u, 0u, 0u}, vw = kw;
        { const int tokc = tok < 0 ? 0 : tok; const bf16_t* rp = PROJ + ((size_t)b * SEQ + tokc) * NP + kvh * 64 + 8 * pc; kw = *(const u32x4*)(rp + PC_BK); vw = *(const u32x4*)(rp + PC_BV);
          if (tok < 0) { kw = (u32x4){0u, 0u, 0u, 0u}; vw = kw; } }
        float kf[8]; unpack8(kw, kf); float ss = 0.f;
#pragma unroll
        for (int j = 0; j < 8; ++j) ss = fmaf(kf[j], kf[j], ss);
        ss = sum8(ss);
        const float rs = rsq(ss * (1.f / 64.f) + EPS);
#pragma unroll
        for (int j = 0; j < 8; ++j) kf[j] = kf[j] * rs * kg[j];
        *(LAS u32x4*)(lds + key * 144 + pc * 16) = pack8(kf);
        const unsigned vv[4] = {vw.x, vw.y, vw.z, vw.w};
#pragma unroll
        for (int j = 0; j < 8; ++j) *(LAS bf16_t*)(lds + B_VT_OFF + (8 * pc + j) * B_VT_STRIDE + key * 2) = (bf16_t)((vv[j >> 1] >> (16 * (j & 1))) & 0xffffu); } }
    const int g = w >> 2, s = w & 3, head = 2 * kvh + g, r = lane & 31, h = lane >> 5;
    const size_t tokq = (size_t)b * SEQ + t0 + 32 * s + r;
    bf16x8 qf[4];
    { float q[32]; const bf16_t* qrow = PROJ + tokq * NP + PC_BQ + head * 64 + 8 * h; float ss = 0.f;
#pragma unroll
      for (int ks = 0; ks < 4; ++ks) { const u32x4 wv = *(const u32x4*)(qrow + 16 * ks); float t8[8]; unpack8(wv, t8);
#pragma unroll
          for (int j = 0; j < 8; ++j) { q[8 * ks + j] = t8[j]; ss = fmaf(t8[j], t8[j], ss); } }
      ss = xsum32(ss);
      const float rs = rsq(ss * (1.f / 64.f) + EPS) * 0.125f;
#pragma unroll
      for (int ks = 0; ks < 4; ++ks) { float t8[8];
#pragma unroll
          for (int j = 0; j < 8; ++j) t8[j] = q[8 * ks + j] * rs * b_q_g[l * 64 + 16 * ks + 8 * h + j];
          qf[ks] = as_frag(pack8(t8)); } }
    u32x2 gwB[2][4];
#pragma unroll
    for (int et = 0; et < 2; ++et)
#pragma unroll
        for (int g4 = 0; g4 < 4; ++g4) gwB[et][g4] = *(const u32x2*)(PROJ + tokq * NP + PC_BGATE + head * 64 + 32 * et + 8 * g4 + 4 * h);
    f32x16 S[5];
    { const f32x4* bt = (const f32x4*)(WSP(float, WS_BIAS)) + (size_t)head * 5 * 4 * 64 + lane;
#pragma unroll
      for (int kt = 0; kt < 5; ++kt)
#pragma unroll
          for (int q4 = 0; q4 < 4; ++q4) { const f32x4 v = bt[(kt * 4 + q4) * 64]; S[kt][4 * q4 + 0] = v.x; S[kt][4 * q4 + 1] = v.y; S[kt][4 * q4 + 2] = v.z; S[kt][4 * q4 + 3] = v.w; } }
    __syncthreads();
#pragma unroll
    for (int kt = 0; kt < 5; ++kt) { const int kb = 32 * (s + kt);
#pragma unroll
        for (int ks = 0; ks < 4; ++ks) { const bf16x8 a = *(const LAS bf16x8*)(lds + (kb + r) * 144 + (16 * ks + 8 * h) * 2); S[kt] = MFMA32(a, qf[ks], S[kt]); } }
    const float sink = b_sinks[l * 4 + head]; float mx = sink;
#pragma unroll
    for (int kt = 0; kt < 5; ++kt) { const bool dead = (t0 == 0) && (s + kt < 4);
#pragma unroll
        for (int rg = 0; rg < 16; ++rg) { const float v = dead ? -INFINITY : S[kt][rg]; S[kt][rg] = v; mx = fmaxf(mx, v); } }
    mx = xmax32(mx);
    float sum = 0.f;
#pragma unroll
    for (int kt = 0; kt < 5; ++kt)
#pragma unroll
        for (int rg = 0; rg < 16; ++rg) { const float p = fexp(S[kt][rg] - mx); S[kt][rg] = p; sum += p; }
    sum = xsum32(sum);
    const float inv = 1.0f / (sum + fexp(sink - mx));
    f32x16 O[2]; O[0] = (f32x16)(0.f); O[1] = (f32x16)(0.f);
#define B_PV(kt, SP) do { const bf16x8 pf = frag_acc<8 * SP>(S[kt]); const int kb = 32 * (s + kt) + 16 * SP + 4 * h; \
        _Pragma("unroll") for (int et = 0; et < 2; ++et) { const LAS unsigned char* vp = lds + B_VT_OFF + (32 * et + r) * B_VT_STRIDE + kb * 2; \
            const u32x2 lo = *(const LAS u32x2*)vp, hi = *(const LAS u32x2*)(vp + 16); O[et] = MFMA32(as_frag((u32x4){lo.x, lo.y, hi.x, hi.y}), pf, O[et]); } } while (0)
#pragma unroll
    for (int kt = 0; kt < 5; ++kt) { B_PV(kt, 0); B_PV(kt, 1); }
#undef B_PV
#pragma unroll
    for (int et = 0; et < 2; ++et)
#pragma unroll
        for (int g4 = 0; g4 < 4; ++g4) { const int d = 32 * et + 8 * g4 + 4 * h; const u32x2 gw = gwB[et][g4];
            u32x2 o; o.x = pk2(O[et][4 * g4 + 0] * inv * silu(bf_lo(gw.x)), O[et][4 * g4 + 1] * inv * silu(bf_hi(gw.x))); o.y = pk2(O[et][4 * g4 + 2] * inv * silu(bf_lo(gw.y)), O[et][4 * g4 + 3] * inv * silu(bf_hi(gw.y)));
            *(u32x2*)(Y + tokq * DM + 256 + head * 64 + d) = o; }
    __syncthreads();
}
constexpr int C_AA = 128 * 144, C_UU = C_AA + 64 * 129 * 4, C_SEG = C_UU + 64 * 129 * 4, C_CARRY = C_SEG + 8192, C_CST = C_CARRY + 512, C_LOOK = C_CST + 1024;
constexpr unsigned SPIN_CAP = 1u << 16;
__device__ __forceinline__ void gr_store(unsigned long long* g, unsigned tag, float v) { __hip_atomic_store(g, ((unsigned long long)tag << 32) | (unsigned long long)__float_as_uint(v), __ATOMIC_RELAXED, __HIP_MEMORY_SCOPE_AGENT); }
__device__ __forceinline__ unsigned long long gr_load(const unsigned long long* g) { return __hip_atomic_load(g, __ATOMIC_RELAXED, __HIP_MEMORY_SCOPE_AGENT); }
__device__ __forceinline__ void mixer_c(Frame& F, int l, int unit, unsigned* qh, unsigned& nxt) {
    CArgs* A = get_args(); const float* c_conv_w = A->in[I_C_CONV_W]; const float* c_conv_b = A->in[I_C_CONV_B]; const float* c_b_r = A->in[I_C_B_R]; const float* c_b_i = A->in[I_C_B_I]; const float* c_lambda = A->in[I_C_LAMBDA]; bf16_t* WrT = WSP(bf16_t, WS_WR); bf16_t* WiT = WSP(bf16_t, WS_WI); bf16_t* Y = WSP(bf16_t, WS_Y); bf16_t* PROJ = WSP(bf16_t, WS_PROJ);
    unsigned long long* GC = WSP(unsigned long long, WS_GC);
    LAS unsigned char* lds = F.lds; const int tid = F.tid, lane = F.lane, w = F.wave;
    const int pair = unit >> 4, b = (unit >> 2) & 3, n = unit & 3; const unsigned tag = (unsigned)l + 1u;
    LAS float* Aa = (LAS float*)(lds + C_AA); LAS float* Uu = (LAS float*)(lds + C_UU); LAS float* SegX = (LAS float*)(lds + C_SEG); LAS float* Carry = (LAS float*)(lds + C_CARRY); LAS float* Cst = (LAS float*)(lds + C_CST); LAS float* LookY = (LAS float*)(lds + C_LOOK);
    const int pc = tid & 7, trow = tid >> 3;
    const int tt = w & 3, mt = w >> 2, r = lane & 31, h = lane >> 5;
    const int sc = tid & 63, seg = tid >> 6;
    u32x4 xin[2][2][4];
#pragma unroll
    for (int hf = 0; hf < 2; ++hf)
#pragma unroll
        for (int it = 0; it < 2; ++it) { const int tok = 128 * (2 * pair + hf) + trow + 64 * it; const bf16_t* rp = PROJ + (size_t)b * SEQ * NP + 64 * n + 8 * pc;
#pragma unroll
            for (int jj = 0; jj < 4; ++jj) { const int tk = tok - 3 + jj, tkc = tk < 0 ? 0 : tk; xin[hf][it][jj] = *(const u32x4*)(rp + (size_t)tkc * NP + PC_CX); } }
    if (tid < 64) { const int cg = l * 256 + 64 * n + tid;
        Cst[4 * tid + 0] = c_b_r[cg]; Cst[4 * tid + 1] = c_b_i[cg]; Cst[4 * tid + 2] = -8.0f * log1pf(expf(-c_lambda[cg])); Cst[4 * tid + 3] = 0.f; }
    bf16x8 wrf[4], wif[4];
#pragma unroll
    for (int ks = 0; ks < 4; ++ks) { const size_t o = ((size_t)(l * 4 + n) * 64 + 32 * mt + r) * 64 + 16 * ks + 8 * h; wrf[ks] = *(const bf16x8*)(WrT + o); wif[ks] = *(const bf16x8*)(WiT + o); }
    unsigned long long* gbase = GC + ((size_t)((b * 4 + n) * 32) * 128) + 2 * lane;
    float a[2][16], u[2][16];
#pragma unroll
    for (int hf = 0; hf < 2; ++hf) { const int tile = 2 * pair + hf, t0 = tile * 128; LAS float* Seg = SegX + 1024 * hf;
        float cw[4][8], cb[8];
#pragma unroll
        for (int j = 0; j < 8; ++j) { cb[j] = c_conv_b[l * 256 + 64 * n + 8 * pc + j];
#pragma unroll
            for (int jj = 0; jj < 4; ++jj) cw[jj][j] = c_conv_w[((size_t)l * 4 + jj) * 256 + 64 * n + 8 * pc + j]; }
#pragma unroll
        for (int it = 0; it < 2; ++it) { const int t = trow + 64 * it, tok = t0 + t; float acc[8];
#pragma unroll
            for (int j = 0; j < 8; ++j) acc[j] = cb[j];
#pragma unroll
            for (int jj = 0; jj < 4; ++jj) { float x8[8]; unpack8(xin[hf][it][jj], x8); const float m = (tok - 3 + jj) < 0 ? 0.f : 1.f;
#pragma unroll
                for (int j = 0; j < 8; ++j) acc[j] = fmaf(cw[jj][j] * m, x8[j], acc[j]); }
            *(LAS u32x4*)(lds + t * 144 + pc * 16) = pack8(acc); }
        __syncthreads();
        { f32x16 R = (f32x16)(0.f), I = (f32x16)(0.f);
#pragma unroll
          for (int ks = 0; ks < 4; ++ks) { const bf16x8 bfr = *(const LAS bf16x8*)(lds + (32 * tt + r) * 144 + (16 * ks + 8 * h) * 2); R = MFMA32(wrf[ks], bfr, R); I = MFMA32(wif[ks], bfr, I); }
          const int t = 32 * tt + r;
#pragma unroll
          for (int g4 = 0; g4 < 4; ++g4) { const int c0 = 32 * mt + 8 * g4 + 4 * h; const u32x2 xw = *(const LAS u32x2*)(lds + t * 144 + c0 * 2);
              const float xc[4] = {bf_lo(xw.x), bf_hi(xw.x), bf_lo(xw.y), bf_hi(xw.y)};
#pragma unroll
              for (int j = 0; j < 4; ++j) { const f32x4 cs = *(const LAS f32x4*)(Cst + 4 * (c0 + j));
                  const float rr = sigm(R[4 * g4 + j] + cs.x), ii = sigm(I[4 * g4 + j] + cs.y), la = cs.z * rr, av = fexp(la), uv = __builtin_amdgcn_sqrtf(fmaxf(one_minus_exp(2.0f * la), 0.f)) * (ii * xc[j]);
                  Aa[(c0 + j) * 129 + t] = av; Uu[(c0 + j) * 129 + t] = uv; }
              __builtin_amdgcn_sched_barrier(0); } }
        __syncthreads();
        { float Ap = 1.f, Hp = 0.f;
#pragma unroll
          for (int i = 0; i < 16; ++i) { a[hf][i] = Aa[sc * 129 + 16 * seg + i]; u[hf][i] = Uu[sc * 129 + 16 * seg + i]; }
#pragma unroll
          for (int i = 0; i < 16; ++i) { Hp = fmaf(a[hf][i], Hp, u[hf][i]); Ap *= a[hf][i]; }
          Seg[(seg * 64 + sc) * 2] = Ap; Seg[(seg * 64 + sc) * 2 + 1] = Hp; }
        __syncthreads();
        if (w == 0) { float At = 1.f, Ht = 0.f;
#pragma unroll
            for (int s2 = 0; s2 < 8; ++s2) { const float As = Seg[(s2 * 64 + lane) * 2], Hs = Seg[(s2 * 64 + lane) * 2 + 1]; Ht = fmaf(As, Ht, Hs); At *= As; }
            gr_store(gbase + (size_t)tile * 128, tag, At); gr_store(gbase + (size_t)tile * 128 + 1, tag, Ht); }
    }
    { const int tile = 2 * pair; float Aw = 1.f, Hw = 0.f; const int p0 = 4 * w;
      if (p0 < tile) { unsigned long long ga[4], gh[4]; unsigned spins = 0;
          for (;;) { bool ok = true;
#pragma unroll
              for (int k = 0; k < 4; ++k) { const int p = (p0 + k < tile) ? p0 + k : tile - 1; ga[k] = gr_load(gbase + (size_t)p * 128); gh[k] = gr_load(gbase + (size_t)p * 128 + 1);
                  ok = ok && ((unsigned)(ga[k] >> 32) == tag) && ((unsigned)(gh[k] >> 32) == tag); }
              if (__all(ok) || ++spins > SPIN_CAP) break;
              __builtin_amdgcn_s_sleep(2); }
#pragma unroll
          for (int k = 0; k < 4; ++k) if (p0 + k < tile) { const float Ap = __uint_as_float((unsigned)ga[k]), Hp = __uint_as_float((unsigned)gh[k]); Hw = fmaf(Ap, Hw, Hp); Aw *= Ap; } }
      LookY[(w * 64 + lane) * 2] = Aw; LookY[(w * 64 + lane) * 2 + 1] = Hw; }
    __syncthreads();
    if (tid == 0) nxt = __hip_atomic_fetch_add(qh, 1u, __ATOMIC_RELAXED, __HIP_MEMORY_SCOPE_AGENT);
#pragma unroll
    for (int hf = 0; hf < 2; ++hf) { const int t0 = (2 * pair + hf) * 128; const LAS float* Seg = SegX + 1024 * hf;
        u32x4 gwC[2];
#pragma unroll
        for (int it = 0; it < 2; ++it) gwC[it] = *(const u32x4*)(PROJ + ((size_t)b * SEQ + t0 + trow + 64 * it) * NP + PC_CGATE + 64 * n + 8 * pc);
        { float hh = 0.f;
          if (hf == 0) {
#pragma unroll
              for (int w2 = 0; w2 < 8; ++w2) hh = fmaf(LookY[(w2 * 64 + sc) * 2], hh, LookY[(w2 * 64 + sc) * 2 + 1]);
          } else hh = Carry[sc];
          for (int s2 = 0; s2 < seg; ++s2) hh = fmaf(Seg[(s2 * 64 + sc) * 2], hh, Seg[(s2 * 64 + sc) * 2 + 1]);
#pragma unroll
          for (int i = 0; i < 16; ++i) { hh = fmaf(a[hf][i], hh, u[hf][i]); Uu[sc * 129 + 16 * seg + i] = hh; }
          if (hf == 0 && seg == 7) Carry[sc] = hh; }
        __syncthreads();
#pragma unroll
        for (int it = 0; it < 2; ++it) { const int t = trow + 64 * it; const size_t tokg = (size_t)b * SEQ + t0 + t;
            float g8[8], y8[8]; unpack8(gwC[it], g8);
#pragma unroll
            for (int j = 0; j < 8; ++j) y8[j] = Uu[(8 * pc + j) * 129 + t] * silu(g8[j]);
            *(u32x4*)(Y + tokg * DM + 512 + 64 * n + 8 * pc) = pack8(y8); }
        if (hf == 0) __syncthreads();
    }
    __syncthreads();
}

typedef short s16x4 __attribute__((ext_vector_type(4)));
__device__ __forceinline__ u32x2 tr_read4(const LAS unsigned char* p) { const s16x4 v = __builtin_amdgcn_ds_read_tr16_b64_v4i16((LAS s16x4*)p); return __builtin_bit_cast(u32x2, v); }

constexpr int D_WAVE = 14464, D_VT = 5120, D_DEC = 14336, D_SST = 8 * D_WAVE, D_SIN = D_SST  , D_PDL = D_SST + 8192;
static_assert(D_PDL + 128 <= RING_BYTES, "mixer D LDS map");
constexpr int GD_STRIDE = 2112;
__device__ __forceinline__ void mixer_d(Frame& F, int l, int unit) {
    CArgs* A = get_args(); const float* d_w_up = A->in[I_D_W_UP]; const float* d_b_up = A->in[I_D_B_UP]; const float* d_norm_g = A->in[I_D_NORM_G]; bf16_t* Y = WSP(bf16_t, WS_Y); bf16_t* PROJ = WSP(bf16_t, WS_PROJ);
    unsigned long long* GD = WSP(unsigned long long, WS_GD);
    const int tid = F.tid, lane = F.lane, w = F.wave;
    const int grp = unit >> 4, b = (unit >> 2) & 3, head = unit & 3, r = lane & 31, h = lane >> 5; const unsigned tag = (unsigned)l + 1u;
    LAS unsigned char* scr = F.lds + w * D_WAVE; LAS unsigned char* VT = scr + D_VT; LAS float* Dec = (LAS float*)(scr + D_DEC); LAS f32x4* Sst = (LAS f32x4*)(F.lds + D_SST); LAS f32x4* Sin = (LAS f32x4*)(F.lds + D_SIN); LAS float* Pdl = (LAS float*)(F.lds + D_PDL);
    bf16x8 wupf; { float t8[8];
#pragma unroll
        for (int j = 0; j < 8; ++j) t8[j] = d_w_up[((size_t)l * 16 + 8 * h + j) * 128 + 32 * head + r];
        wupf = as_frag(pack8(t8)); }
    const float bup = d_b_up[l * 128 + 32 * head + r];
    Sst[tid] = (f32x4){0.f, 0.f, 0.f, 0.f}; if (tid < 32) Pdl[tid] = 1.f;
    __syncthreads();
    const int chunk = 8 * grp + w; const size_t mrow0 = (size_t)b * SEQ + 64 * chunk;
    float qv[32], kv[32], bb[32];
    f32x16 G[2];
#pragma unroll
    for (int tile = 0; tile < 2; ++tile) { const bf16x8 lrf = *(const bf16x8*)(PROJ + (mrow0 + 32 * tile + r) * NP + PC_DLR + 8 * h); G[tile] = MFMA32(lrf, wupf, (f32x16)(0.f)); }
    { const bf16_t* qbase = PROJ + mrow0 * NP + PC_DQ + 32 * head; const unsigned loff = (unsigned)(4 * h * NP + r);
#pragma unroll
      for (int i = 0; i < 32; ++i) { const unsigned o = loff + (unsigned)((32 * (i >> 4) + 8 * ((i >> 2) & 3) + (i & 3)) * NP);
          qv[i] = __uint_as_float((unsigned)qbase[o] << 16); kv[i] = __uint_as_float((unsigned)qbase[o + (PC_DK - PC_DQ)] << 16); } }
    float run = 0.f;
#pragma unroll
    for (int k = 0; k < 8; ++k) { float c[4];
#pragma unroll
        for (int j = 0; j < 4; ++j) { const float z = G[k >> 2][4 * (k & 3) + j] + bup; const float gl = -(fmaxf(-z, 0.f) + log1p_01(fexp(-fabsf(z)))) * (1.f / 16.f); c[j] = (j ? c[j - 1] : 0.f) + gl; }
        const float tot = c[3], ptot = xget32(tot, h); const float pre = run + (h ? ptot : 0.f);
#pragma unroll
        for (int j = 0; j < 4; ++j) bb[4 * k + j] = pre + c[j];
        run += tot + ptot; }
    const float blast = run, dec = fexp(blast);
    if (h == 0) Dec[r] = dec;
#pragma unroll
    for (int i = 0; i < 32; ++i) { const int t = 32 * (i >> 4) + 8 * ((i >> 2) & 3) + 4 * h + (i & 3); *(LAS bf16_t*)(scr + t * 80 + r * 2) = (bf16_t)f2bf(qv[i] * 0.17677669529663687f * fexp(bb[i])); }
    __builtin_amdgcn_wave_barrier(); asm volatile("" ::: "memory");
    bf16x8 qB[2][2], qP[2][2];
#pragma unroll
    for (int it = 0; it < 2; ++it)
#pragma unroll
        for (int ks = 0; ks < 2; ++ks) { const LAS unsigned char* p = scr + (32 * it + r) * 80; qB[it][ks] = *(const LAS bf16x8*)(p + (16 * ks + 8 * h) * 2);
            const u32x2 lo = *(const LAS u32x2*)(p + (16 * ks + 4 * h) * 2), hi = *(const LAS u32x2*)(p + (16 * ks + 8 + 4 * h) * 2); qP[it][ks] = as_frag((u32x4){lo.x, lo.y, hi.x, hi.y}); }
    __builtin_amdgcn_wave_barrier(); asm volatile("" ::: "memory");
#pragma unroll
    for (int i = 0; i < 32; ++i) { const int t = 32 * (i >> 4) + 8 * ((i >> 2) & 3) + 4 * h + (i & 3); *(LAS bf16_t*)(scr + t * 80 + r * 2) = (bf16_t)f2bf(kv[i] * fexp(-bb[i])); }
    __builtin_amdgcn_wave_barrier(); asm volatile("" ::: "memory");
    bf16x8 kA[2][2];
#pragma unroll
    for (int jt = 0; jt < 2; ++jt)
#pragma unroll
        for (int ks = 0; ks < 2; ++ks) kA[jt][ks] = *(const LAS bf16x8*)(scr + (32 * jt + r) * 80 + (16 * ks + 8 * h) * 2);
    __builtin_amdgcn_wave_barrier(); asm volatile("" ::: "memory");
#pragma unroll
    for (int k = 0; k < 8; ++k) { const int t = 32 * (k >> 2) + 8 * (k & 3) + 4 * h; u32x2 o;
        o.x = pk2(kv[4 * k + 0] * fexp(blast - bb[4 * k + 0]), kv[4 * k + 1] * fexp(blast - bb[4 * k + 1])); o.y = pk2(kv[4 * k + 2] * fexp(blast - bb[4 * k + 2]), kv[4 * k + 3] * fexp(blast - bb[4 * k + 3]));
        *(LAS u32x2*)(scr + r * 144 + t * 2) = o; }
    __builtin_amdgcn_wave_barrier(); asm volatile("" ::: "memory");
    bf16x8 keA[4];
#pragma unroll
    for (int ks = 0; ks < 4; ++ks) keA[ks] = *(const LAS bf16x8*)(scr + r * 144 + (16 * ks + 8 * h) * 2);
#pragma unroll
    for (int i8 = 0; i8 < 8; ++i8) { const int tv = 8 * i8 + (lane >> 3), pc = lane & 7; const u32x4 vw = *(const u32x4*)(PROJ + (mrow0 + tv) * NP + PC_DV + 64 * head + 8 * pc);
        *(LAS u32x4*)(VT + tv * 144 + pc * 16) = vw; }
    const LAS unsigned char* vrb = VT + ((lane & 15) >> 2) * 144 + (16 * ((lane >> 4) & 1) + 4 * (lane & 3)) * 2;
    __builtin_amdgcn_wave_barrier(); asm volatile("" ::: "memory");
    bf16x8 P[3][2];
#define D_ATT(idx, jt, it) do { f32x16 acc = (f32x16)(0.f); acc = MFMA32(kA[jt][0], qB[it][0], acc); acc = MFMA32(kA[jt][1], qB[it][1], acc); \
    if (jt == it) { const int rr = r - 4 * h; _Pragma("unroll") for (int rg = 0; rg < 16; ++rg) { acc[rg] = (rr < (rg & 3) + 8 * (rg >> 2)) ? 0.f : acc[rg]; } } \
    P[idx][0] = frag_acc<0>(acc); P[idx][1] = frag_acc<8>(acc); } while (0)
    D_ATT(0, 0, 0); __builtin_amdgcn_sched_barrier(0); D_ATT(1, 0, 1); __builtin_amdgcn_sched_barrier(0); D_ATT(2, 1, 1); __builtin_amdgcn_sched_barrier(0);
#undef D_ATT
    f32x16 ds[2];
#pragma unroll
    for (int et = 0; et < 2; ++et) { ds[et] = (f32x16)(0.f);
#pragma unroll
        for (int ks = 0; ks < 4; ++ks) { const LAS unsigned char* vp = vrb + (16 * ks + 8 * h) * 144 + 64 * et; const u32x2 lo = tr_read4(vp), hi = tr_read4(vp + 4 * 144);
            ds[et] = MFMA32(keA[ks], as_frag((u32x4){lo.x, lo.y, hi.x, hi.y}), ds[et]); } }
    f32x16 L[2]; float pdv[16], dv[16];
#pragma unroll
    for (int q4 = 0; q4 < 4; ++q4) { const f32x4 v = *(const LAS f32x4*)(Dec + 8 * q4 + 4 * h); dv[4 * q4 + 0] = v.x; dv[4 * q4 + 1] = v.y; dv[4 * q4 + 2] = v.z; dv[4 * q4 + 3] = v.w; }
#pragma unroll 1
    for (int step = 0; step < 8; ++step) {
        if (w == step) {
#pragma unroll
            for (int q4 = 0; q4 < 4; ++q4) { const f32x4 v = *(const LAS f32x4*)(Pdl + 8 * q4 + 4 * h); pdv[4 * q4 + 0] = v.x; pdv[4 * q4 + 1] = v.y; pdv[4 * q4 + 2] = v.z; pdv[4 * q4 + 3] = v.w; }
#pragma unroll
            for (int et = 0; et < 2; ++et)
#pragma unroll
                for (int q4 = 0; q4 < 4; ++q4) { const f32x4 v = Sst[(et * 4 + q4) * 64 + lane]; L[et][4 * q4 + 0] = v.x; L[et][4 * q4 + 1] = v.y; L[et][4 * q4 + 2] = v.z; L[et][4 * q4 + 3] = v.w;
                    f32x4 nv; nv.x = fmaf(v.x, dv[4 * q4 + 0], ds[et][4 * q4 + 0]); nv.y = fmaf(v.y, dv[4 * q4 + 1], ds[et][4 * q4 + 1]); nv.z = fmaf(v.z, dv[4 * q4 + 2], ds[et][4 * q4 + 2]); nv.w = fmaf(v.w, dv[4 * q4 + 3], ds[et][4 * q4 + 3]);
                    Sst[(et * 4 + q4) * 64 + lane] = nv; }
            if (lane < 32) Pdl[lane] = Pdl[lane] * Dec[lane]; }
        __syncthreads(); }
    { unsigned long long* gmine = GD + (size_t)((b * 4 + head) * 8 + grp) * GD_STRIDE; const f32x4 sv = Sst[tid];
      gr_store(gmine + 4 * tid + 0, tag, sv.x); gr_store(gmine + 4 * tid + 1, tag, sv.y); gr_store(gmine + 4 * tid + 2, tag, sv.z); gr_store(gmine + 4 * tid + 3, tag, sv.w);
      if (tid < 32) gr_store(gmine + 2048 + tid, tag, Pdl[tid]);
      f32x4 sin = (f32x4){0.f, 0.f, 0.f, 0.f}; const int d0 = 8 * ((tid >> 6) & 3) + 4 * ((tid >> 5) & 1);
      const unsigned long long* gb = GD + (size_t)((b * 4 + head) * 8) * GD_STRIDE;
      for (int p0 = 0; p0 < grp; p0 += 4) { unsigned long long gs[4][4], gd[4][4]; unsigned spins = 0;
          for (;;) { bool ok = true;
#pragma unroll
              for (int k = 0; k < 4; ++k) { const int p = (p0 + k < grp) ? p0 + k : grp - 1; const unsigned long long* gp = gb + (size_t)p * GD_STRIDE;
#pragma unroll
                  for (int e = 0; e < 4; ++e) { gs[k][e] = gr_load(gp + 4 * tid + e); gd[k][e] = gr_load(gp + 2048 + d0 + e); ok = ok && ((unsigned)(gs[k][e] >> 32) == tag) && ((unsigned)(gd[k][e] >> 32) == tag); } }
              if (__all(ok) || ++spins > SPIN_CAP) break;
              __builtin_amdgcn_s_sleep(2); }
#pragma unroll
          for (int k = 0; k < 4; ++k) if (p0 + k < grp) {
              sin.x = fmaf(sin.x, __uint_as_float((unsigned)gd[k][0]), __uint_as_float((unsigned)gs[k][0])); sin.y = fmaf(sin.y, __uint_as_float((unsigned)gd[k][1]), __uint_as_float((unsigned)gs[k][1]));
              sin.z = fmaf(sin.z, __uint_as_float((unsigned)gd[k][2]), __uint_as_float((unsigned)gs[k][2])); sin.w = fmaf(sin.w, __uint_as_float((unsigned)gd[k][3]), __uint_as_float((unsigned)gs[k][3])); } }
      Sin[tid] = sin; }
    __syncthreads();
    bf16x8 SA[2][2];
#pragma unroll
    for (int et = 0; et < 2; ++et) {
#pragma unroll
        for (int q4 = 0; q4 < 4; ++q4) { const f32x4 v = Sin[(et * 4 + q4) * 64 + lane]; L[et][4 * q4 + 0] = fmaf(pdv[4 * q4 + 0], v.x, L[et][4 * q4 + 0]); L[et][4 * q4 + 1] = fmaf(pdv[4 * q4 + 1], v.y, L[et][4 * q4 + 1]);
            L[et][4 * q4 + 2] = fmaf(pdv[4 * q4 + 2], v.z, L[et][4 * q4 + 2]); L[et][4 * q4 + 3] = fmaf(pdv[4 * q4 + 3], v.w, L[et][4 * q4 + 3]); }
        SA[et][0] = frag_acc<0>(L[et]); SA[et][1] = frag_acc<8>(L[et]); }
#pragma unroll
    for (int it = 0; it < 2; ++it) { f32x16 o[2]; o[0] = (f32x16)(0.f); o[1] = (f32x16)(0.f);
#pragma unroll
        for (int jt = 0; jt <= it; ++jt) { const int idx = (jt == 0) ? it : 2;
#pragma unroll
            for (int sp = 0; sp < 2; ++sp)
#pragma unroll
                for (int et = 0; et < 2; ++et) { const LAS unsigned char* vp = vrb + (32 * jt + 16 * sp + 4 * h) * 144 + 64 * et; const u32x2 lo = tr_read4(vp), hi = tr_read4(vp + 8 * 144);
                    o[et] = MFMA32(as_frag((u32x4){lo.x, lo.y, hi.x, hi.y}), P[idx][sp], o[et]); } }
#pragma unroll
        for (int ks = 0; ks < 2; ++ks)
#pragma unroll
            for (int et = 0; et < 2; ++et) o[et] = MFMA32(SA[et][ks], qP[it][ks], o[et]);
        float ss = 0.f;
#pragma unroll
        for (int et = 0; et < 2; ++et)
#pragma unroll
            for (int rg = 0; rg < 16; ++rg) ss = fmaf(o[et][rg], o[et][rg], ss);
        ss = xsum32(ss);
        const float rstd = rsq(ss * (1.f / 64.f) + EPS); const size_t tok = mrow0 + 32 * it + r;
#pragma unroll
        for (int et = 0; et < 2; ++et)
#pragma unroll
            for (int g4 = 0; g4 < 4; ++g4) { const int e = 32 * et + 8 * g4 + 4 * h; const f32x4 ng = *(const f32x4*)(d_norm_g + l * 64 + e); const u32x2 gw = *(const u32x2*)(PROJ + tok * NP + PC_DGATE + 64 * head + e);
                u32x2 ov; ov.x = pk2(o[et][4 * g4 + 0] * rstd * ng.x * silu(bf_lo(gw.x)), o[et][4 * g4 + 1] * rstd * ng.y * silu(bf_hi(gw.x)));
                ov.y = pk2(o[et][4 * g4 + 2] * rstd * ng.z * silu(bf_lo(gw.y)), o[et][4 * g4 + 3] * rstd * ng.w * silu(bf_hi(gw.y)));
                *(u32x2*)(Y + tok * DM + 768 + 64 * head + e) = ov; } }
    __syncthreads();
}

constexpr int U_D = 128, U_C = 256, U_B = 256, U_A = 256, U_MIX = U_C + U_D + U_B + U_A, U_W = (I_L + NWAVES - 1) / NWAVES;
__global__ void __launch_bounds__(NTHR, 2) fwd_kernel(Args args) {
    extern __shared__ __attribute__((aligned(16))) unsigned char lds_raw[];
    Frame F;
    F.lds = (LAS unsigned char*)lds_raw; F.MISC = (volatile LAS unsigned*)(F.lds + MISC_OFF);
    F.tid = threadIdx.x; F.lane = F.tid & 63; F.wave = __builtin_amdgcn_readfirstlane(F.tid >> 6); F.G = gridDim.x;
    for (int u = F.tid; u < 256; u += NTHR) ((LAS unsigned*)(F.lds + LDSCTL_OFF))[u] = 0u;
    __syncthreads();
    XcdBarrier bar = xcd_barrier_post((unsigned*)(args.ws + WS_CTL) + CW_BAR, F.MISC + 8);
#define GRID_BAR() xcd_barrier(bar)
    p0_prologue(F);
    GRID_BAR();
#pragma unroll 1
    for (int l = 0; l < DEPTH; ++l) {
        { CArgs* A = get_args();
          pg8::Gemm g{WSP(bf16_t, WS_XB), WSP(bf16_t, WS_WIN) + (size_t)l * NP * DM, M, NP, DM}; pg8::StaticOrder S; S.init(M, NP, F.G, (int)blockIdx.x);
          pg8::EpiProj E{WSP(bf16_t, WS_PROJ), NP, WSP(float, WS_SSQ), __builtin_amdgcn_make_buffer_rsrc(WSP(bf16_t, WS_PROJ), 0, (int)((size_t)M * NP * 2), 0x00020000)};
          pg8::gemm_phase<pg8::EpiProj, pg8::StaticOrder, true, true>(F.lds, g, S, E); }
        int all_seen = 1;
        if (F.G == 256) { all_seen = 0;
            asm volatile("s_waitcnt vmcnt(0)" ::: "memory"); __syncthreads();
            if (F.tid == 0) { const int c = (int)blockIdx.x; unsigned* ctl = (unsigned*)(args.ws + WS_CTL);
                __hip_atomic_fetch_add(ctl + CW_PCNT + 64 * (l * 64 + 8 * (c & 7) + ((c >> 3) & 7)), 1u, RLX_AGENT); __hip_atomic_fetch_add(ctl + CW_GDONE + 64 * l, 1u, RLX_AGENT); }
        } else GRID_BAR();
        { CArgs* A = get_args(); unsigned* qh = WSP(unsigned, WS_CTL) + CW_Q + 64 * l;
          __syncthreads();
          if (F.tid == 0) F.MISC[16] = __hip_atomic_fetch_add(qh, 1u, RLX_AGENT);
          __syncthreads();
          int u = (int)F.MISC[16];
          const int U_TOTAL = U_MIX + (l + 1 < DEPTH ? U_W : 0);
          while (u < U_TOTAL) {
              const bool pre = u >= U_D + U_C;
              unsigned nxt = 0u; if (pre && F.tid == 0) nxt = __hip_atomic_fetch_add(qh, 1u, RLX_AGENT);
              if (!all_seen) {
                  if (F.tid == 0) { int need = 1, bb = 0, lo = 0, hi = 0;
                      if (u < U_D) { bb = (u >> 2) & 3; lo = 512 * (u >> 4); hi = lo + 511; }
                      else if (u < U_C + U_D) { const int uc = u - U_D; bb = (uc >> 2) & 3; lo = 256 * (uc >> 4) - 3; hi = lo + 258; }
                      else if (u < U_C + U_D + U_A) { const int ua = u - U_C - U_D; bb = ua >> 6; lo = 64 * (ua & 63) - 30; hi = lo + 93; }
                      else if (u < U_MIX) { const int ub = u - U_C - U_D - U_A; bb = ub >> 6; lo = 128 * ((ub >> 1) & 31) - 128; hi = lo + 255; }
                      else need = 0;
                      unsigned* ctl = (unsigned*)(A->ws + WS_CTL); unsigned* pc = ctl + CW_PCNT + 64 * (l * 64 + 16 * bb);
                      const int p0 = (lo < 0 ? 0 : lo) >> 8, p1 = hi >> 8; unsigned sp = 0;
                      if (need) while ((__hip_atomic_load(pc + 64 * p0, RLX_AGENT) < 4u || __hip_atomic_load(pc + 64 * p1, RLX_AGENT) < 4u) && ++sp < (1u << 20)) __builtin_amdgcn_s_sleep(1);
                      const unsigned gd = __hip_atomic_load(ctl + CW_GDONE + 64 * l, RLX_AGENT);
                      F.MISC[18] = (gd >= (unsigned)F.G) ? 1u : 0u; }
                  __syncthreads();
                  all_seen = (int)F.MISC[18];
              }
              Frame FL = F; { int t = F.tid; asm volatile("" : "+v"(t)); FL.tid = t; FL.lane = t & 63; FL.wave = __builtin_amdgcn_readfirstlane(t >> 6); }
              if (u < U_D) { mixer_d(FL, l, u); }
              else if (u < U_C + U_D) { mixer_c(FL, l, u - U_D, qh, nxt); }
              else if (u < U_C + U_D + U_A) { mixer_a(FL, l, u - U_C - U_D); }
              else if (u < U_MIX) { mixer_b(FL, l, u - U_C - U_D - U_A); }
              else { const int it = (u - U_MIX) * NWAVES + FL.wave; if (it < I_L) convert_item(FL, l + 1, it); __syncthreads(); }
              if (F.tid == 0) F.MISC[16] = (pre || (u >= U_D && u < U_D + U_C)) ? nxt : __hip_atomic_fetch_add(qh, 1u, RLX_AGENT);
              __syncthreads();
              u = (int)F.MISC[16];
          }
        }
        GRID_BAR();
        { CArgs* A = get_args();
          pg8::Gemm g{WSP(bf16_t, WS_Y), WSP(bf16_t, WS_WOUT) + (size_t)l * DM * DM, M, DM, DM}; pg8::StaticOrder S; S.init(M, DM, F.G, (int)blockIdx.x);
          pg8::EpiRes E{A->in[I_X], A->out, WSP(bf16_t, WS_XB), WSP(float, WS_SSQ), l == 0 ? 0 : (l + 1 < DEPTH ? 1 : 2), __builtin_amdgcn_make_buffer_rsrc(WSP(bf16_t, WS_XB), 0, (int)((size_t)M * DM * 2), 0x00020000)};
          pg8::gemm_phase<pg8::EpiRes, pg8::StaticOrder, true, true>(F.lds, g, S, E); }
        if (l + 1 < DEPTH) {
            if (F.G == 256) {
                asm volatile("s_waitcnt vmcnt(0)" ::: "memory"); __syncthreads();
                if (F.tid == 0) { unsigned* cnt = (unsigned*)(args.ws + WS_CTL) + CW_TEAM + 64 * (l * 64 + ((int)blockIdx.x & 63));
                    __hip_atomic_fetch_add(cnt, 1u, RLX_AGENT);
                    unsigned sp = 0; while (__hip_atomic_load(cnt, RLX_AGENT) < 4u && ++sp < (1u << 20)) __builtin_amdgcn_s_sleep(1);
                    __builtin_amdgcn_fence(__ATOMIC_ACQUIRE, "agent"); asm volatile("s_waitcnt vmcnt(0)" ::: "memory"); }
                __syncthreads();
            } else GRID_BAR();
        }
    }
}

extern "C" void kernel_launch(void* const* d_in, const int* in_sizes, int n_in, void* d_out, int out_size, void* d_ws, size_t ws_size, hipStream_t stream) {
    static int grid = 0;
    if (grid == 0) {
        if (n_in != 23 || in_sizes[0] != M * DM || out_size != M * DM || ws_size < WS_END) { fprintf(stderr, "kernel_launch: unexpected problem shape (n_in %d, in0 %d, out %d, ws %zu)\n", n_in, n_in > 0 ? in_sizes[0] : -1, out_size, ws_size); grid = -1; return; }
        int dev = 0, cus = 0, per_cu = 0;
        if (hipGetDevice(&dev) != hipSuccess || hipDeviceGetAttribute(&cus, hipDeviceAttributeMultiprocessorCount, dev) != hipSuccess) { grid = -1; return; }
        if (hipFuncSetAttribute((const void*)fwd_kernel, hipFuncAttributeMaxDynamicSharedMemorySize, LDS_BYTES) != hipSuccess) { fprintf(stderr, "kernel_launch: hipFuncSetAttribute failed\n"); grid = -1; return; }
        if (hipOccupancyMaxActiveBlocksPerMultiprocessor(&per_cu, (const void*)fwd_kernel, NTHR, LDS_BYTES) != hipSuccess || per_cu < 1) { fprintf(stderr, "kernel_launch: occupancy query says %d blocks per CU\n", per_cu); grid = -1; (void)hipGetLastError(); return; }
        grid = cus * per_cu < 256 ? cus * per_cu : 256;
    }
    if (grid <= 0) return;
    (void)hipMemsetAsync((char*)d_ws + WS_CTL, 0, CTL_ZERO_BYTES, stream);
    Args a{};
    for (int i = 0; i < 23; ++i) a.in[i] = (const float*)d_in[i];
    a.out = (float*)d_out; a.ws = (unsigned char*)d_ws;
    void* kargs[] = {&a};
    hipError_t e = hipLaunchCooperativeKernel((const void*)fwd_kernel, dim3(grid), dim3(NTHR), kargs, LDS_BYTES, stream);
    if (e != hipSuccess) fprintf(stderr, "kernel_launch: cooperative launch failed: %s (grid %d)\n", hipGetErrorString(e), grid);
}
```

```cpp
#include <hip/hip_runtime.h>
#include <cstdio>
#include <cstdint>
template <int CTRL> __device__ __forceinline__ float dpp(float x) { return __builtin_bit_cast(float, __builtin_amdgcn_mov_dpp(__builtin_bit_cast(int, x), CTRL, 0xf, 0xf, true)); }
constexpr int DPP_XOR1 = 0xB1, DPP_XOR2 = 0x4E, DPP_XOR7 = 0x141, DPP_XOR8 = 0x128;
__device__ __forceinline__ float sum8(float v) { v += dpp<DPP_XOR1>(v); v += dpp<DPP_XOR2>(v); v += dpp<DPP_XOR7>(v); return v; }
__device__ __forceinline__ float sum16(float v) { v = sum8(v); v += dpp<DPP_XOR8>(v); return v; }
__device__ __forceinline__ float xsum16(float x) { auto s = __builtin_amdgcn_permlane16_swap(__float_as_uint(x), __float_as_uint(x), false, false); return __uint_as_float(s[0]) + __uint_as_float(s[1]); }
__device__ __forceinline__ float xsum32(float x) { auto s = __builtin_amdgcn_permlane32_swap(__float_as_uint(x), __float_as_uint(x), false, false); return __uint_as_float(s[0]) + __uint_as_float(s[1]); }
__device__ __forceinline__ float xmax32(float x) { auto s = __builtin_amdgcn_permlane32_swap(__float_as_uint(x), __float_as_uint(x), false, false); return fmaxf(__uint_as_float(s[0]), __uint_as_float(s[1])); }
__device__ __forceinline__ float xget32(float x, int hi) { auto s = __builtin_amdgcn_permlane32_swap(__float_as_uint(x), __float_as_uint(x), false, false); return __uint_as_float(hi ? s[0] : s[1]); }
__device__ __forceinline__ float sum32(float v) { return xsum16(sum16(v)); }
namespace pg8 {
#define PG8_LAS __attribute__((address_space(3)))
typedef unsigned short bf16_t;
typedef short bf16x8 __attribute__((ext_vector_type(8)));
typedef float f32x4 __attribute__((ext_vector_type(4)));
typedef unsigned u32x4 __attribute__((ext_vector_type(4)));
constexpr int BM = 256, BK = 64, HALF = 128, HTB = HALF * BK * 2  , STAGE_BYTES = 8 * HTB, NXCD = 8, WGM = 8;

__host__ __device__ __forceinline__ int lds_byte(int r, int c) { const int st = (r >> 4) * 2 + (c >> 5), rr = r & 15, cc = c & 31, ob = rr * 64 + cc * 2; return st * 1024 + (ob ^ (((ob >> 9) & 1) << 5)); }
__host__ __device__ __forceinline__ void stage_rc(int b, int& R, int& C) { const int st = b / 1024, sb = b % 1024, swz = sb ^ (((sb >> 9) & 1) << 5); R = (st >> 1) * 16 + swz / 64; C = (st & 1) * 32 + (swz % 64) / 2; }
__host__ __device__ __forceinline__ int perm32(int rho) { const int n = rho >> 4, i = rho & 15; return 8 * (i >> 2) + 4 * n + (i & 3); }

struct Unit { int pm, pn; };
struct Gemm { const bf16_t* A; const bf16_t* Bt; int M, N, K; };

struct StaticOrder {
    int nM, nN, nwg, G, c;
    __host__ __device__ void init(int M, int N, int G_, int c_) { nM = M / BM; nN = N / BM; nwg = nM * nN; G = G_; c = c_; }
    __host__ __device__ bool next(int i, Unit& u) const {
        const long L = (long)i * G + c; if (L >= nwg) return false;
        int wgid = (int)L; { const int q = nwg / NXCD, r = nwg % NXCD, xcd = wgid % NXCD, off = wgid / NXCD; wgid = (xcd < r ? xcd * (q + 1) : r * (q + 1) + (xcd - r) * q) + off; }
        const int nig = WGM * nN, gid = wgid / nig, fm = gid * WGM, gsz = (nM - fm) < WGM ? (nM - fm) : WGM;
        u.pm = fm + ((wgid % nig) % gsz); u.pn = (wgid % nig) / gsz; return true;
    }
    __device__ __forceinline__ void a_ready(const Unit&) const {}
    __device__ __forceinline__ void done(const Unit&) const {}
};

__device__ __forceinline__ unsigned cvt_pk_bf16(float lo, float hi) { unsigned r; asm volatile("v_cvt_pk_bf16_f32 %0, %1, %2" : "=v"(r) : "v"(lo), "v"(hi)); return r; }
struct EpiProj {
    static constexpr bool PERM = true, AFTER_DRAIN = false;
    bf16_t* O; int ldc; const float* ssq; __amdgpu_buffer_rsrc_t rsrc;
    __device__ __forceinline__ void operator()(const f32x4 (&acc)[2][2][4][2], const Unit& u, int wr, int wc, int fr, int fq) const {
        const int row0 = u.pm * BM + wr * 64 + fr, col0 = u.pn * BM + wc * 32 + 8 * fq;
#pragma unroll
        for (int ai = 0; ai < 2; ++ai)
#pragma unroll
            for (int m = 0; m < 4; ++m) { const int row = row0 + ai * HALF + m * 16;
                const f32x4 s4 = *(const f32x4*)(ssq + (size_t)row * 16 + 4 * fq);
                float s = (s4[0] + s4[1]) + (s4[2] + s4[3]); s = xsum32(xsum16(s));
                const float rs = 1.0f / sqrtf(s * (1.0f / 1024.0f) + 1e-6f);
                const unsigned boff = (unsigned)(((size_t)row * ldc + col0) * 2);
#pragma unroll
                for (int bj = 0; bj < 2; ++bj) { const f32x4 v0 = acc[ai][bj][m][0] * rs, v1 = acc[ai][bj][m][1] * rs;
                    u32x4 w; w.x = cvt_pk_bf16(v0[0], v0[1]); w.y = cvt_pk_bf16(v0[2], v0[3]); w.z = cvt_pk_bf16(v1[0], v1[1]); w.w = cvt_pk_bf16(v1[2], v1[3]);
                    __builtin_amdgcn_raw_buffer_store_b128(w, rsrc, boff + bj * HALF * 2, 0,   16); } }
    }
};
struct EpiRes {
    static constexpr bool PERM = true, AFTER_DRAIN = false;
    float* xout; bf16_t* xb; float* ssq; int mode; __amdgpu_buffer_rsrc_t rsrc;
    __device__ __forceinline__ void operator()(const f32x4 (&acc)[2][2][4][2], const Unit& u, int wr, int wc, int fr, int fq) const {
        const int row0 = u.pm * BM + wr * 64 + fr, col0 = u.pn * BM + wc * 32 + 8 * fq;
#pragma unroll
        for (int ai = 0; ai < 2; ++ai)
#pragma unroll
            for (int m = 0; m < 4; ++m) { const int row = row0 + ai * HALF + m * 16; float ss = 0.f;
#pragma unroll
                for (int bj = 0; bj < 2; ++bj) { const size_t off = (size_t)row * 1024 + col0 + bj * HALF; f32x4 x0, x1;
                    { const u32x4 w = *(const u32x4*)(xb + off); x0 = (f32x4){__uint_as_float(w.x << 16), __uint_as_float(w.x & 0xffff0000u), __uint_as_float(w.y << 16), __uint_as_float(w.y & 0xffff0000u)};
                        x1 = (f32x4){__uint_as_float(w.z << 16), __uint_as_float(w.z & 0xffff0000u), __uint_as_float(w.w << 16), __uint_as_float(w.w & 0xffff0000u)}; }
                    x0 = x0 + acc[ai][bj][m][0]; x1 = x1 + acc[ai][bj][m][1];
                    if (mode == 2) { *(f32x4*)(xout + off) = x0; *(f32x4*)(xout + off + 4) = x1; }
                    else { u32x4 w; w.x = cvt_pk_bf16(x0[0], x0[1]); w.y = cvt_pk_bf16(x0[2], x0[3]); w.z = cvt_pk_bf16(x1[0], x1[1]); w.w = cvt_pk_bf16(x1[2], x1[3]);
                        __builtin_amdgcn_raw_buffer_store_b128(w, rsrc, (unsigned)(off * 2), 0,   16);
                        const float r0 = __uint_as_float(w.x << 16), r1 = __uint_as_float(w.x & 0xffff0000u), r2 = __uint_as_float(w.y << 16), r3 = __uint_as_float(w.y & 0xffff0000u),
                                    r4 = __uint_as_float(w.z << 16), r5 = __uint_as_float(w.z & 0xffff0000u), r6 = __uint_as_float(w.w << 16), r7 = __uint_as_float(w.w & 0xffff0000u);
                        ss += (r0 * r0 + r1 * r1) + (r2 * r2 + r3 * r3) + (r4 * r4 + r5 * r5) + (r6 * r6 + r7 * r7); } }
                if (mode != 2) { ss = xsum32(xsum16(ss)); if (fq == 0) __hip_atomic_store(ssq + (size_t)row * 16 + u.pn * 4 + wc, ss, __ATOMIC_RELAXED, __HIP_MEMORY_SCOPE_AGENT); } }
    }
};

template <class Epi, class Sched, bool ALIGN_EPI = false, bool SP2 = false>
__device__ __forceinline__ void gemm_phase(PG8_LAS unsigned char* lds, const Gemm g, const Sched& S, const Epi& E) {
    int tid_ = threadIdx.x; asm volatile("" : "+v"(tid_));
    const int tid = tid_, wid = __builtin_amdgcn_readfirstlane(tid >> 6), lane = tid & 63, wr = wid >> 2, wc = wid & 3, fr = lane & 15, fq = lane >> 4;
    const int K = g.K, nt = K / BK;
    unsigned voffA[2], voffB[2];
#pragma unroll
    for (int i = 0; i < 2; ++i) { int R, C; stage_rc(tid * 16 + i * 8192, R, C); const int Rb = Epi::PERM ? ((R & ~31) + perm32(R & 31)) : R;
        voffA[i] = (unsigned)(R * K + C) * 2u; voffB[i] = (unsigned)(Rb * K + C) * 2u; }
    const size_t kstep = (size_t)(BK * 2);
    const size_t hstep = (size_t)HALF * K * 2;
    const size_t tstep = 2 * hstep;
    const unsigned ldsw = (unsigned)wid * 1024u;
    const int aoff = lds_byte(wr * 64 + fr, fq * 8), boff = lds_byte(wc * 32 + fr, fq * 8);
#define PG8_SA(b, h) (((b) * 2 + (h)) * HTB)
#define PG8_SB(b, h) ((4 + (b) * 2 + (h)) * HTB)
#define PG8_STAGE(bufoff, gbase, voff) do { _Pragma("unroll") for (int _i = 0; _i < 2; ++_i) \
        __builtin_amdgcn_global_load_lds((const unsigned*)((const char*)(gbase) + (voff)[_i]), (PG8_LAS unsigned*)(lds + (bufoff) + ldsw + _i * 8192), 16, 0, 0); } while (0)
#define PG8_LDA(dst, b, h) do { _Pragma("unroll") for (int m = 0; m < 4; ++m) _Pragma("unroll") for (int k = 0; k < 2; ++k) dst[m][k] = *(const PG8_LAS bf16x8*)(lds + PG8_SA(b, h) + aoff + m * 2048 + k * 1024); } while (0)
#define PG8_LDB(dst, b, h) do { _Pragma("unroll") for (int n = 0; n < 2; ++n) _Pragma("unroll") for (int k = 0; k < 2; ++k) dst[n][k] = *(const PG8_LAS bf16x8*)(lds + PG8_SB(b, h) + boff + n * 2048 + k * 1024); } while (0)
#define PG8_MMA(ai, bj, At, Bt) do { __builtin_amdgcn_s_setprio(1); _Pragma("unroll") for (int m = 0; m < 4; ++m) _Pragma("unroll") for (int n = 0; n < 2; ++n) _Pragma("unroll") for (int k = 0; k < 2; ++k) \
        acc[ai][bj][m][n] = __builtin_amdgcn_mfma_f32_16x16x32_bf16(Bt[n][k], At[m][k], acc[ai][bj][m][n], 0, 0, 0); __builtin_amdgcn_s_setprio(0); } while (0)
#define PG8_WAIT_V(n) asm volatile("s_waitcnt vmcnt(" #n ")" ::: "memory")
#define PG8_WAIT_L(n) asm volatile("s_waitcnt lgkmcnt(" #n ")" ::: "memory")
#define PG8_BAR __builtin_amdgcn_s_barrier()
#define PG8_SCHED __builtin_amdgcn_sched_barrier(0)
    Unit cur, nxt; int ui = 0;
    if (!S.next(0, cur)) return;
    f32x4 acc[2][2][4][2];
#pragma unroll
    for (int a = 0; a < 2; ++a)
#pragma unroll
        for (int b = 0; b < 2; ++b)
#pragma unroll
            for (int m = 0; m < 4; ++m)
#pragma unroll
                for (int n = 0; n < 2; ++n) acc[a][b][m][n] = (f32x4){0.f, 0.f, 0.f, 0.f};
    bf16x8 At[4][2], B0[2][2], B1[2][2];
    const char* cA = (const char*)g.A + (size_t)cur.pm * tstep; const char* cB = (const char*)g.Bt + (size_t)cur.pn * tstep;
    S.a_ready(cur);
    if constexpr (SP2) {
        PG8_STAGE(PG8_SB(0, 0), cB, voffB); PG8_STAGE(PG8_SB(0, 1), cB + hstep, voffB); PG8_STAGE(PG8_SA(0, 0), cA, voffA); PG8_STAGE(PG8_SA(0, 1), cA + hstep, voffA);
        if (wr == 1) PG8_BAR;
        PG8_WAIT_V(2); PG8_BAR;
        PG8_STAGE(PG8_SB(1, 0), cB + kstep, voffB); PG8_STAGE(PG8_SA(1, 0), cA + kstep, voffA); PG8_STAGE(PG8_SB(1, 1), cB + hstep + kstep, voffB);
        PG8_WAIT_V(6); PG8_BAR;
    } else {
        PG8_STAGE(PG8_SB(0, 0), cB, voffB); PG8_STAGE(PG8_SA(0, 0), cA, voffA); PG8_STAGE(PG8_SB(0, 1), cB + hstep, voffB); PG8_STAGE(PG8_SA(0, 1), cA + hstep, voffA);
        if (wr == 1) PG8_BAR;
        PG8_WAIT_V(4); PG8_BAR;
        PG8_STAGE(PG8_SB(1, 0), cB + kstep, voffB); PG8_STAGE(PG8_SA(1, 0), cA + kstep, voffA); PG8_STAGE(PG8_SB(1, 1), cB + hstep + kstep, voffB);
        PG8_WAIT_V(6); PG8_BAR;
    }
    for (;;) {
        const bool has_next = S.next(ui + 1, nxt);
        const char* nA = has_next ? (const char*)g.A + (size_t)nxt.pm * tstep : cA; const char* nB = has_next ? (const char*)g.Bt + (size_t)nxt.pn * tstep : cB;
        for (int t = 0; t < nt; t += 2) {
            const bool last = (t == nt - 2);
            const char* a1 = cA + (size_t)(t + 1) * kstep;
            const char* a2 = last ? nA : cA + (size_t)(t + 2) * kstep; const char* b2 = last ? nB : cB + (size_t)(t + 2) * kstep;
            const char* a3 = a2 + kstep; const char* b3 = b2 + kstep;
            if (last && has_next) S.a_ready(nxt);
            if constexpr (SP2) {
            PG8_LDB(B0, 0, 0); PG8_LDB(B1, 0, 1); PG8_SCHED; PG8_LDA(At, 0, 0); PG8_STAGE(PG8_SA(1, 1), a1 + hstep, voffA);
            PG8_WAIT_V(8); PG8_WAIT_L(0); PG8_BAR; PG8_MMA(0, 0, At, B0); PG8_MMA(0, 1, At, B1); PG8_BAR; PG8_SCHED;
            PG8_LDA(At, 0, 1); PG8_STAGE(PG8_SB(0, 0), b2, voffB); PG8_STAGE(PG8_SB(0, 1), b2 + hstep, voffB); PG8_STAGE(PG8_SA(0, 0), a2, voffA);
            PG8_WAIT_V(8); PG8_WAIT_L(0); PG8_BAR; PG8_MMA(1, 0, At, B0); PG8_MMA(1, 1, At, B1); PG8_BAR; PG8_SCHED;
            PG8_LDB(B0, 1, 0); PG8_LDB(B1, 1, 1); PG8_SCHED; PG8_LDA(At, 1, 0); PG8_STAGE(PG8_SA(0, 1), a2 + hstep, voffA);
            PG8_WAIT_V(8); PG8_WAIT_L(0); PG8_BAR; PG8_MMA(0, 0, At, B0); PG8_MMA(0, 1, At, B1); PG8_BAR; PG8_SCHED;
            PG8_LDA(At, 1, 1); PG8_STAGE(PG8_SB(1, 0), b3, voffB); PG8_STAGE(PG8_SB(1, 1), b3 + hstep, voffB); PG8_STAGE(PG8_SA(1, 0), a3, voffA);
            PG8_WAIT_V(8); PG8_WAIT_L(0); PG8_BAR; PG8_MMA(1, 0, At, B0); PG8_MMA(1, 1, At, B1); PG8_BAR; PG8_SCHED;
            } else {
            PG8_LDB(B0, 0, 0); PG8_SCHED; PG8_LDA(At, 0, 0); PG8_STAGE(PG8_SA(1, 1), a1 + hstep, voffA);
            PG8_WAIT_L(8); PG8_BAR; PG8_WAIT_L(0); PG8_MMA(0, 0, At, B0); PG8_BAR; PG8_SCHED;
            PG8_LDB(B1, 0, 1); PG8_STAGE(PG8_SB(0, 0), b2, voffB);
            PG8_BAR; PG8_WAIT_L(0); PG8_MMA(0, 1, At, B1); PG8_BAR;
            PG8_LDA(At, 0, 1); PG8_STAGE(PG8_SA(0, 0), a2, voffA);
            PG8_BAR; PG8_WAIT_L(0); PG8_MMA(1, 0, At, B0); PG8_BAR; PG8_SCHED;
            PG8_STAGE(PG8_SB(0, 1), b2 + hstep, voffB);
            PG8_WAIT_V(6); PG8_BAR; PG8_MMA(1, 1, At, B1); PG8_BAR;
            PG8_LDB(B0, 1, 0); PG8_SCHED; PG8_LDA(At, 1, 0); PG8_STAGE(PG8_SA(0, 1), a2 + hstep, voffA);
            PG8_WAIT_L(8); PG8_BAR; PG8_WAIT_L(0); PG8_MMA(0, 0, At, B0); PG8_BAR; PG8_SCHED;
            PG8_LDB(B1, 1, 1); PG8_STAGE(PG8_SB(1, 0), b3, voffB);
            PG8_BAR; PG8_WAIT_L(0); PG8_MMA(0, 1, At, B1); PG8_BAR;
            PG8_LDA(At, 1, 1); PG8_STAGE(PG8_SA(1, 0), a3, voffA);
            PG8_BAR; PG8_WAIT_L(0); PG8_MMA(1, 0, At, B0); PG8_BAR; PG8_SCHED;
            PG8_STAGE(PG8_SB(1, 1), b3 + hstep, voffB);
            PG8_WAIT_V(6); PG8_BAR; PG8_MMA(1, 1, At, B1); PG8_BAR;
            }
        }
        if constexpr (ALIGN_EPI) { if (wr == 0) PG8_BAR; }
        if constexpr (!Epi::AFTER_DRAIN) { E(acc, cur, wr, wc, fr, fq); S.done(cur); }
        if (!has_next) break;
#pragma unroll
        for (int a = 0; a < 2; ++a)
#pragma unroll
            for (int b = 0; b < 2; ++b)
#pragma unroll
                for (int m = 0; m < 4; ++m)
#pragma unroll
                    for (int n = 0; n < 2; ++n) acc[a][b][m][n] = (f32x4){0.f, 0.f, 0.f, 0.f};
        cur = nxt; cA = nA; cB = nB; ++ui;
        if constexpr (ALIGN_EPI) { if (wr == 1) PG8_BAR; }
    }
    PG8_WAIT_V(0);
    if constexpr (!ALIGN_EPI) { if (wr == 0) PG8_BAR; }
    PG8_BAR;
    if constexpr (Epi::AFTER_DRAIN) { E.fused(acc, cur, wr, wc, fr, fq, lds, wid, lane); S.done(cur); }
#undef PG8_SA
#undef PG8_SB
#undef PG8_STAGE
#undef PG8_LDA
#undef PG8_LDB
#undef PG8_MMA
#undef PG8_WAIT_V
#undef PG8_WAIT_L
#undef PG8_BAR
#undef PG8_SCHED
}
}
using pg8::bf16_t; using pg8::bf16x8; using pg8::f32x4; using pg8::u32x4; using pg8::cvt_pk_bf16;
#define GAS __attribute__((address_space(1)))
#define LAS __attribute__((address_space(3)))
typedef float f32x16 __attribute__((ext_vector_type(16)));
typedef float f32x2 __attribute__((ext_vector_type(2)));
typedef unsigned u32x2 __attribute__((ext_vector_type(2)));
typedef GAS unsigned gu32;
#define RLX_AGENT __ATOMIC_RELAXED, __HIP_MEMORY_SCOPE_AGENT
#define LDS_WAIT() asm volatile("s_waitcnt lgkmcnt(0)" ::: "memory")
#define MFMA32(a, b, c) __builtin_amdgcn_mfma_f32_32x32x16_bf16((a), (b), (c), 0, 0, 0)

constexpr int NWAVES = 8, NTHR = 512;
constexpr int BATCH = 4, SEQ = 4096, DM = 1024, DEPTH = 4, M = BATCH * SEQ, NIN = 2832, NP = 3072;
constexpr float EPS = 1e-6f;
constexpr int PC_AVAL = 0, PC_AGLU = 256, PC_AGATE = 512, PC_BQ = 768, PC_BK = 1024, PC_BV = 1152, PC_BGATE = 1280, PC_CX = 1536, PC_CGATE = 1792,
              PC_DQ = 2048, PC_DK = 2176, PC_DV = 2304, PC_DGATE = 2560, PC_DLR = 2816;
__host__ __device__ __forceinline__ int win_remap(int n) { return n < 2560 ? n : (n < 2816 ? n + 16 : (n < 2832 ? n - 256 : -1)); }
constexpr size_t MiB = 1u << 20;
constexpr size_t WS_CTL = 0, CTL_ZERO_BYTES = 1 * MiB;
constexpr size_t WS_WIN = 2 * MiB;
constexpr size_t WS_WOUT = 26 * MiB;
constexpr size_t WS_APW = 34 * MiB;
constexpr size_t WS_WR = WS_APW + 512 * 1024, WS_WI = WS_WR + 128 * 1024;
constexpr size_t WS_SSQ = 35 * MiB;
constexpr size_t WS_XB = 36 * MiB;
constexpr size_t WS_Y = 68 * MiB;
constexpr size_t WS_PROJ = 100 * MiB;
constexpr size_t WS_GC = 200 * MiB;
constexpr size_t WS_GD = 201 * MiB;
constexpr size_t WS_BIAS = 204 * MiB;
constexpr size_t WS_END = 205 * MiB;
constexpr int CW_BAR = 4096;
constexpr int CW_TEAM = 65536;
constexpr int CW_PCNT = 131072;
constexpr int CW_GDONE = CW_PCNT + 64 * 256;
constexpr int CW_Q = 16384;
constexpr int RING_BYTES = 131072, LDSCTL_OFF = RING_BYTES, MISC_OFF = LDSCTL_OFF + 320, LDS_BYTES = 147456;

__device__ __forceinline__ float bf_lo(unsigned w) { return __uint_as_float(w << 16); }
__device__ __forceinline__ float bf_hi(unsigned w) { return __uint_as_float(w & 0xffff0000u); }
__device__ __forceinline__ unsigned f2bf(float f) { unsigned u = __float_as_uint(f); return (u + 0x7fffu + ((u >> 16) & 1u)) >> 16; }
typedef __bf16 bf16v2 __attribute__((ext_vector_type(2)));
__device__ __forceinline__ unsigned pk2(float lo, float hi) { const f32x2 f = {lo, hi}; const bf16v2 b = __builtin_convertvector(f, bf16v2); return __builtin_bit_cast(unsigned, b); }
__device__ __forceinline__ float fexp(float x) { return __builtin_amdgcn_exp2f(x * 1.4426950408889634f); }
__device__ __forceinline__ float frcp(float x) { return __builtin_amdgcn_rcpf(x); }
__device__ __forceinline__ float sigm(float x) { return frcp(1.f + fexp(-x)); }
__device__ __forceinline__ float silu(float x) { return x * sigm(x); }
__device__ __forceinline__ float rsq(float x) { return __builtin_amdgcn_rsqf(x); }
__device__ __forceinline__ float log1p_01(float e) { return __builtin_amdgcn_logf(1.0f + e) * 0.6931471805599453f; }
__device__ __forceinline__ float one_minus_exp(float x) { const float p = -x * (1.0f + x * (0.5f + x * (1.0f / 6.0f + x * (1.0f / 24.0f + x * (1.0f / 120.0f + x * (1.0f / 720.0f)))))); return x > -0.25f ? p : 1.0f - fexp(x); }
__device__ __forceinline__ void unpack8(const u32x4 w, float (&f)[8]) { f[0] = bf_lo(w.x); f[1] = bf_hi(w.x); f[2] = bf_lo(w.y); f[3] = bf_hi(w.y); f[4] = bf_lo(w.z); f[5] = bf_hi(w.z); f[6] = bf_lo(w.w); f[7] = bf_hi(w.w); }
__device__ __forceinline__ u32x4 pack8(const float (&f)[8]) { u32x4 w; w.x = pk2(f[0], f[1]); w.y = pk2(f[2], f[3]); w.z = pk2(f[4], f[5]); w.w = pk2(f[6], f[7]); return w; }
__device__ __forceinline__ bf16x8 as_frag(const u32x4 w) { return __builtin_bit_cast(bf16x8, w); }
__device__ __forceinline__ bf16x8 frag_from_acc(const f32x16& a, int s8) { u32x4 w; w.x = pk2(a[s8 + 0], a[s8 + 1]); w.y = pk2(a[s8 + 2], a[s8 + 3]); w.z = pk2(a[s8 + 4], a[s8 + 5]); w.w = pk2(a[s8 + 6], a[s8 + 7]); return as_frag(w); }
__device__ __forceinline__ float wave_sum(float v) { return xsum32(sum32(v)); }
#define XB_TMO      128
#define XB_XCNT(j)  (256  + 64 * (j))
#define XB_XSUB(j)  (1280 + 64 * (j))
#define XB_XGEN(j)  (2304 + 64 * (j))
#define XB_TOP      3328
#define XB_TOPGEN   3392
#define XCD_BAR_WORDS 3456
#define XB_SPIN_CAP (1u << 18)

__device__ __forceinline__ unsigned xb_ld(unsigned* p)              { return __hip_atomic_load(p, __ATOMIC_RELAXED, __HIP_MEMORY_SCOPE_AGENT); }
__device__ __forceinline__ unsigned xb_add(unsigned* p, unsigned v) { return __hip_atomic_fetch_add(p, v, __ATOMIC_RELAXED, __HIP_MEMORY_SCOPE_AGENT); }
__device__ __forceinline__ unsigned xb_xcc_id() { return (unsigned)__builtin_amdgcn_s_getreg((3 << 11) | 20) & 0xFu; }
#define XB_SPIN(cond, bar) do { unsigned _sp = 0; while (cond) { __builtin_amdgcn_s_sleep(1); \
    if ((++_sp & 255u) == 0u) { if (xb_ld(&(bar)[XB_TMO])) break; if (_sp > XB_SPIN_CAP) { atomicAdd(&(bar)[XB_TMO], 1u); break; } } } } while (0)

struct XcdBarrier {
    unsigned* bar; unsigned x;
    volatile LAS unsigned* st;
};

__device__ __forceinline__ XcdBarrier xcd_barrier_post(unsigned* bar, volatile LAS unsigned* st) {
    XcdBarrier b; b.bar = bar; b.x = xb_xcc_id(); b.st = st;
    if (threadIdx.x == 0) (void)xb_add(&bar[XB_XCNT(b.x)], 1u);
    return b;
}
__device__ __forceinline__ void xcd_barrier_complete(unsigned* bar, unsigned x, unsigned& nloc, unsigned& nx) {
    const unsigned G = gridDim.x * gridDim.y * gridDim.z;
    unsigned sum, cnt, mine, sp = 0u;
    for (;;) {
        sum = 0u; cnt = 0u; mine = 0u;
#pragma unroll
        for (unsigned j = 0; j < 16; ++j) { const unsigned c = xb_ld(&bar[XB_XCNT(j)]); sum += c; cnt += (c > 0u) ? 1u : 0u; mine = (j == x) ? c : mine; }
        if (sum == G) break;
        __builtin_amdgcn_s_sleep(1);
        if ((++sp & 255u) == 0u) { if (xb_ld(&bar[XB_TMO])) break; if (sp > XB_SPIN_CAP) { atomicAdd(&bar[XB_TMO], 1u); break; } }
    }
    nloc = mine > 0u ? mine : 1u; nx = cnt > 0u ? cnt : 1u;
}

__device__ __forceinline__ void xcd_barrier(const XcdBarrier& b) {
    asm volatile("s_waitcnt vmcnt(0)" ::: "memory");
    __syncthreads();
    if (threadIdx.x == 0) {
        unsigned* bar = b.bar;
        __builtin_amdgcn_s_waitcnt(0);
        unsigned nloc = b.st[0], nx = b.st[1];
        if (nloc == 0u) { xcd_barrier_complete(bar, b.x, nloc, nx); b.st[0] = nloc; b.st[1] = nx; }
        const unsigned old = xb_add(&bar[XB_XSUB(b.x)], 1u);
        const unsigned gen = old / nloc;
        if (old + 1u == (gen + 1u) * nloc) {
            __builtin_amdgcn_fence(__ATOMIC_RELEASE, "agent");
            asm volatile("s_waitcnt vmcnt(0)" ::: "memory");
            const unsigned og = xb_add(&bar[XB_TOP], 1u);
            const unsigned tg = og / nx;
            if (og + 1u == (tg + 1u) * nx) xb_add(&bar[XB_TOPGEN], 1u);
            else XB_SPIN(xb_ld(&bar[XB_TOPGEN]) == tg, bar);
            __builtin_amdgcn_fence(__ATOMIC_ACQUIRE, "agent");
            xb_add(&bar[XB_XGEN(b.x)], 1u);
            asm volatile("s_waitcnt vmcnt(0)" ::: "memory");
        } else {
            XB_SPIN(xb_ld(&bar[XB_XGEN(b.x)]) == gen, bar);
            __builtin_amdgcn_fence(__ATOMIC_ACQUIRE, "agent");
            asm volatile("s_waitcnt vmcnt(0)" ::: "memory");
        }
    }
    __syncthreads();
}
template <int S8> __device__ __forceinline__ bf16x8 frag_acc(const f32x16& a) { u32x4 w; w.x = pk2(a[S8 + 0], a[S8 + 1]); w.y = pk2(a[S8 + 2], a[S8 + 3]); w.z = pk2(a[S8 + 4], a[S8 + 5]); w.w = pk2(a[S8 + 6], a[S8 + 7]); return as_frag(w); }

struct Args { const float* in[23]; float* out; unsigned char* ws; };
typedef __attribute__((address_space(4))) const Args CArgs;
__device__ __forceinline__ CArgs* get_args() { CArgs* p = (CArgs*)__builtin_amdgcn_kernarg_segment_ptr(); asm volatile("" : "+s"(p)); return p; }
enum { I_X = 0, I_NORM_G, I_W_IN, I_A_CONV_W, I_A_CONV_B, I_A_LN_G, I_A_LN_B, I_A_PW, I_B_Q_G, I_B_K_G, I_B_SINKS, I_REL_BIAS, I_C_CONV_W, I_C_CONV_B, I_C_W_R, I_C_B_R, I_C_W_I, I_C_B_I, I_C_LAMBDA, I_D_W_UP, I_D_B_UP, I_D_NORM_G, I_W_OUT };
struct Frame { LAS unsigned char* lds; volatile LAS unsigned* MISC; int tid, lane, wave, G; };
#define WSP(T, off) ((T*)(A->ws + (off)))

template <bool REMAP>
__device__ __forceinline__ void transpose_item(const float* W, int ldw, const float* gk, bf16_t* WT, int ldt, int k0, int n0, LAS float* scr, int lane) {
    const int nn = n0 + (lane & 31); const int col = REMAP ? win_remap(nn) : nn, colc = col < 0 ? 0 : col;
    const float* wp = W + (size_t)(k0 + (lane >> 5)) * ldw + colc;
    float v[32];
#pragma unroll
    for (int i = 0; i < 32; ++i) v[i] = wp[(size_t)(2 * i) * ldw];
    const int c = lane & 7;
    f32x4 g0 = (f32x4){1.f, 1.f, 1.f, 1.f}, g1 = g0; if (gk) { g0 = *(const f32x4*)(gk + k0 + 8 * c); g1 = *(const f32x4*)(gk + k0 + 8 * c + 4); }
#pragma unroll
    for (int i = 0; i < 32; ++i) scr[(2 * i + (lane >> 5)) * 33 + (lane & 31)] = col < 0 ? 0.f : v[i];
    LDS_WAIT(); asm volatile("" ::: "memory");
#pragma unroll
    for (int j = 0; j < 4; ++j) { const int n = (lane >> 3) + 8 * j; const LAS float* s = scr + (8 * c) * 33 + n;
        u32x4 o; o.x = pk2(s[0 * 33] * g0.x, s[1 * 33] * g0.y); o.y = pk2(s[2 * 33] * g0.z, s[3 * 33] * g0.w); o.z = pk2(s[4 * 33] * g1.x, s[5 * 33] * g1.y); o.w = pk2(s[6 * 33] * g1.z, s[7 * 33] * g1.w);
        *(u32x4*)(WT + (size_t)(n0 + n) * ldt + k0 + 8 * c) = o; }
    LDS_WAIT(); asm volatile("" ::: "memory");
}
constexpr int I_IN = 16 * 96, I_OUT = 16 * 32, I_PW = 4 * 8, I_G = 4 * 2, I_L = I_IN + I_OUT + I_PW + 2 * I_G;
__device__ __forceinline__ void convert_item(Frame& F, int l, int r) {
    CArgs* A = get_args(); const float* norm_g = A->in[I_NORM_G]; const float* w_in = A->in[I_W_IN]; const float* a_pw = A->in[I_A_PW]; const float* c_w_r = A->in[I_C_W_R]; const float* c_w_i = A->in[I_C_W_I]; const float* w_out = A->in[I_W_OUT];
    bf16_t* WtIn = WSP(bf16_t, WS_WIN); bf16_t* WtOut = WSP(bf16_t, WS_WOUT); bf16_t* ApwT = WSP(bf16_t, WS_APW); bf16_t* WrT = WSP(bf16_t, WS_WR); bf16_t* WiT = WSP(bf16_t, WS_WI);
    LAS float* scr = (LAS float*)(F.lds + F.wave * 16384);
    if (r < I_IN) { const int kb = r / 96, nb = r % 96; transpose_item<true>(w_in + (size_t)l * DM * NIN, NIN, norm_g + l * DM, WtIn + (size_t)l * NP * DM, DM, 64 * kb, 32 * nb, scr, F.lane); return; } r -= I_IN;
    if (r < I_OUT) { const int kb = r / 32, nb = r % 32; transpose_item<false>(w_out + (size_t)l * DM * DM, DM, nullptr, WtOut + (size_t)l * DM * DM, DM, 64 * kb, 32 * nb, scr, F.lane); return; } r -= I_OUT;
    if (r < I_PW) { const int kb = r / 8, nb = r % 8; transpose_item<false>(a_pw + (size_t)l * 65536, 256, nullptr, ApwT + (size_t)l * 65536, 256, 64 * kb, 32 * nb, scr, F.lane); return; } r -= I_PW;
    if (r < I_G) { const int blk = r / 2, nb = r % 2; transpose_item<false>(c_w_r + (size_t)(l * 4 + blk) * 4096, 64, nullptr, WrT + (size_t)(l * 4 + blk) * 4096, 64, 0, 32 * nb, scr, F.lane); return; } r -= I_G;
    { const int blk = r / 2, nb = r % 2; transpose_item<false>(c_w_i + (size_t)(l * 4 + blk) * 4096, 64, nullptr, WiT + (size_t)(l * 4 + blk) * 4096, 64, 0, 32 * nb, scr, F.lane); }
}
__device__ __forceinline__ void p0_prologue(Frame& F) {
    CArgs* A = get_args(); const float* x = A->in[I_X]; bf16_t* XB = WSP(bf16_t, WS_XB); float* SSQ = WSP(float, WS_SSQ);
    const int gw = blockIdx.x * NWAVES + F.wave, NGW = F.G * NWAVES;
    for (int it = gw; it < I_L; it += NGW) convert_item(F, 0, it);
    { const float* rel_bias = A->in[I_REL_BIAS]; float* BT = WSP(float, WS_BIAS);
      for (int i = gw * 64 + F.lane; i < 4 * 5 * 16 * 64; i += NGW * 64) { const int e = i & 3, ln = (i >> 2) & 63, q4 = (i >> 8) & 3, kt = (i >> 10) % 5, hd = (i >> 10) / 5;
          const int dist = (ln & 31) - (e + 8 * q4) - 4 * (ln >> 5) + 128 - 32 * kt; float v = -INFINITY;
          if (dist >= 0 && dist < 128) { int bucket = dist; if (dist >= 16) { bucket = 16 + (int)(logf((float)dist / 16.0f) / 2.0794415416798357f * 16.0f); bucket = bucket < 31 ? bucket : 31; } v = rel_bias[bucket * 4 + hd]; }
          BT[i] = v; } }
    for (int m = gw; m < M; m += 2 * NGW) {
        const f32x4* xr0 = (const f32x4*)(x + (size_t)m * DM) + F.lane; const int m1 = (m + NGW < M) ? m + NGW : m; const f32x4* xr1 = (const f32x4*)(x + (size_t)m1 * DM) + F.lane; f32x4 v0[4], v1[4]; float s0 = 0.f, s1 = 0.f;
#pragma unroll
        for (int j = 0; j < 4; ++j) { v0[j] = xr0[64 * j]; v1[j] = xr1[64 * j]; }
#pragma unroll
        for (int j = 0; j < 4; ++j) { s0 += (v0[j].x * v0[j].x + v0[j].y * v0[j].y) + (v0[j].z * v0[j].z + v0[j].w * v0[j].w); s1 += (v1[j].x * v1[j].x + v1[j].y * v1[j].y) + (v1[j].z * v1[j].z + v1[j].w * v1[j].w); }
        s0 = wave_sum(s0); s1 = wave_sum(s1);
        u32x2* o0 = (u32x2*)(XB + (size_t)m * DM) + F.lane; u32x2* o1 = (u32x2*)(XB + (size_t)m1 * DM) + F.lane;
#pragma unroll
        for (int j = 0; j < 4; ++j) { u32x2 w; w.x = pk2(v0[j].x, v0[j].y); w.y = pk2(v0[j].z, v0[j].w); o0[64 * j] = w; w.x = pk2(v1[j].x, v1[j].y); w.y = pk2(v1[j].z, v1[j].w); o1[64 * j] = w; }
        if (F.lane < 16) { SSQ[(size_t)m * 16 + F.lane] = (F.lane == 0) ? s0 : 0.f; SSQ[(size_t)m1 * 16 + F.lane] = (F.lane == 0) ? s1 : 0.f; }
    }
}

constexpr int A_TA = 64, A_ROWS = A_TA + 30, A_S_OFF = A_ROWS * 512, A_S_STRIDE = 528;
__device__ __forceinline__ void mixer_a(Frame& F, int l, int unit) {
    CArgs* A = get_args(); const float* a_conv_w = A->in[I_A_CONV_W]; const float* a_conv_b = A->in[I_A_CONV_B]; const float* a_ln_g = A->in[I_A_LN_G]; const float* a_ln_b = A->in[I_A_LN_B]; bf16_t* ApwT = WSP(bf16_t, WS_APW); bf16_t* Y = WSP(bf16_t, WS_Y); bf16_t* PROJ = WSP(bf16_t, WS_PROJ);
    LAS unsigned char* lds = F.lds; const int tid = F.tid, lane = F.lane, w = F.wave;
    const int b = unit >> 6, t0 = (unit & 63) * A_TA; const size_t m0 = (size_t)b * SEQ + t0;
    const int pA = tid & 127, tgA = tid >> 7, c0A = 2 * pA;
    float w0[31], w1[31];
#pragma unroll
    for (int j = 0; j < 31; ++j) { const f32x2 ww = *(const f32x2*)(a_conv_w + ((size_t)l * 31 + j) * 256 + c0A); w0[j] = ww.x; w1[j] = ww.y; }
    const f32x2 cb = *(const f32x2*)(a_conv_b + l * 256 + c0A), lg = *(const f32x2*)(a_ln_g + l * 256 + c0A), lb = *(const f32x2*)(a_ln_b + l * 256 + c0A);
    { u32x4 vw[6], gw[6];
#pragma unroll
      for (int k = 0; k < 6; ++k) { const int it = tid + k * NTHR, itc = it < A_ROWS * 32 ? it : A_ROWS * 32 - 1, r = itc >> 5, p = itc & 31, tok = t0 + r - 30, tokc = tok < 0 ? 0 : tok;
          const bf16_t* rp = PROJ + ((size_t)b * SEQ + tokc) * NP + 8 * p; vw[k] = *(const u32x4*)(rp + PC_AVAL); gw[k] = *(const u32x4*)(rp + PC_AGLU); }
#pragma unroll
      for (int k = 0; k < 6; ++k) { const int it = tid + k * NTHR, r = it >> 5, p = it & 31, tok = t0 + r - 30;
          float v[8], g[8]; unpack8(vw[k], v); unpack8(gw[k], g);
#pragma unroll
          for (int j = 0; j < 8; ++j) v[j] = tok < 0 ? 0.f : v[j] * sigm(g[j]);
          if (it < A_ROWS * 32) *(LAS u32x4*)(lds + r * 512 + p * 16) = pack8(v); } }
    __syncthreads();
    bf16x8 af[16];
    { const bf16_t* ap = ApwT + (size_t)l * 65536 + (size_t)(32 * w + (lane & 31)) * 256 + 8 * (lane >> 5);
#pragma unroll
      for (int ks = 0; ks < 16; ++ks) af[ks] = *(const bf16x8*)(ap + 16 * ks); }
    { const int p = pA, tg = tgA;
#pragma unroll 1
      for (int blk = 0; blk < 2; ++blk) { const int base = 16 * tg + 8 * blk;
        f32x2 in[38];
#pragma unroll
        for (int i = 0; i < 38; ++i) { const unsigned wv = *(const LAS unsigned*)(lds + (base + i) * 512 + p * 4); in[i] = (f32x2){bf_lo(wv), bf_hi(wv)}; }
        f32x2 acc[8];
#pragma unroll
        for (int o = 0; o < 8; ++o) acc[o] = cb;
#pragma unroll
        for (int j = 0; j < 31; ++j) { const f32x2 wj = {w0[j], w1[j]};
#pragma unroll
            for (int o = 0; o < 8; ++o) acc[o] = __builtin_elementwise_fma(wj, in[o + j], acc[o]); }
        float sv[8], qv[8];
#pragma unroll
        for (int o = 0; o < 8; ++o) { sv[o] = acc[o].x + acc[o].y; qv[o] = acc[o].x * acc[o].x + acc[o].y * acc[o].y; }
#pragma unroll
        for (int o = 0; o < 8; ++o) { sv[o] = sum32(sv[o]); qv[o] = sum32(qv[o]); }
#pragma unroll
        for (int o = 0; o < 8; ++o) { const float mean = sv[o] * (1.f / 64.f), var = fmaxf(qv[o] * (1.f / 64.f) - mean * mean, 0.f), rstd = rsq(var + EPS);
            const float v0 = (acc[o].x - mean) * rstd * lg.x + lb.x, v1 = (acc[o].y - mean) * rstd * lg.y + lb.y;
            *(LAS unsigned*)(lds + A_S_OFF + (base + o) * A_S_STRIDE + p * 4) = pk2(silu(v0), silu(v1)); } } }
    __syncthreads();
    { const int r = lane & 31, h = lane >> 5;
      u32x2 gwA[2][4];
#pragma unroll
      for (int tt = 0; tt < 2; ++tt)
#pragma unroll
          for (int g4 = 0; g4 < 4; ++g4) gwA[tt][g4] = *(const u32x2*)(PROJ + (m0 + 32 * tt + r) * NP + PC_AGATE + 32 * w + 8 * g4 + 4 * h);
      f32x16 acc[2];
#pragma unroll
      for (int tt = 0; tt < 2; ++tt) { acc[tt] = (f32x16)(0.f);
#pragma unroll
          for (int ks = 0; ks < 16; ++ks) { const bf16x8 bfr = *(const LAS bf16x8*)(lds + A_S_OFF + (32 * tt + r) * A_S_STRIDE + (16 * ks + 8 * h) * 2); acc[tt] = MFMA32(af[ks], bfr, acc[tt]); } }
#pragma unroll
      for (int tt = 0; tt < 2; ++tt) { const size_t tok = m0 + 32 * tt + r;
#pragma unroll
          for (int g4 = 0; g4 < 4; ++g4) { const int n = 32 * w + 8 * g4 + 4 * h; const u32x2 gw = gwA[tt][g4];
              u32x2 o; o.x = pk2(acc[tt][4 * g4 + 0] * silu(bf_lo(gw.x)), acc[tt][4 * g4 + 1] * silu(bf_hi(gw.x))); o.y = pk2(acc[tt][4 * g4 + 2] * silu(bf_lo(gw.y)), acc[tt][4 * g4 + 3] * silu(bf_hi(gw.y)));
              *(u32x2*)(Y + tok * DM + n) = o; } } }
    __syncthreads();
}

constexpr int B_VT_OFF = 256 * 144, B_VT_STRIDE = 536;
__device__ __forceinline__ void mixer_b(Frame& F, int l, int unit) {
    CArgs* A = get_args(); const float* b_q_g = A->in[I_B_Q_G]; const float* b_k_g = A->in[I_B_K_G]; const float* b_sinks = A->in[I_B_SINKS]; bf16_t* Y = WSP(bf16_t, WS_Y); bf16_t* PROJ = WSP(bf16_t, WS_PROJ);
    LAS unsigned char* lds = F.lds; const int tid = F.tid, lane = F.lane, w = F.wave;
    const int b = unit >> 6, qb = (unit >> 1) & 31, kvh = unit & 1, t0 = qb * 128;
    { float kg[8]; const int pc = tid & 7;
#pragma unroll
      for (int j = 0; j < 8; ++j) kg[j] = b_k_g[l * 64 + 8 * pc + j];
#pragma unroll
      for (int it = 0; it < 4; ++it) { const int i = it * NTHR + tid, key = i >> 3, tok = t0 - 128 + key; u32x4 kw = (u32x4){0u, 0u, 0u, 0u}, vw = kw;
        { const int tokc = tok < 0 ? 0 : tok; const bf16_t* rp = PROJ + ((size_t)b * SEQ + tokc) * NP + kvh * 64 + 8 * pc; kw = *(const u32x4*)(rp + PC_BK); vw = *(const u32x4*)(rp + PC_BV);
          if (tok < 0) { kw = (u32x4){0u, 0u, 0u, 0u}; vw = kw; } }
        float kf[8]; unpack8(kw, kf); float ss = 0.f;
#pragma unroll
        for (int j = 0; j < 8; ++j) ss = fmaf(kf[j], kf[j], ss);
        ss = sum8(ss);
        const float rs = rsq(ss * (1.f / 64.f) + EPS);
#pragma unroll
        for (int j = 0; j < 8; ++j) kf[j] = kf[j] * rs * kg[j];
        *(LAS u32x4*)(lds + key * 144 + pc * 16) = pack8(kf);
        const unsigned vv[4] = {vw.x, vw.y, vw.z, vw.w};
#pragma unroll
        for (int j = 0; j < 8; ++j) *(LAS bf16_t*)(lds + B_VT_OFF + (8 * pc + j) * B_VT_STRIDE + key * 2) = (bf16_t)((vv[j >> 1] >> (16 * (j & 1))) & 0xffffu); } }
    const int g = w >> 2, s = w & 3, head = 2 * kvh + g, r = lane & 31, h = lane >> 5;
    const size_t tokq = (size_t)b * SEQ + t0 + 32 * s + r;
    bf16x8 qf[4];
    { float q[32]; const bf16_t* qrow = PROJ + tokq * NP + PC_BQ + head * 64 + 8 * h; float ss = 0.f;
#pragma unroll
      for (int ks = 0; ks < 4; ++ks) { const u32x4 wv = *(const u32x4*)(qrow + 16 * ks); float t8[8]; unpack8(wv, t8);
#pragma unroll
          for (int j = 0; j < 8; ++j) { q[8 * ks + j] = t8[j]; ss = fmaf(t8[j], t8[j], ss); } }
      ss = xsum32(ss);
      const float rs = rsq(ss * (1.f / 64.f) + EPS) * 0.125f;
#pragma unroll
      for (int ks = 0; ks < 4; ++ks) { float t8[8];
#pragma unroll
          for (int j = 0; j < 8; ++j) t8[j] = q[8 * ks + j] * rs * b_q_g[l * 64 + 16 * ks + 8 * h + j];
          qf[ks] = as_frag(pack8(t8)); } }
    u32x2 gwB[2][4];
#pragma unroll
    for (int et = 0; et < 2; ++et)
#pragma unroll
        for (int g4 = 0; g4 < 4; ++g4) gwB[et][g4] = *(const u32x2*)(PROJ + tokq * NP + PC_BGATE + head * 64 + 32 * et + 8 * g4 + 4 * h);
    f32x16 S[5];
    { const f32x4* bt = (const f32x4*)(WSP(float, WS_BIAS)) + (size_t)head * 5 * 4 * 64 + lane;
#pragma unroll
      for (int kt = 0; kt < 5; ++kt)
#pragma unroll
          for (int q4 = 0; q4 < 4; ++q4) { const f32x4 v = bt[(kt * 4 + q4) * 64]; S[kt][4 * q4 + 0] = v.x; S[kt][4 * q4 + 1] = v.y; S[kt][4 * q4 + 2] = v.z; S[kt][4 * q4 + 3] = v.w; } }
    __syncthreads();
#pragma unroll
    for (int kt = 0; kt < 5; ++kt) { const int kb = 32 * (s + kt);
#pragma unroll
        for (int ks = 0; ks < 4; ++ks) { const bf16x8 a = *(const LAS bf16x8*)(lds + (kb + r) * 144 + (16 * ks + 8 * h) * 2); S[kt] = MFMA32(a, qf[ks], S[kt]); } }
    const float sink = b_sinks[l * 4 + head]; float mx = sink;
#pragma unroll
    for (int kt = 0; kt < 5; ++kt) { const bool dead = (t0 == 0) && (s + kt < 4);
#pragma unroll
        for (int rg = 0; rg < 16; ++rg) { const float v = dead ? -INFINITY : S[kt][rg]; S[kt][rg] = v; mx = fmaxf(mx, v); } }
    mx = xmax32(mx);
    float sum = 0.f;
#pragma unroll
    for (int kt = 0; kt < 5; ++kt)
#pragma unroll
        for (int rg = 0; rg < 16; ++rg) { const float p = fexp(S[kt][rg] - mx); S[kt][rg] = p; sum += p; }
    sum = xsum32(sum);
    const float inv = 1.0f / (sum + fexp(sink - mx));
    f32x16 O[2]; O[0] = (f32x16)(0.f); O[1] = (f32x16)(0.f);
#define B_PV(kt, SP) do { const bf16x8 pf = frag_acc<8 * SP>(S[kt]); const int kb = 32 * (s + kt) + 16 * SP + 4 * h; \
        _Pragma("unroll") for (int et = 0; et < 2; ++et) { const LAS unsigned char* vp = lds + B_VT_OFF + (32 * et + r) * B_VT_STRIDE + kb * 2; \
            const u32x2 lo = *(const LAS u32x2*)vp, hi = *(const LAS u32x2*)(vp + 16); O[et] = MFMA32(as_frag((u32x4){lo.x, lo.y, hi.x, hi.y}), pf, O[et]); } } while (0)
#pragma unroll
    for (int kt = 0; kt < 5; ++kt) { B_PV(kt, 0); B_PV(kt, 1); }
#undef B_PV
#pragma unroll
    for (int et = 0; et < 2; ++et)
#pragma unroll
        for (int g4 = 0; g4 < 4; ++g4) { const int d = 32 * et + 8 * g4 + 4 * h; const u32x2 gw = gwB[et][g4];
            u32x2 o; o.x = pk2(O[et][4 * g4 + 0] * inv * silu(bf_lo(gw.x)), O[et][4 * g4 + 1] * inv * silu(bf_hi(gw.x))); o.y = pk2(O[et][4 * g4 + 2] * inv * silu(bf_lo(gw.y)), O[et][4 * g4 + 3] * inv * silu(bf_hi(gw.y)));
            *(u32x2*)(Y + tokq * DM + 256 + head * 64 + d) = o; }
    __syncthreads();
}
constexpr int C_AA = 128 * 144, C_UU = C_AA + 64 * 129 * 4, C_SEG = C_UU + 64 * 129 * 4, C_CARRY = C_SEG + 8192, C_CST = C_CARRY + 512, C_LOOK = C_CST + 1024;
constexpr unsigned SPIN_CAP = 1u << 16;
__device__ __forceinline__ void gr_store(unsigned long long* g, unsigned tag, float v) { __hip_atomic_store(g, ((unsigned long long)tag << 32) | (unsigned long long)__float_as_uint(v), __ATOMIC_RELAXED, __HIP_MEMORY_SCOPE_AGENT); }
__device__ __forceinline__ unsigned long long gr_load(const unsigned long long* g) { return __hip_atomic_load(g, __ATOMIC_RELAXED, __HIP_MEMORY_SCOPE_AGENT); }
__device__ __forceinline__ void mixer_c(Frame& F, int l, int unit, unsigned* qh, unsigned& nxt) {
    CArgs* A = get_args(); const float* c_conv_w = A->in[I_C_CONV_W]; const float* c_conv_b = A->in[I_C_CONV_B]; const float* c_b_r = A->in[I_C_B_R]; const float* c_b_i = A->in[I_C_B_I]; const float* c_lambda = A->in[I_C_LAMBDA]; bf16_t* WrT = WSP(bf16_t, WS_WR); bf16_t* WiT = WSP(bf16_t, WS_WI); bf16_t* Y = WSP(bf16_t, WS_Y); bf16_t* PROJ = WSP(bf16_t, WS_PROJ);
    unsigned long long* GC = WSP(unsigned long long, WS_GC);
    LAS unsigned char* lds = F.lds; const int tid = F.tid, lane = F.lane, w = F.wave;
    const int pair = unit >> 4, b = (unit >> 2) & 3, n = unit & 3; const unsigned tag = (unsigned)l + 1u;
    LAS float* Aa = (LAS float*)(lds + C_AA); LAS float* Uu = (LAS float*)(lds + C_UU); LAS float* SegX = (LAS float*)(lds + C_SEG); LAS float* Carry = (LAS float*)(lds + C_CARRY); LAS float* Cst = (LAS float*)(lds + C_CST); LAS float* LookY = (LAS float*)(lds + C_LOOK);
    const int pc = tid & 7, trow = tid >> 3;
    const int tt = w & 3, mt = w >> 2, r = lane & 31, h = lane >> 5;
    const int sc = tid & 63, seg = tid >> 6;
    u32x4 xin[2][2][4];
#pragma unroll
    for (int hf = 0; hf < 2; ++hf)
#pragma unroll
        for (int it = 0; it < 2; ++it) { const int tok = 128 * (2 * pair + hf) + trow + 64 * it; const bf16_t* rp = PROJ + (size_t)b * SEQ * NP + 64 * n + 8 * pc;
#pragma unroll
            for (int jj = 0; jj < 4; ++jj) { const int tk = tok - 3 + jj, tkc = tk < 0 ? 0 : tk; xin[hf][it][jj] = *(const u32x4*)(rp + (size_t)tkc * NP + PC_CX); } }
    if (tid < 64) { const int cg = l * 256 + 64 * n + tid;
        Cst[4 * tid + 0] = c_b_r[cg]; Cst[4 * tid + 1] = c_b_i[cg]; Cst[4 * tid + 2] = -8.0f * log1pf(expf(-c_lambda[cg])); Cst[4 * tid + 3] = 0.f; }
    bf16x8 wrf[4], wif[4];
#pragma unroll
    for (int ks = 0; ks < 4; ++ks) { const size_t o = ((size_t)(l * 4 + n) * 64 + 32 * mt + r) * 64 + 16 * ks + 8 * h; wrf[ks] = *(const bf16x8*)(WrT + o); wif[ks] = *(const bf16x8*)(WiT + o); }
    unsigned long long* gbase = GC + ((size_t)((b * 4 + n) * 32) * 128) + 2 * lane;
    float a[2][16], u[2][16];
#pragma unroll
    for (int hf = 0; hf < 2; ++hf) { const int tile = 2 * pair + hf, t0 = tile * 128; LAS float* Seg = SegX + 1024 * hf;
        float cw[4][8], cb[8];
#pragma unroll
        for (int j = 0; j < 8; ++j) { cb[j] = c_conv_b[l * 256 + 64 * n + 8 * pc + j];
#pragma unroll
            for (int jj = 0; jj < 4; ++jj) cw[jj][j] = c_conv_w[((size_t)l * 4 + jj) * 256 + 64 * n + 8 * pc + j]; }
#pragma unroll
        for (int it = 0; it < 2; ++it) { const int t = trow + 64 * it, tok = t0 + t; float acc[8];
#pragma unroll
            for (int j = 0; j < 8; ++j) acc[j] = cb[j];
#pragma unroll
            for (int jj = 0; jj < 4; ++jj) { float x8[8]; unpack8(xin[hf][it][jj], x8); const float m = (tok - 3 + jj) < 0 ? 0.f : 1.f;
#pragma unroll
                for (int j = 0; j < 8; ++j) acc[j] = fmaf(cw[jj][j] * m, x8[j], acc[j]); }
            *(LAS u32x4*)(lds + t * 144 + pc * 16) = pack8(acc); }
        __syncthreads();
        { f32x16 R = (f32x16)(0.f), I = (f32x16)(0.f);
#pragma unroll
          for (int ks = 0; ks < 4; ++ks) { const bf16x8 bfr = *(const LAS bf16x8*)(lds + (32 * tt + r) * 144 + (16 * ks + 8 * h) * 2); R = MFMA32(wrf[ks], bfr, R); I = MFMA32(wif[ks], bfr, I); }
          const int t = 32 * tt + r;
#pragma unroll
          for (int g4 = 0; g4 < 4; ++g4) { const int c0 = 32 * mt + 8 * g4 + 4 * h; const u32x2 xw = *(const LAS u32x2*)(lds + t * 144 + c0 * 2);
              const float xc[4] = {bf_lo(xw.x), bf_hi(xw.x), bf_lo(xw.y), bf_hi(xw.y)};
#pragma unroll
              for (int j = 0; j < 4; ++j) { const f32x4 cs = *(const LAS f32x4*)(Cst + 4 * (c0 + j));
                  const float rr = sigm(R[4 * g4 + j] + cs.x), ii = sigm(I[4 * g4 + j] + cs.y), la = cs.z * rr, av = fexp(la), uv = __builtin_amdgcn_sqrtf(fmaxf(one_minus_exp(2.0f * la), 0.f)) * (ii * xc[j]);
                  Aa[(c0 + j) * 129 + t] = av; Uu[(c0 + j) * 129 + t] = uv; }
              __builtin_amdgcn_sched_barrier(0); } }
        __syncthreads();
        { float Ap = 1.f, Hp = 0.f;
#pragma unroll
          for (int i = 0; i < 16; ++i) { a[hf][i] = Aa[sc * 129 + 16 * seg + i]; u[hf][i] = Uu[sc * 129 + 16 * seg + i]; }
#pragma unroll
          for (int i = 0; i < 16; ++i) { Hp = fmaf(a[hf][i], Hp, u[hf][i]); Ap *= a[hf][i]; }
          Seg[(seg * 64 + sc) * 2] = Ap; Seg[(seg * 64 + sc) * 2 + 1] = Hp; }
        __syncthreads();
        if (w == 0) { float At = 1.f, Ht = 0.f;
#pragma unroll
            for (int s2 = 0; s2 < 8; ++s2) { const float As = Seg[(s2 * 64 + lane) * 2], Hs = Seg[(s2 * 64 + lane) * 2 + 1]; Ht = fmaf(As, Ht, Hs); At *= As; }
            gr_store(gbase + (size_t)tile * 128, tag, At); gr_store(gbase + (size_t)tile * 128 + 1, tag, Ht); }
    }
    { const int tile = 2 * pair; float Aw = 1.f, Hw = 0.f; const int p0 = 4 * w;
      if (p0 < tile) { unsigned long long ga[4], gh[4]; unsigned spins = 0;
          for (;;) { bool ok = true;
#pragma unroll
              for (int k = 0; k < 4; ++k) { const int p = (p0 + k < tile) ? p0 + k : tile - 1; ga[k] = gr_load(gbase + (size_t)p * 128); gh[k] = gr_load(gbase + (size_t)p * 128 + 1);
                  ok = ok && ((unsigned)(ga[k] >> 32) == tag) && ((unsigned)(gh[k] >> 32) == tag); }
              if (__all(ok) || ++spins > SPIN_CAP) break;
              __builtin_amdgcn_s_sleep(2); }
#pragma unroll
          for (int k = 0; k < 4; ++k) if (p0 + k < tile) { const float Ap = __uint_as_float((unsigned)ga[k]), Hp = __uint_as_float((unsigned)gh[k]); Hw = fmaf(Ap, Hw, Hp); Aw *= Ap; } }
      LookY[(w * 64 + lane) * 2] = Aw; LookY[(w * 64 + lane) * 2 + 1] = Hw; }
    __syncthreads();
    if (tid == 0) nxt = __hip_atomic_fetch_add(qh, 1u, __ATOMIC_RELAXED, __HIP_MEMORY_SCOPE_AGENT);
#pragma unroll
    for (int hf = 0; hf < 2; ++hf) { const int t0 = (2 * pair + hf) * 128; const LAS float* Seg = SegX + 1024 * hf;
        u32x4 gwC[2];
#pragma unroll
        for (int it = 0; it < 2; ++it) gwC[it] = *(const u32x4*)(PROJ + ((size_t)b * SEQ + t0 + trow + 64 * it) * NP + PC_CGATE + 64 * n + 8 * pc);
        { float hh = 0.f;
          if (hf == 0) {
#pragma unroll
              for (int w2 = 0; w2 < 8; ++w2) hh = fmaf(LookY[(w2 * 64 + sc) * 2], hh, LookY[(w2 * 64 + sc) * 2 + 1]);
          } else hh = Carry[sc];
          for (int s2 = 0; s2 < seg; ++s2) hh = fmaf(Seg[(s2 * 64 + sc) * 2], hh, Seg[(s2 * 64 + sc) * 2 + 1]);
#pragma unroll
          for (int i = 0; i < 16; ++i) { hh = fmaf(a[hf][i], hh, u[hf][i]); Uu[sc * 129 + 16 * seg + i] = hh; }
          if (hf == 0 && seg == 7) Carry[sc] = hh; }
        __syncthreads();
#pragma unroll
        for (int it = 0; it < 2; ++it) { const int t = trow + 64 * it; const size_t tokg = (size_t)b * SEQ + t0 + t;
            float g8[8], y8[8]; unpack8(gwC[it], g8);
#pragma unroll
            for (int j = 0; j < 8; ++j) y8[j] = Uu[(8 * pc + j) * 129 + t] * silu(g8[j]);
            *(u32x4*)(Y + tokg * DM + 512 + 64 * n + 8 * pc) = pack8(y8); }
        if (hf == 0) __syncthreads();
    }
    __syncthreads();
}

typedef short s16x4 __attribute__((ext_vector_type(4)));
__device__ __forceinline__ u32x2 tr_read4(const LAS unsigned char* p) { const s16x4 v = __builtin_amdgcn_ds_read_tr16_b64_v4i16((LAS s16x4*)p); return __builtin_bit_cast(u32x2, v); }

constexpr int D_WAVE = 14464, D_VT = 5120, D_DEC = 14336, D_SST = 8 * D_WAVE, D_SIN = D_SST  , D_PDL = D_SST + 8192;
static_assert(D_PDL + 128 <= RING_BYTES, "mixer D LDS map");
constexpr int GD_STRIDE = 2112;
__device__ __forceinline__ void mixer_d(Frame& F, int l, int unit) {
    CArgs* A = get_args(); const float* d_w_up = A->in[I_D_W_UP]; const float* d_b_up = A->in[I_D_B_UP]; const float* d_norm_g = A->in[I_D_NORM_G]; bf16_t* Y = WSP(bf16_t, WS_Y); bf16_t* PROJ = WSP(bf16_t, WS_PROJ);
    unsigned long long* GD = WSP(unsigned long long, WS_GD);
    const int tid = F.tid, lane = F.lane, w = F.wave;
    const int grp = unit >> 4, b = (unit >> 2) & 3, head = unit & 3, r = lane & 31, h = lane >> 5; const unsigned tag = (unsigned)l + 1u;
    LAS unsigned char* scr = F.lds + w * D_WAVE; LAS unsigned char* VT = scr + D_VT; LAS float* Dec = (LAS float*)(scr + D_DEC); LAS f32x4* Sst = (LAS f32x4*)(F.lds + D_SST); LAS f32x4* Sin = (LAS f32x4*)(F.lds + D_SIN); LAS float* Pdl = (LAS float*)(F.lds + D_PDL);
    bf16x8 wupf; { float t8[8];
#pragma unroll
        for (int j = 0; j < 8; ++j) t8[j] = d_w_up[((size_t)l * 16 + 8 * h + j) * 128 + 32 * head + r];
        wupf = as_frag(pack8(t8)); }
    const float bup = d_b_up[l * 128 + 32 * head + r];
    Sst[tid] = (f32x4){0.f, 0.f, 0.f, 0.f}; if (tid < 32) Pdl[tid] = 1.f;
    __syncthreads();
    const int chunk = 8 * grp + w; const size_t mrow0 = (size_t)b * SEQ + 64 * chunk;
    float qv[32], kv[32], bb[32];
    f32x16 G[2];
#pragma unroll
    for (int tile = 0; tile < 2; ++tile) { const bf16x8 lrf = *(const bf16x8*)(PROJ + (mrow0 + 32 * tile + r) * NP + PC_DLR + 8 * h); G[tile] = MFMA32(lrf, wupf, (f32x16)(0.f)); }
    { const bf16_t* qbase = PROJ + mrow0 * NP + PC_DQ + 32 * head; const unsigned loff = (unsigned)(4 * h * NP + r);
#pragma unroll
      for (int i = 0; i < 32; ++i) { const unsigned o = loff + (unsigned)((32 * (i >> 4) + 8 * ((i >> 2) & 3) + (i & 3)) * NP);
          qv[i] = __uint_as_float((unsigned)qbase[o] << 16); kv[i] = __uint_as_float((unsigned)qbase[o + (PC_DK - PC_DQ)] << 16); } }
    float run = 0.f;
#pragma unroll
    for (int k = 0; k < 8; ++k) { float c[4];
#pragma unroll
        for (int j = 0; j < 4; ++j) { const float z = G[k >> 2][4 * (k & 3) + j] + bup; const float gl = -(fmaxf(-z, 0.f) + log1p_01(fexp(-fabsf(z)))) * (1.f / 16.f); c[j] = (j ? c[j - 1] : 0.f) + gl; }
        const float tot = c[3], ptot = xget32(tot, h); const float pre = run + (h ? ptot : 0.f);
#pragma unroll
        for (int j = 0; j < 4; ++j) bb[4 * k + j] = pre + c[j];
        run += tot + ptot; }
    const float blast = run, dec = fexp(blast);
    if (h == 0) Dec[r] = dec;
#pragma unroll
    for (int i = 0; i < 32; ++i) { const int t = 32 * (i >> 4) + 8 * ((i >> 2) & 3) + 4 * h + (i & 3); *(LAS bf16_t*)(scr + t * 80 + r * 2) = (bf16_t)f2bf(qv[i] * 0.17677669529663687f * fexp(bb[i])); }
    __builtin_amdgcn_wave_barrier(); asm volatile("" ::: "memory");
    bf16x8 qB[2][2], qP[2][2];
#pragma unroll
    for (int it = 0; it < 2; ++it)
#pragma unroll
        for (int ks = 0; ks < 2; ++ks) { const LAS unsigned char* p = scr + (32 * it + r) * 80; qB[it][ks] = *(const LAS bf16x8*)(p + (16 * ks + 8 * h) * 2);
            const u32x2 lo = *(const LAS u32x2*)(p + (16 * ks + 4 * h) * 2), hi = *(const LAS u32x2*)(p + (16 * ks + 8 + 4 * h) * 2); qP[it][ks] = as_frag((u32x4){lo.x, lo.y, hi.x, hi.y}); }
    __builtin_amdgcn_wave_barrier(); asm volatile("" ::: "memory");
#pragma unroll
    for (int i = 0; i < 32; ++i) { const int t = 32 * (i >> 4) + 8 * ((i >> 2) & 3) + 4 * h + (i & 3); *(LAS bf16_t*)(scr + t * 80 + r * 2) = (bf16_t)f2bf(kv[i] * fexp(-bb[i])); }
    __builtin_amdgcn_wave_barrier(); asm volatile("" ::: "memory");
    bf16x8 kA[2][2];
#pragma unroll
    for (int jt = 0; jt < 2; ++jt)
#pragma unroll
        for (int ks = 0; ks < 2; ++ks) kA[jt][ks] = *(const LAS bf16x8*)(scr + (32 * jt + r) * 80 + (16 * ks + 8 * h) * 2);
    __builtin_amdgcn_wave_barrier(); asm volatile("" ::: "memory");
#pragma unroll
    for (int k = 0; k < 8; ++k) { const int t = 32 * (k >> 2) + 8 * (k & 3) + 4 * h; u32x2 o;
        o.x = pk2(kv[4 * k + 0] * fexp(blast - bb[4 * k + 0]), kv[4 * k + 1] * fexp(blast - bb[4 * k + 1])); o.y = pk2(kv[4 * k + 2] * fexp(blast - bb[4 * k + 2]), kv[4 * k + 3] * fexp(blast - bb[4 * k + 3]));
        *(LAS u32x2*)(scr + r * 144 + t * 2) = o; }
    __builtin_amdgcn_wave_barrier(); asm volatile("" ::: "memory");
    bf16x8 keA[4];
#pragma unroll
    for (int ks = 0; ks < 4; ++ks) keA[ks] = *(const LAS bf16x8*)(scr + r * 144 + (16 * ks + 8 * h) * 2);
#pragma unroll
    for (int i8 = 0; i8 < 8; ++i8) { const int tv = 8 * i8 + (lane >> 3), pc = lane & 7; const u32x4 vw = *(const u32x4*)(PROJ + (mrow0 + tv) * NP + PC_DV + 64 * head + 8 * pc);
        *(LAS u32x4*)(VT + tv * 144 + pc * 16) = vw; }
    const LAS unsigned char* vrb = VT + ((lane & 15) >> 2) * 144 + (16 * ((lane >> 4) & 1) + 4 * (lane & 3)) * 2;
    __builtin_amdgcn_wave_barrier(); asm volatile("" ::: "memory");
    bf16x8 P[3][2];
#define D_ATT(idx, jt, it) do { f32x16 acc = (f32x16)(0.f); acc = MFMA32(kA[jt][0], qB[it][0], acc); acc = MFMA32(kA[jt][1], qB[it][1], acc); \
    if (jt == it) { const int rr = r - 4 * h; _Pragma("unroll") for (int rg = 0; rg < 16; ++rg) { acc[rg] = (rr < (rg & 3) + 8 * (rg >> 2)) ? 0.f : acc[rg]; } } \
    P[idx][0] = frag_acc<0>(acc); P[idx][1] = frag_acc<8>(acc); } while (0)
    D_ATT(0, 0, 0); __builtin_amdgcn_sched_barrier(0); D_ATT(1, 0, 1); __builtin_amdgcn_sched_barrier(0); D_ATT(2, 1, 1); __builtin_amdgcn_sched_barrier(0);
#undef D_ATT
    f32x16 ds[2];
#pragma unroll
    for (int et = 0; et < 2; ++et) { ds[et] = (f32x16)(0.f);
#pragma unroll
        for (int ks = 0; ks < 4; ++ks) { const LAS unsigned char* vp = vrb + (16 * ks + 8 * h) * 144 + 64 * et; const u32x2 lo = tr_read4(vp), hi = tr_read4(vp + 4 * 144);
            ds[et] = MFMA32(keA[ks], as_frag((u32x4){lo.x, lo.y, hi.x, hi.y}), ds[et]); } }
    f32x16 L[2]; float pdv[16], dv[16];
#pragma unroll
    for (int q4 = 0; q4 < 4; ++q4) { const f32x4 v = *(const LAS f32x4*)(Dec + 8 * q4 + 4 * h); dv[4 * q4 + 0] = v.x; dv[4 * q4 + 1] = v.y; dv[4 * q4 + 2] = v.z; dv[4 * q4 + 3] = v.w; }
#pragma unroll 1
    for (int step = 0; step < 8; ++step) {
        if (w == step) {
#pragma unroll
            for (int q4 = 0; q4 < 4; ++q4) { const f32x4 v = *(const LAS f32x4*)(Pdl + 8 * q4 + 4 * h); pdv[4 * q4 + 0] = v.x; pdv[4 * q4 + 1] = v.y; pdv[4 * q4 + 2] = v.z; pdv[4 * q4 + 3] = v.w; }
#pragma unroll
            for (int et = 0; et < 2; ++et)
#pragma unroll
                for (int q4 = 0; q4 < 4; ++q4) { const f32x4 v = Sst[(et * 4 + q4) * 64 + lane]; L[et][4 * q4 + 0] = v.x; L[et][4 * q4 + 1] = v.y; L[et][4 * q4 + 2] = v.z; L[et][4 * q4 + 3] = v.w;
                    f32x4 nv; nv.x = fmaf(v.x, dv[4 * q4 + 0], ds[et][4 * q4 + 0]); nv.y = fmaf(v.y, dv[4 * q4 + 1], ds[et][4 * q4 + 1]); nv.z = fmaf(v.z, dv[4 * q4 + 2], ds[et][4 * q4 + 2]); nv.w = fmaf(v.w, dv[4 * q4 + 3], ds[et][4 * q4 + 3]);
                    Sst[(et * 4 + q4) * 64 + lane] = nv; }
            if (lane < 32) Pdl[lane] = Pdl[lane] * Dec[lane]; }
        __syncthreads(); }
    { unsigned long long* gmine = GD + (size_t)((b * 4 + head) * 8 + grp) * GD_STRIDE; const f32x4 sv = Sst[tid];
      gr_store(gmine + 4 * tid + 0, tag, sv.x); gr_store(gmine + 4 * tid + 1, tag, sv.y); gr_store(gmine + 4 * tid + 2, tag, sv.z); gr_store(gmine + 4 * tid + 3, tag, sv.w);
      if (tid < 32) gr_store(gmine + 2048 + tid, tag, Pdl[tid]);
      f32x4 sin = (f32x4){0.f, 0.f, 0.f, 0.f}; const int d0 = 8 * ((tid >> 6) & 3) + 4 * ((tid >> 5) & 1);
      const unsigned long long* gb = GD + (size_t)((b * 4 + head) * 8) * GD_STRIDE;
      for (int p0 = 0; p0 < grp; p0 += 4) { unsigned long long gs[4][4], gd[4][4]; unsigned spins = 0;
          for (;;) { bool ok = true;
#pragma unroll
              for (int k = 0; k < 4; ++k) { const int p = (p0 + k < grp) ? p0 + k : grp - 1; const unsigned long long* gp = gb + (size_t)p * GD_STRIDE;
#pragma unroll
                  for (int e = 0; e < 4; ++e) { gs[k][e] = gr_load(gp + 4 * tid + e); gd[k][e] = gr_load(gp + 2048 + d0 + e); ok = ok && ((unsigned)(gs[k][e] >> 32) == tag) && ((unsigned)(gd[k][e] >> 32) == tag); } }
              if (__all(ok) || ++spins > SPIN_CAP) break;
              __builtin_amdgcn_s_sleep(2); }
#pragma unroll
          for (int k = 0; k < 4; ++k) if (p0 + k < grp) {
              sin.x = fmaf(sin.x, __uint_as_float((unsigned)gd[k][0]), __uint_as_float((unsigned)gs[k][0])); sin.y = fmaf(sin.y, __uint_as_float((unsigned)gd[k][1]), __uint_as_float((unsigned)gs[k][1]));
              sin.z = fmaf(sin.z, __uint_as_float((unsigned)gd[k][2]), __uint_as_float((unsigned)gs[k][2])); sin.w = fmaf(sin.w, __uint_as_float((unsigned)gd[k][3]), __uint_as_float((unsigned)gs[k][3])); } }
      Sin[tid] = sin; }
    __syncthreads();
    bf16x8 SA[2][2];
#pragma unroll
    for (int et = 0; et < 2; ++et) {
#pragma unroll
        for (int q4 = 0; q4 < 4; ++q4) { const f32x4 v = Sin[(et * 4 + q4) * 64 + lane]; L[et][4 * q4 + 0] = fmaf(pdv[4 * q4 + 0], v.x, L[et][4 * q4 + 0]); L[et][4 * q4 + 1] = fmaf(pdv[4 * q4 + 1], v.y, L[et][4 * q4 + 1]);
            L[et][4 * q4 + 2] = fmaf(pdv[4 * q4 + 2], v.z, L[et][4 * q4 + 2]); L[et][4 * q4 + 3] = fmaf(pdv[4 * q4 + 3], v.w, L[et][4 * q4 + 3]); }
        SA[et][0] = frag_acc<0>(L[et]); SA[et][1] = frag_acc<8>(L[et]); }
#pragma unroll
    for (int it = 0; it < 2; ++it) { f32x16 o[2]; o[0] = (f32x16)(0.f); o[1] = (f32x16)(0.f);
#pragma unroll
        for (int jt = 0; jt <= it; ++jt) { const int idx = (jt == 0) ? it : 2;
#pragma unroll
            for (int sp = 0; sp < 2; ++sp)
#pragma unroll
                for (int et = 0; et < 2; ++et) { const LAS unsigned char* vp = vrb + (32 * jt + 16 * sp + 4 * h) * 144 + 64 * et; const u32x2 lo = tr_read4(vp), hi = tr_read4(vp + 8 * 144);
                    o[et] = MFMA32(as_frag((u32x4){lo.x, lo.y, hi.x, hi.y}), P[idx][sp], o[et]); } }
#pragma unroll
        for (int ks = 0; ks < 2; ++ks)
#pragma unroll
            for (int et = 0; et < 2; ++et) o[et] = MFMA32(SA[et][ks], qP[it][ks], o[et]);
        float ss = 0.f;
#pragma unroll
        for (int et = 0; et < 2; ++et)
#pragma unroll
            for (int rg = 0; rg < 16; ++rg) ss = fmaf(o[et][rg], o[et][rg], ss);
        ss = xsum32(ss);
        const float rstd = rsq(ss * (1.f / 64.f) + EPS); const size_t tok = mrow0 + 32 * it + r;
#pragma unroll
        for (int et = 0; et < 2; ++et)
#pragma unroll
            for (int g4 = 0; g4 < 4; ++g4) { const int e = 32 * et + 8 * g4 + 4 * h; const f32x4 ng = *(const f32x4*)(d_norm_g + l * 64 + e); const u32x2 gw = *(const u32x2*)(PROJ + tok * NP + PC_DGATE + 64 * head + e);
                u32x2 ov; ov.x = pk2(o[et][4 * g4 + 0] * rstd * ng.x * silu(bf_lo(gw.x)), o[et][4 * g4 + 1] * rstd * ng.y * silu(bf_hi(gw.x)));
                ov.y = pk2(o[et][4 * g4 + 2] * rstd * ng.z * silu(bf_lo(gw.y)), o[et][4 * g4 + 3] * rstd * ng.w * silu(bf_hi(gw.y)));
                *(u32x2*)(Y + tok * DM + 768 + 64 * head + e) = ov; } }
    __syncthreads();
}

constexpr int U_D = 128, U_C = 256, U_B = 256, U_A = 256, U_MIX = U_C + U_D + U_B + U_A, U_W = (I_L + NWAVES - 1) / NWAVES;
__global__ void __launch_bounds__(NTHR, 2) fwd_kernel(Args args) {
    extern __shared__ __attribute__((aligned(16))) unsigned char lds_raw[];
    Frame F;
    F.lds = (LAS unsigned char*)lds_raw; F.MISC = (volatile LAS unsigned*)(F.lds + MISC_OFF);
    F.tid = threadIdx.x; F.lane = F.tid & 63; F.wave = __builtin_amdgcn_readfirstlane(F.tid >> 6); F.G = gridDim.x;
    for (int u = F.tid; u < 256; u += NTHR) ((LAS unsigned*)(F.lds + LDSCTL_OFF))[u] = 0u;
    __syncthreads();
    XcdBarrier bar = xcd_barrier_post((unsigned*)(args.ws + WS_CTL) + CW_BAR, F.MISC + 8);
#define GRID_BAR() xcd_barrier(bar)
    p0_prologue(F);
    GRID_BAR();
#pragma unroll 1
    for (int l = 0; l < DEPTH; ++l) {
        { CArgs* A = get_args();
          pg8::Gemm g{WSP(bf16_t, WS_XB), WSP(bf16_t, WS_WIN) + (size_t)l * NP * DM, M, NP, DM}; pg8::StaticOrder S; S.init(M, NP, F.G, (int)blockIdx.x);
          pg8::EpiProj E{WSP(bf16_t, WS_PROJ), NP, WSP(float, WS_SSQ), __builtin_amdgcn_make_buffer_rsrc(WSP(bf16_t, WS_PROJ), 0, (int)((size_t)M * NP * 2), 0x00020000)};
          pg8::gemm_phase<pg8::EpiProj, pg8::StaticOrder, true, true>(F.lds, g, S, E); }
        int all_seen = 1;
        if (F.G == 256) { all_seen = 0;
            asm volatile("s_waitcnt vmcnt(0)" ::: "memory"); __syncthreads();
            if (F.tid == 0) { const int c = (int)blockIdx.x; unsigned* ctl = (unsigned*)(args.ws + WS_CTL);
                __hip_atomic_fetch_add(ctl + CW_PCNT + 64 * (l * 64 + 8 * (c & 7) + ((c >> 3) & 7)), 1u, RLX_AGENT); __hip_atomic_fetch_add(ctl + CW_GDONE + 64 * l, 1u, RLX_AGENT); }
        } else GRID_BAR();
        { CArgs* A = get_args(); unsigned* qh = WSP(unsigned, WS_CTL) + CW_Q + 64 * l;
          __syncthreads();
          if (F.tid == 0) F.MISC[16] = __hip_atomic_fetch_add(qh, 1u, RLX_AGENT);
          __syncthreads();
          int u = (int)F.MISC[16];
          const int U_TOTAL = U_MIX + (l + 1 < DEPTH ? U_W : 0);
          while (u < U_TOTAL) {
              const bool pre = u >= U_D + U_C;
              unsigned nxt = 0u; if (pre && F.tid == 0) nxt = __hip_atomic_fetch_add(qh, 1u, RLX_AGENT);
              if (!all_seen) {
                  if (F.tid == 0) { int need = 1, bb = 0, lo = 0, hi = 0;
                      if (u < U_D) { bb = (u >> 2) & 3; lo = 512 * (u >> 4); hi = lo + 511; }
                      else if (u < U_C + U_D) { const int uc = u - U_D; bb = (uc >> 2) & 3; lo = 256 * (uc >> 4) - 3; hi = lo + 258; }
                      else if (u < U_C + U_D + U_A) { const int ua = u - U_C - U_D; bb = ua >> 6; lo = 64 * (ua & 63) - 30; hi = lo + 93; }
                      else if (u < U_MIX) { const int ub = u - U_C - U_D - U_A; bb = ub >> 6; lo = 128 * ((ub >> 1) & 31) - 128; hi = lo + 255; }
                      else need = 0;
                      unsigned* ctl = (unsigned*)(A->ws + WS_CTL); unsigned* pc = ctl + CW_PCNT + 64 * (l * 64 + 16 * bb);
                      const int p0 = (lo < 0 ? 0 : lo) >> 8, p1 = hi >> 8; unsigned sp = 0;
                      if (need) while ((__hip_atomic_load(pc + 64 * p0, RLX_AGENT) < 4u || __hip_atomic_load(pc + 64 * p1, RLX_AGENT) < 4u) && ++sp < (1u << 20)) __builtin_amdgcn_s_sleep(1);
                      const unsigned gd = __hip_atomic_load(ctl + CW_GDONE + 64 * l, RLX_AGENT);
                      F.MISC[18] = (gd >= (unsigned)F.G) ? 1u : 0u; }
                  __syncthreads();
                  all_seen = (int)F.MISC[18];
              }
              Frame FL = F; { int t = F.tid; asm volatile("" : "+v"(t)); FL.tid = t; FL.lane = t & 63; FL.wave = __builtin_amdgcn_readfirstlane(t >> 6); }
              if (u < U_D) { mixer_d(FL, l, u); }
              else if (u < U_C + U_D) { mixer_c(FL, l, u - U_D, qh, nxt); }
              else if (u < U_C + U_D + U_A) { mixer_a(FL, l, u - U_C - U_D); }
              else if (u < U_MIX) { mixer_b(FL, l, u - U_C - U_D - U_A); }
              else { const int it = (u - U_MIX) * NWAVES + FL.wave; if (it < I_L) convert_item(FL, l + 1, it); __syncthreads(); }
              if (F.tid == 0) F.MISC[16] = (pre || (u >= U_D && u < U_D + U_C)) ? nxt : __hip_atomic_fetch_add(qh, 1u, RLX_AGENT);
              __syncthreads();
              u = (int)F.MISC[16];
          }
        }
        GRID_BAR();
        { CArgs* A = get_args();
          pg8::Gemm g{WSP(bf16_t, WS_Y), WSP(bf16_t, WS_WOUT) + (size_t)l * DM * DM, M, DM, DM}; pg8::StaticOrder S; S.init(M, DM, F.G, (int)blockIdx.x);
          pg8::EpiRes E{A->out, WSP(bf16_t, WS_XB), WSP(float, WS_SSQ), l + 1 < DEPTH ? 1 : 2, __builtin_amdgcn_make_buffer_rsrc(WSP(bf16_t, WS_XB), 0, (int)((size_t)M * DM * 2), 0x00020000)};
          pg8::gemm_phase<pg8::EpiRes, pg8::StaticOrder, true, true>(F.lds, g, S, E); }
        if (l + 1 < DEPTH) {
            if (F.G == 256) {
                asm volatile("s_waitcnt vmcnt(0)" ::: "memory"); __syncthreads();
                if (F.tid == 0) { unsigned* cnt = (unsigned*)(args.ws + WS_CTL) + CW_TEAM + 64 * (l * 64 + ((int)blockIdx.x & 63));
                    __hip_atomic_fetch_add(cnt, 1u, RLX_AGENT);
                    unsigned sp = 0; while (__hip_atomic_load(cnt, RLX_AGENT) < 4u && ++sp < (1u << 20)) __builtin_amdgcn_s_sleep(1);
                    __builtin_amdgcn_fence(__ATOMIC_ACQUIRE, "agent"); asm volatile("s_waitcnt vmcnt(0)" ::: "memory"); }
                __syncthreads();
            } else GRID_BAR();
        }
    }
}

extern "C" void kernel_launch(void* const* d_in, const int* in_sizes, int n_in, void* d_out, int out_size, void* d_ws, size_t ws_size, hipStream_t stream) {
    static int grid = 0;
    if (grid == 0) {
        if (n_in != 23 || in_sizes[0] != M * DM || out_size != M * DM || ws_size < WS_END) { fprintf(stderr, "kernel_launch: unexpected problem shape (n_in %d, in0 %d, out %d, ws %zu)\n", n_in, n_in > 0 ? in_sizes[0] : -1, out_size, ws_size); grid = -1; return; }
        int dev = 0, cus = 0, per_cu = 0;
        if (hipGetDevice(&dev) != hipSuccess || hipDeviceGetAttribute(&cus, hipDeviceAttributeMultiprocessorCount, dev) != hipSuccess) { grid = -1; return; }
        if (hipFuncSetAttribute((const void*)fwd_kernel, hipFuncAttributeMaxDynamicSharedMemorySize, LDS_BYTES) != hipSuccess) { fprintf(stderr, "kernel_launch: hipFuncSetAttribute failed\n"); grid = -1; return; }
        if (hipOccupancyMaxActiveBlocksPerMultiprocessor(&per_cu, (const void*)fwd_kernel, NTHR, LDS_BYTES) != hipSuccess || per_cu < 1) { fprintf(stderr, "kernel_launch: occupancy query says %d blocks per CU\n", per_cu); grid = -1; (void)hipGetLastError(); return; }
        grid = cus * per_cu < 256 ? cus * per_cu : 256;
    }
    if (grid <= 0) return;
    (void)hipMemsetAsync((char*)d_ws + WS_CTL, 0, CTL_ZERO_BYTES, stream);
    Args a{};
    for (int i = 0; i < 23; ++i) a.in[i] = (const float*)d_in[i];
    a.out = (float*)d_out; a.ws = (unsigned char*)d_ws;
    void* kargs[] = {&a};
    hipError_t e = hipLaunchCooperativeKernel((const void*)fwd_kernel, dim3(grid), dim3(NTHR), kargs, LDS_BYTES, stream);
    if (e != hipSuccess) fprintf(stderr, "kernel_launch: cooperative launch failed: %s (grid %d)\n", hipGetErrorString(e), grid);
}
```
